# Optimizing an MI355X kernel written in HIP

```python
import math
import jax, jax.numpy as jnp
from jax import lax
import numpy as np

D_MODEL = 2048
BATCH = 4
SEQ = 2048
DEPTH = 2
DEC_BATCH = 128
DEC_SEQ = 4
PAST_LEN = 16384
PAGE_SIZE = 128

W_A = D_MODEL // 2
SSM_GROUP = 16
G_A = W_A // SSM_GROUP
P_STATE = 64
W_B = D_MODEL // 2
CHUNK_B = 128
G_B = 8
CB = W_B // G_B
DK = 128
DV = 128
W_C = D_MODEL // 2
H_C = W_C // DV
QKV_DIM = 2 * H_C * DK + W_C
CONV_W = 4
CHUNK_C = 64
N_BRANCH = 3
N_IN = 2 * W_A + 3 * W_B + QKV_DIM + 2 * H_C + W_C + N_BRANCH * D_MODEL
_IN_SIZES = (W_A, W_A, W_B, W_B, W_B, QKV_DIM, H_C, H_C, W_C, N_BRANCH * D_MODEL)
ALPHA = (2 * DEPTH) ** 0.25
BETA_INIT = (8 * DEPTH) ** -0.25
LN_EPS = 1e-5
NORM_EPS = 1e-6

kernel_name = 'hybrid_s5_gmlp_gdn_decoder_step'


def _layernorm(x, g, b):
    xf = x.astype(jnp.float32)
    mu = jnp.mean(xf, -1, keepdims=True)
    var = jnp.mean(jnp.square(xf - mu), -1, keepdims=True)
    y = (xf - mu) * lax.rsqrt(var + LN_EPS) * g.astype(jnp.float32) + b.astype(jnp.float32)
    return y.astype(x.dtype)


def _cplx_combine(left, right):
    a1r, a1i, b1r, b1i = left
    a2r, a2i, b2r, b2i = right
    ar = a2r * a1r - a2i * a1i
    ai = a2r * a1i + a2i * a1r
    br = a2r * b1r - a2i * b1i + b2r
    bi = a2r * b1i + a2i * b1r + b2i
    return ar, ai, br, bi


def _s5_branch(xa, h_re, h_im, lam_re, lam_im, log_dt, b_re, b_im, c_re, c_im, d, w_glu, b_glu):
    f32 = jnp.float32
    bn, t = xa.shape[0], xa.shape[1]
    u = xa.astype(f32).reshape(bn, t, G_A, SSM_GROUP)
    lr = lam_re.astype(f32)
    li = lam_im.astype(f32)
    dt = jnp.exp(log_dt.astype(f32))[:, None]
    mag = jnp.exp(lr * dt)
    ab_r = mag * jnp.cos(li * dt)
    ab_i = mag * jnp.sin(li * dt)
    den = lr * lr + li * li
    nr = ab_r - 1.0
    ni = ab_i
    f_r = (nr * lr + ni * li) / den
    f_i = (ni * lr - nr * li) / den
    br = b_re.astype(f32)
    bi = b_im.astype(f32)
    bb_r = f_r[..., None] * br - f_i[..., None] * bi
    bb_i = f_r[..., None] * bi + f_i[..., None] * br
    bu_r = jnp.einsum('gpc,btgc->btgp', bb_r, u)
    bu_i = jnp.einsum('gpc,btgc->btgp', bb_i, u)
    a_r = jnp.broadcast_to(ab_r, bu_r.shape)
    a_i = jnp.broadcast_to(ab_i, bu_i.shape)
    cum_r, cum_i, s_r, s_i = lax.associative_scan(_cplx_combine, (a_r, a_i, bu_r, bu_i), axis=1)
    h0r = h_re.astype(f32)[:, None]
    h0i = h_im.astype(f32)[:, None]
    s_r, s_i = s_r + cum_r * h0r - cum_i * h0i, s_i + cum_r * h0i + cum_i * h0r
    y = jnp.einsum('gcp,btgp->btgc', c_re.astype(f32), s_r) - jnp.einsum('gcp,btgp->btgc', c_im.astype(f32), s_i)
    y = y.reshape(bn, t, W_A) + d.astype(f32) * xa.astype(f32)
    z = jax.nn.gelu(y).astype(xa.dtype)
    z = z * jax.nn.sigmoid(z @ w_glu + b_glu)
    return z, s_r[:, -1].astype(h_re.dtype), s_i[:, -1].astype(h_im.dtype)


def _chunk_gmlp_branch(u, v, ln_v_g, ln_v_b, w_s, b_s):
    bn, t = u.shape[0], u.shape[1]
    vn = _layernorm(v, ln_v_g, ln_v_b)
    pad = (-t) % CHUNK_B
    nc = (t + pad) // CHUNK_B
    vp = jnp.pad(vn, ((0, 0), (0, pad), (0, 0))).reshape(bn, nc, CHUNK_B, G_B, CB)
    ws = w_s * jnp.tril(jnp.ones((CHUNK_B, CHUNK_B), w_s.dtype))
    s = jnp.einsum('gij,bnjgc->bnigc', ws, vp) + b_s.T[None, None, :, :, None]
    s = s.reshape(bn, nc * CHUNK_B, W_B)[:, :t]
    return u * s, vn


def _causal_conv(x, buf, w):
    t = x.shape[1]
    xp = jnp.concatenate([buf.astype(x.dtype), x], axis=1)
    y = sum(xp[:, j:j + t] * w[j] for j in range(CONV_W))
    return y, xp[:, t:]


def _l2norm(x):
    return x * lax.rsqrt(jnp.sum(x * x, -1, keepdims=True) + NORM_EPS)


def _gated_delta_chunked(q, k, v, g, beta, s0):
    bn, t = q.shape[0], q.shape[1]
    pad = (-t) % CHUNK_C
    nc = (t + pad) // CHUNK_C

    def chunks(a):
        a = jnp.pad(a, ((0, 0), (0, pad)) + ((0, 0),) * (a.ndim - 2))
        a = a.reshape((bn, nc, CHUNK_C) + a.shape[2:])
        return jnp.moveaxis(jnp.moveaxis(a, 3, 2), 1, 0)

    q = chunks(q * DK ** -0.5)
    k = chunks(k)
    v = chunks(v)
    g = chunks(g)
    beta = chunks(beta)
    gc = jnp.cumsum(g, axis=-1)
    idx = jnp.arange(CHUNK_C)
    causal = idx[:, None] >= idx[None, :]
    strict = idx[:, None] > idx[None, :]
    diff = gc[..., :, None] - gc[..., None, :]
    decay = jnp.where(causal, jnp.exp(jnp.where(causal, diff, 0.0)), 0.0)
    kb = k * beta[..., None]
    vb = v * beta[..., None]
    lmat = jnp.where(strict, jnp.einsum('nbhid,nbhjd->nbhij', kb, k) * decay, 0.0)
    eye = jnp.eye(CHUNK_C, dtype=jnp.float32)
    rhs = jnp.concatenate([vb, kb * jnp.exp(gc)[..., None]], axis=-1)
    sol = lax.linalg.triangular_solve(lmat + eye, rhs, left_side=True, lower=True, unit_diagonal=True)
    u_c = sol[..., :DV]
    w_c = sol[..., DV:]

    def step(s, inp):
        qi, ki, ui, wi, gi, di = inp
        v_new = ui - jnp.einsum('bhck,bhkv->bhcv', wi, s)
        attn = jnp.einsum('bhik,bhjk->bhij', qi, ki) * di
        o = jnp.einsum('bhck,bhkv->bhcv', qi * jnp.exp(gi)[..., None], s) + jnp.einsum('bhij,bhjv->bhiv', attn, v_new)
        gl = gi[..., -1:]
        s = s * jnp.exp(gl)[..., None] + jnp.einsum('bhck,bhcv->bhkv', ki * jnp.exp(gl - gi)[..., None], v_new)
        return s, o

    s_fin, o = lax.scan(step, s0, (q, k, u_c, w_c, gc, decay))
    o = jnp.moveaxis(jnp.moveaxis(o, 0, 1), 2, 3).reshape(bn, nc * CHUNK_C, H_C, DV)[:, :t]
    return o, s_fin


def _gdn_branch(qkv, a_c, b_c, gate_c, conv_buf, s0, conv_w, a_log, dt_bias, norm_g):
    f32 = jnp.float32
    bn, t = qkv.shape[0], qkv.shape[1]
    y, new_buf = _causal_conv(qkv, conv_buf, conv_w)
    y = jax.nn.silu(y).astype(f32)
    q, k, v = jnp.split(y, [H_C * DK, 2 * H_C * DK], axis=-1)
    q = _l2norm(q.reshape(bn, t, H_C, DK))
    k = _l2norm(k.reshape(bn, t, H_C, DK))
    v = v.reshape(bn, t, H_C, DV)
    g = -jnp.exp(a_log.astype(f32)) * jax.nn.softplus(a_c.astype(f32) + dt_bias.astype(f32))
    beta = jax.nn.sigmoid(b_c.astype(f32))
    o, s_fin = _gated_delta_chunked(q, k, v, g, beta, s0.astype(f32))
    o = o * lax.rsqrt(jnp.mean(o * o, -1, keepdims=True) + NORM_EPS) * norm_g.astype(f32)
    o = o.reshape(bn, t, W_C).astype(qkv.dtype) * jax.nn.silu(gate_c)
    return o, s_fin.astype(s0.dtype), new_buf.astype(conv_buf.dtype)


def _layer(x, h_re, h_im, s0, cbuf, w_in, b_gate, lam_re, lam_im, log_dt, b_re, b_im, c_re, c_im, d,
           w_glu, b_glu, w_pa, ln_v_g, ln_v_b, w_s, b_s, w_pb, conv_w, a_log, dt_bias, norm_g, w_pc,
           w_out, ln_g, ln_b):
    proj = x @ w_in
    split_at = np.cumsum(_IN_SIZES)[:-1].tolist()
    xa, ga, ub, vb, gb, qkv, a_c, b_c, gate_c, zg = jnp.split(proj, split_at, axis=-1)
    ya, h_re_n, h_im_n = _s5_branch(xa, h_re, h_im, lam_re, lam_im, log_dt, b_re, b_im, c_re, c_im, d, w_glu, b_glu)
    pa = (ya * jax.nn.silu(ga)) @ w_pa
    yb, v_rows = _chunk_gmlp_branch(ub, vb, ln_v_g, ln_v_b, w_s, b_s)
    pb = (yb * jax.nn.silu(gb)) @ w_pb
    yc, s_n, cbuf_n = _gdn_branch(qkv, a_c, b_c, gate_c, cbuf, s0, conv_w, a_log, dt_bias, norm_g)
    pc = yc @ w_pc
    g_a, g_b, g_c = jnp.split(jax.nn.sigmoid(zg + b_gate), N_BRANCH, axis=-1)
    out = (g_a * pa + g_b * pb + g_c * pc) @ w_out
    y = _layernorm(ALPHA * x + out, ln_g, ln_b)
    return y, h_re_n, h_im_n, s_n, cbuf_n, v_rows


def setup_inputs(seed: int = 0) -> dict:
    key = jax.random.key(seed)
    ks = list(jax.random.split(key, 40))

    def nrm(shape, scale=1.0):
        return jax.random.normal(ks.pop(), shape, jnp.float32) * scale

    def unif(shape, lo, hi):
        return jax.random.uniform(ks.pop(), shape, jnp.float32, lo, hi)

    dt_c = jnp.exp(unif((DEPTH, H_C), math.log(1e-3), math.log(1e-1)))
    return {
        'x_prompt': nrm((BATCH, SEQ, D_MODEL)),
        'x_sample': nrm((DEC_BATCH, DEC_SEQ, D_MODEL)),
        'state_ssm_re': nrm((DEPTH, DEC_BATCH, G_A, P_STATE), 0.5),
        'state_ssm_im': nrm((DEPTH, DEC_BATCH, G_A, P_STATE), 0.5),
        'state_delta': nrm((DEPTH, DEC_BATCH, H_C, DK, DV), DK ** -0.5),
        'state_conv': nrm((DEPTH, DEC_BATCH, CONV_W - 1, QKV_DIM)),
        'w_in': nrm((DEPTH, D_MODEL, N_IN), D_MODEL ** -0.5),
        'b_gate': nrm((DEPTH, N_BRANCH * D_MODEL), 0.01),
        'lam_re': -0.5 + nrm((DEPTH, G_A, P_STATE), 0.01),
        'lam_im': math.pi * jnp.arange(P_STATE, dtype=jnp.float32) + nrm((DEPTH, G_A, P_STATE), 0.01),
        'log_dt': unif((DEPTH, G_A), math.log(1e-3), math.log(1e-1)),
        'ssm_b_re': nrm((DEPTH, G_A, P_STATE, SSM_GROUP), (2 * SSM_GROUP) ** -0.5),
        'ssm_b_im': nrm((DEPTH, G_A, P_STATE, SSM_GROUP), (2 * SSM_GROUP) ** -0.5),
        'ssm_c_re': nrm((DEPTH, G_A, SSM_GROUP, P_STATE), P_STATE ** -0.5),
        'ssm_c_im': nrm((DEPTH, G_A, SSM_GROUP, P_STATE), P_STATE ** -0.5),
        'ssm_d': nrm((DEPTH, W_A)),
        'w_glu': nrm((DEPTH, W_A, W_A), W_A ** -0.5),
        'b_glu': nrm((DEPTH, W_A), 0.01),
        'w_pa': nrm((DEPTH, W_A, D_MODEL), BETA_INIT * W_A ** -0.5),
        'ln_v_g': 1.0 + nrm((DEPTH, W_B), 0.01),
        'ln_v_b': nrm((DEPTH, W_B), 0.01),
        'w_s': nrm((DEPTH, G_B, CHUNK_B, CHUNK_B), CHUNK_B ** -0.5),
        'b_s': 1.0 + nrm((DEPTH, G_B, CHUNK_B), 0.1),
        'w_pb': nrm((DEPTH, W_B, D_MODEL), BETA_INIT * W_B ** -0.5),
        'conv_w': nrm((DEPTH, CONV_W, QKV_DIM), CONV_W ** -0.5),
        'a_log': jnp.log(unif((DEPTH, H_C), 1.0, 16.0)),
        'dt_bias': dt_c + jnp.log(-jnp.expm1(-dt_c)),
        'gdn_norm_g': 1.0 + nrm((DEPTH, DV), 0.01),
        'w_pc': nrm((DEPTH, W_C, D_MODEL), BETA_INIT * W_C ** -0.5),
        'w_out': nrm((DEPTH, D_MODEL, D_MODEL), BETA_INIT * D_MODEL ** -0.5),
        'ln_g': 1.0 + nrm((DEPTH, D_MODEL), 0.01),
        'ln_b': nrm((DEPTH, D_MODEL), 0.01),
    }


def reference(x_prompt, x_sample, state_ssm_re, state_ssm_im, state_delta, state_conv, w_in, b_gate,
              lam_re, lam_im, log_dt, ssm_b_re, ssm_b_im, ssm_c_re, ssm_c_im, ssm_d, w_glu, b_glu, w_pa,
              ln_v_g, ln_v_b, w_s, b_s, w_pb, conv_w, a_log, dt_bias, gdn_norm_g, w_pc, w_out, ln_g, ln_b):
    layer_params = (w_in, b_gate, lam_re, lam_im, log_dt, ssm_b_re, ssm_b_im, ssm_c_re, ssm_c_im, ssm_d,
                    w_glu, b_glu, w_pa, ln_v_g, ln_v_b, w_s, b_s, w_pb, conv_w, a_log, dt_bias,
                    gdn_norm_g, w_pc, w_out, ln_g, ln_b)
    bp = x_prompt.shape[0]
    h0 = jnp.zeros((bp, G_A, P_STATE), state_ssm_re.dtype)
    s0 = jnp.zeros((bp, H_C, DK, DV), state_delta.dtype)
    c0 = jnp.zeros((bp, CONV_W - 1, QKV_DIM), state_conv.dtype)
    y_prompt, y_sample = x_prompt, x_sample
    p_re, p_im, p_s, p_c = [], [], [], []
    q_re, q_im, q_s, q_c, q_v = [], [], [], [], []
    for l in range(DEPTH):
        lp = tuple(p[l] for p in layer_params)
        y_prompt, hr, hi, sd, cb, _ = _layer(y_prompt, h0, h0, s0, c0, *lp)
        p_re.append(hr)
        p_im.append(hi)
        p_s.append(sd)
        p_c.append(cb)
        y_sample, hr, hi, sd, cb, vr = _layer(y_sample, state_ssm_re[l], state_ssm_im[l], state_delta[l],
                                              state_conv[l], *lp)
        q_re.append(hr)
        q_im.append(hi)
        q_s.append(sd)
        q_c.append(cb)
        q_v.append(vr)
    return (y_prompt, y_sample, jnp.stack(p_re), jnp.stack(p_im), jnp.stack(p_s), jnp.stack(p_c),
            jnp.stack(q_re), jnp.stack(q_im), jnp.stack(q_s), jnp.stack(q_c), jnp.stack(q_v))
```

```cpp
#include <hip/hip_runtime.h>
#include <hip/hip_cooperative_groups.h>
#include <cstdio>
#include <cstdint>
namespace cg = cooperative_groups;

#ifndef MK_SINGLE
#define MK_SINGLE 1
#endif

#define LAS __attribute__((address_space(3)))
typedef unsigned short bf16_t;
typedef short bf16x8 __attribute__((ext_vector_type(8)));
typedef float f32x4 __attribute__((ext_vector_type(4)));
typedef float f32x2 __attribute__((ext_vector_type(2)));
typedef float f32x16 __attribute__((ext_vector_type(16)));
typedef unsigned u32x4 __attribute__((ext_vector_type(4)));
typedef unsigned u32x2 __attribute__((ext_vector_type(2)));

constexpr int DM = 2048, TP = 8192, TS = 512, MT = TP + TS;
constexpr int NIN = 15376, NP = 15616;
constexpr int C_XA = 0, C_GA = 1024, C_UB = 2048, C_VB = 3072, C_GB = 4096, C_QKV = 5120, C_GATEC = 8192, C_ZG = 9216, C_AB = 15360;
constexpr int NPHASE = 13;
constexpr float ALPHA = 1.41421356237f;

constexpr size_t MiB = 1u << 20;
constexpr size_t WS_CTL = 0;
constexpr size_t WS_W0 = 1 * MiB, WS_WL = 83 * MiB;
constexpr size_t WO_IN = 0, WO_GLU = 61 * MiB, WO_PA = 63 * MiB, WO_PB = 67 * MiB, WO_PC = 71 * MiB, WO_OUT = 75 * MiB;
constexpr size_t WS_XB = 167 * MiB, WS_P = 201 * MiB, WS_AB = 461 * MiB, WS_ZB = 462 * MiB, WS_YA = 479 * MiB, WS_YB = 496 * MiB, WS_YC = 513 * MiB;
constexpr size_t WS_M32 = 530 * MiB, WS_MB = 598 * MiB, WS_H32 = 632 * MiB, WS_X32 = 700 * MiB, WS_END = 768 * MiB;

constexpr size_t O_YP = 0, O_YS = 16777216, O_SRP = 17825792, O_SIP = 17858560, O_DP = 17891328, O_CP = 18939904,
                 O_SRS = 19013632, O_SIS = 20062208, O_DS = 21110784, O_CS = 54665216, O_GV = 57024512, O_END = 58073088;

constexpr int LDS_BYTES = 147456;

struct Args { const float* in[32]; float* out; unsigned char* ws; int ph_lo, ph_hi; };
typedef const __attribute__((address_space(4))) Args CArgs;

__device__ __forceinline__ unsigned f2bf(float f) { unsigned u = __builtin_bit_cast(unsigned, f); return (u + 0x7fffu + ((u >> 16) & 1u)) >> 16; }
__device__ __forceinline__ unsigned pk2(float lo, float hi) { return f2bf(lo) | (f2bf(hi) << 16); }
__device__ __forceinline__ float bf2f(unsigned short h) { return __builtin_bit_cast(float, (unsigned)h << 16); }
__device__ __forceinline__ float bflo(unsigned w) { return __builtin_bit_cast(float, w << 16); }
__device__ __forceinline__ float bfhi(unsigned w) { return __builtin_bit_cast(float, w & 0xffff0000u); }
__device__ __forceinline__ float sigm(float x) { return 1.f / (1.f + __expf(-x)); }
__device__ __forceinline__ float silu(float x) { return x / (1.f + __expf(-x)); }
__device__ __forceinline__ float gelu_tanh(float x) { return x * sigm(1.5957691216f * (x + 0.044715f * x * x * x)); }
__device__ __forceinline__ float softplus(float x) { return x > 20.f ? x : log1pf(expf(x)); }
__device__ __forceinline__ float wave_sum(float v) {
#pragma unroll
    for (int o = 1; o < 64; o <<= 1) v += __shfl_xor(v, o);
    return v;
}
__device__ __forceinline__ void unpack8(const u32x4 w, float (&f)[8]) {
    f[0] = bflo(w.x); f[1] = bfhi(w.x); f[2] = bflo(w.y); f[3] = bfhi(w.y); f[4] = bflo(w.z); f[5] = bfhi(w.z); f[6] = bflo(w.w); f[7] = bfhi(w.w);
}
__device__ __forceinline__ u32x4 pack8(const float (&f)[8]) { u32x4 w; w.x = pk2(f[0], f[1]); w.y = pk2(f[2], f[3]); w.z = pk2(f[4], f[5]); w.w = pk2(f[6], f[7]); return w; }
#define LDS_WAIT() asm volatile("s_waitcnt lgkmcnt(0)" ::: "memory")
__device__ __forceinline__ int launder_v(int x) { asm volatile("" : "+v"(x)); return x; }
__device__ __forceinline__ int launder_s(int x) { asm volatile("" : "+s"(x)); return x; }
__device__ __forceinline__ CArgs& kargs() { int z; asm volatile("s_mov_b32 %0, 0" : "=s"(z));
    return *(CArgs*)((const __attribute__((address_space(4))) char*)__builtin_amdgcn_kernarg_segment_ptr() + z); }
__device__ __forceinline__ LAS unsigned char* lds_base() { extern __shared__ __attribute__((aligned(16))) unsigned char lds_raw[]; int z; asm volatile("s_mov_b32 %0, 0" : "=s"(z));
    return (LAS unsigned char*)lds_raw + z; }

namespace pg8 {
constexpr int BM = 256, BK = 64, HALF = 128, HTB = HALF * BK * 2, STAGE_BYTES = 8 * HTB, NXCD = 8, WGM = 8;
__device__ __forceinline__ int lds_byte(int r, int c) { const int st = (r >> 4) * 2 + (c >> 5), rr = r & 15, cc = c & 31, ob = rr * 64 + cc * 2; return st * 1024 + (ob ^ (((ob >> 9) & 1) << 5)); }
__device__ __forceinline__ void stage_rc(int b, int& R, int& C) { const int st = b / 1024, sb = b % 1024, swz = sb ^ (((sb >> 9) & 1) << 5); R = (st >> 1) * 16 + swz / 64; C = (st & 1) * 32 + (swz % 64) / 2; }
__device__ __forceinline__ int perm32(int rho) { const int n = rho >> 4, i = rho & 15; return 8 * (i >> 2) + 4 * n + (i & 3); }

struct Unit { int pm, pn, br; };
struct Gemm { const bf16_t* A0; const bf16_t* A1; const bf16_t* A2; const bf16_t* B0; const bf16_t* B1; const bf16_t* B2; int K; };

struct Sched {
    int nM, nN, nbr, nwg, G, c;
    __device__ __forceinline__ void init(int nM_, int nN_, int nbr_, int G_, int c_) { nM = nM_; nN = nN_; nbr = nbr_; nwg = nM * nN; G = G_; c = c_; }
    __device__ __forceinline__ bool next(int i, Unit& u) const {
        const int ti = i / nbr; u.br = i - ti * nbr;
        const long L = (long)ti * G + c; if (L >= nwg) return false;
        int wgid = (int)L; { const int q = nwg / NXCD, r = nwg % NXCD, xcd = wgid % NXCD, off = wgid / NXCD; wgid = (xcd < r ? xcd * (q + 1) : r * (q + 1) + (xcd - r) * q) + off; }
        const int nig = WGM * nN, gid = wgid / nig, fm = gid * WGM, gsz = (nM - fm) < WGM ? (nM - fm) : WGM;
        u.pm = fm + ((wgid % nig) % gsz); u.pn = (wgid % nig) / gsz; return true;
    }
};

template <class Epi>
__device__ __forceinline__ void gemm_phase(LAS unsigned char* lds, const Gemm g, const Sched& S, const Epi& E, const int tid) {
    const int wid = __builtin_amdgcn_readfirstlane(tid >> 6), lane = tid & 63, wr = wid >> 2, wc = wid & 3, fr = lane & 15, fq = lane >> 4;
    const int K = g.K, nt = K / BK;
    unsigned voffA[2], voffB[2];
#pragma unroll
    for (int i = 0; i < 2; ++i) { int R, C; stage_rc(tid * 16 + i * 8192, R, C); const int Rb = (R & ~31) + perm32(R & 31);
        voffA[i] = (unsigned)(R * K + C) * 2u; voffB[i] = (unsigned)(Rb * K + C) * 2u; }
    const size_t kstep = (size_t)(BK * 2);
    const size_t hstep = (size_t)HALF * K * 2;
    const size_t tstep = 2 * hstep;
    const unsigned ldsw = (unsigned)wid * 1024u;
    const int aoff = lds_byte(wr * 64 + fr, fq * 8), boff = lds_byte(wc * 32 + fr, fq * 8);
#define PG8_SA(b, h) (((b) * 2 + (h)) * HTB)
#define PG8_SB(b, h) ((4 + (b) * 2 + (h)) * HTB)
#define PG8_STAGE(bufoff, gbase, voff) do { _Pragma("unroll") for (int _i = 0; _i < 2; ++_i) \
        __builtin_amdgcn_global_load_lds((const unsigned*)((const char*)(gbase) + (voff)[_i]), (LAS unsigned*)(lds + (bufoff) + ldsw + _i * 8192), 16, 0, 0); } while (0)
#define PG8_LDA(dst, b, h) do { _Pragma("unroll") for (int m = 0; m < 4; ++m) _Pragma("unroll") for (int k = 0; k < 2; ++k) dst[m][k] = *(const LAS bf16x8*)(lds + PG8_SA(b, h) + aoff + m * 2048 + k * 1024); } while (0)
#define PG8_LDB(dst, b, h) do { _Pragma("unroll") for (int n = 0; n < 2; ++n) _Pragma("unroll") for (int k = 0; k < 2; ++k) dst[n][k] = *(const LAS bf16x8*)(lds + PG8_SB(b, h) + boff + n * 2048 + k * 1024); } while (0)
#define PG8_MMA(ai, bj, At, Bt) do { __builtin_amdgcn_s_setprio(1); _Pragma("unroll") for (int m = 0; m < 4; ++m) _Pragma("unroll") for (int n = 0; n < 2; ++n) _Pragma("unroll") for (int k = 0; k < 2; ++k) \
        acc[ai][bj][m][n] = __builtin_amdgcn_mfma_f32_16x16x32_bf16(Bt[n][k], At[m][k], acc[ai][bj][m][n], 0, 0, 0); __builtin_amdgcn_s_setprio(0); } while (0)
#define PG8_WAIT_V(n) asm volatile("s_waitcnt vmcnt(" #n ")" ::: "memory")
#define PG8_WAIT_L(n) asm volatile("s_waitcnt lgkmcnt(" #n ")" ::: "memory")
#define PG8_BAR __builtin_amdgcn_s_barrier()
#define PG8_SCHED __builtin_amdgcn_sched_barrier(0)
#define PG8_APTR(u) ((const char*)((u).br == 0 ? g.A0 : ((u).br == 1 ? g.A1 : g.A2)) + (size_t)(u).pm * tstep)
#define PG8_BPTR(u) ((const char*)((u).br == 0 ? g.B0 : ((u).br == 1 ? g.B1 : g.B2)) + (size_t)(u).pn * tstep)
    Unit cur, nxt; int ui = 0;
    if (!S.next(0, cur)) return;
    f32x4 acc[2][2][4][2];
#pragma unroll
    for (int a = 0; a < 2; ++a)
#pragma unroll
        for (int b = 0; b < 2; ++b)
#pragma unroll
            for (int m = 0; m < 4; ++m)
#pragma unroll
                for (int n = 0; n < 2; ++n) acc[a][b][m][n] = (f32x4){0.f, 0.f, 0.f, 0.f};
    bf16x8 At[4][2], B0[2][2], B1[2][2];
    const char* cA = PG8_APTR(cur); const char* cB = PG8_BPTR(cur);
    PG8_STAGE(PG8_SB(0, 0), cB, voffB); PG8_STAGE(PG8_SB(0, 1), cB + hstep, voffB); PG8_STAGE(PG8_SA(0, 0), cA, voffA); PG8_STAGE(PG8_SA(0, 1), cA + hstep, voffA);
    if (wr == 1) PG8_BAR;
    PG8_WAIT_V(2); PG8_BAR;
    PG8_STAGE(PG8_SB(1, 0), cB + kstep, voffB); PG8_STAGE(PG8_SA(1, 0), cA + kstep, voffA); PG8_STAGE(PG8_SB(1, 1), cB + hstep + kstep, voffB);
    PG8_WAIT_V(6); PG8_BAR;
    for (;;) {
        const bool has_next = S.next(ui + 1, nxt);
        const char* nA = has_next ? PG8_APTR(nxt) : cA; const char* nB = has_next ? PG8_BPTR(nxt) : cB;
        for (int t = 0; t < nt; t += 2) {
            const bool last = (t == nt - 2);
            const char* a1 = cA + (size_t)(t + 1) * kstep;
            const char* a2 = last ? nA : cA + (size_t)(t + 2) * kstep; const char* b2 = last ? nB : cB + (size_t)(t + 2) * kstep;
            const char* a3 = a2 + kstep; const char* b3 = b2 + kstep;
            PG8_LDB(B0, 0, 0); PG8_LDB(B1, 0, 1); PG8_SCHED; PG8_LDA(At, 0, 0); PG8_STAGE(PG8_SA(1, 1), a1 + hstep, voffA);
            PG8_WAIT_V(8); PG8_WAIT_L(0); PG8_BAR; PG8_MMA(0, 0, At, B0); PG8_MMA(0, 1, At, B1); PG8_BAR; PG8_SCHED;
            PG8_LDA(At, 0, 1); PG8_STAGE(PG8_SB(0, 0), b2, voffB); PG8_STAGE(PG8_SB(0, 1), b2 + hstep, voffB); PG8_STAGE(PG8_SA(0, 0), a2, voffA);
            PG8_WAIT_V(8); PG8_WAIT_L(0); PG8_BAR; PG8_MMA(1, 0, At, B0); PG8_MMA(1, 1, At, B1); PG8_BAR; PG8_SCHED;
            PG8_LDB(B0, 1, 0); PG8_LDB(B1, 1, 1); PG8_SCHED; PG8_LDA(At, 1, 0); PG8_STAGE(PG8_SA(0, 1), a2 + hstep, voffA);
            PG8_WAIT_V(8); PG8_WAIT_L(0); PG8_BAR; PG8_MMA(0, 0, At, B0); PG8_MMA(0, 1, At, B1); PG8_BAR; PG8_SCHED;
            PG8_LDA(At, 1, 1); PG8_STAGE(PG8_SB(1, 0), b3, voffB); PG8_STAGE(PG8_SB(1, 1), b3 + hstep, voffB); PG8_STAGE(PG8_SA(1, 0), a3, voffA);
            PG8_WAIT_V(8); PG8_WAIT_L(0); PG8_BAR; PG8_MMA(1, 0, At, B0); PG8_MMA(1, 1, At, B1); PG8_BAR; PG8_SCHED;
        }
        if (wr == 0) PG8_BAR;
        E(acc, cur, wr, wc, fr, fq);
        if (!has_next) break;
#pragma unroll
        for (int a = 0; a < 2; ++a)
#pragma unroll
            for (int b = 0; b < 2; ++b)
#pragma unroll
                for (int m = 0; m < 4; ++m)
#pragma unroll
                    for (int n = 0; n < 2; ++n) acc[a][b][m][n] = (f32x4){0.f, 0.f, 0.f, 0.f};
        cur = nxt; cA = nA; cB = nB; ++ui;
        if (wr == 1) PG8_BAR;
    }
    PG8_WAIT_V(0);
    PG8_BAR;
#undef PG8_SA
#undef PG8_SB
#undef PG8_STAGE
#undef PG8_LDA
#undef PG8_LDB
#undef PG8_MMA
#undef PG8_WAIT_V
#undef PG8_WAIT_L
#undef PG8_BAR
#undef PG8_SCHED
#undef PG8_APTR
#undef PG8_BPTR
}

struct Epi1 {
    bf16_t* P; float* AB;
    __device__ __forceinline__ void operator()(const f32x4 (&acc)[2][2][4][2], const Unit& u, int wr, int wc, int fr, int fq) const {
        const int row0 = u.pm * BM + wr * 64 + fr, col0 = u.pn * BM + wc * 32 + 8 * fq;
#pragma unroll
        for (int ai = 0; ai < 2; ++ai)
#pragma unroll
            for (int m = 0; m < 4; ++m) { bf16_t* rowp = P + (size_t)(row0 + ai * HALF + m * 16) * NP + col0;
#pragma unroll
                for (int bj = 0; bj < 2; ++bj) { const f32x4 v0 = acc[ai][bj][m][0], v1 = acc[ai][bj][m][1];
                    u32x4 w; w.x = pk2(v0[0], v0[1]); w.y = pk2(v0[2], v0[3]); w.z = pk2(v1[0], v1[1]); w.w = pk2(v1[2], v1[3]);
                    *(u32x4*)(rowp + bj * HALF) = w; } }
        if (u.pn == 60 && wc == 0 && fq < 2) {
#pragma unroll
            for (int ai = 0; ai < 2; ++ai)
#pragma unroll
                for (int m = 0; m < 4; ++m) { float* ab = AB + (size_t)(row0 + ai * HALF + m * 16) * 16 + 8 * fq;
                    *(f32x4*)ab = acc[ai][0][m][0]; *(f32x4*)(ab + 4) = acc[ai][0][m][1]; }
        }
    }
};
struct Epi2 {
    const bf16_t* Zb; const bf16_t* P; const float* bglu; bf16_t* YA;
    __device__ __forceinline__ void operator()(const f32x4 (&acc)[2][2][4][2], const Unit& u, int wr, int wc, int fr, int fq) const {
        const int row0 = u.pm * BM + wr * 64 + fr, col0 = u.pn * BM + wc * 32 + 8 * fq;
#pragma unroll
        for (int bj = 0; bj < 2; ++bj) { const int col = col0 + bj * HALF;
            const f32x4 b0 = *(const f32x4*)(bglu + col), b1 = *(const f32x4*)(bglu + col + 4);
#pragma unroll
            for (int ai = 0; ai < 2; ++ai)
#pragma unroll
                for (int m = 0; m < 4; ++m) { const size_t row = (size_t)(row0 + ai * HALF + m * 16);
                    float z[8], ga[8], o[8];
                    unpack8(*(const u32x4*)(Zb + row * 1024 + col), z); unpack8(*(const u32x4*)(P + row * NP + C_GA + col), ga);
                    const f32x4 v0 = acc[ai][bj][m][0] + b0, v1 = acc[ai][bj][m][1] + b1;
#pragma unroll
                    for (int e = 0; e < 4; ++e) { o[e] = z[e] * sigm(v0[e]) * silu(ga[e]); o[4 + e] = z[4 + e] * sigm(v1[e]) * silu(ga[4 + e]); }
                    *(u32x4*)(YA + row * 1024 + col) = pack8(o); } }
    }
};
struct Epi3 {
    const bf16_t* P; const float* bgate; float* M32; bf16_t* Mb;
    __device__ __forceinline__ void operator()(const f32x4 (&acc)[2][2][4][2], const Unit& u, int wr, int wc, int fr, int fq) const {
        const int row0 = u.pm * BM + wr * 64 + fr, col0 = u.pn * BM + wc * 32 + 8 * fq, br = u.br;
#pragma unroll
        for (int bj = 0; bj < 2; ++bj) { const int col = col0 + bj * HALF;
            const f32x4 g0 = *(const f32x4*)(bgate + br * DM + col), g1 = *(const f32x4*)(bgate + br * DM + col + 4);
#pragma unroll
            for (int ai = 0; ai < 2; ++ai)
#pragma unroll
                for (int m = 0; m < 4; ++m) { const size_t row = (size_t)(row0 + ai * HALF + m * 16);
                    float zg[8], o[8];
                    unpack8(*(const u32x4*)(P + row * NP + C_ZG + br * DM + col), zg);
                    const f32x4 a0 = acc[ai][bj][m][0], a1 = acc[ai][bj][m][1];
#pragma unroll
                    for (int e = 0; e < 4; ++e) { o[e] = sigm(zg[e] + g0[e]) * a0[e]; o[4 + e] = sigm(zg[4 + e] + g1[e]) * a1[e]; }
                    float* mp = M32 + row * DM + col;
                    if (br > 0) { const f32x4 p0 = *(const f32x4*)mp, p1 = *(const f32x4*)(mp + 4);
#pragma unroll
                        for (int e = 0; e < 4; ++e) { o[e] += p0[e]; o[4 + e] += p1[e]; } }
                    if (br < 2) { *(f32x4*)mp = (f32x4){o[0], o[1], o[2], o[3]}; *(f32x4*)(mp + 4) = (f32x4){o[4], o[5], o[6], o[7]}; }
                    else *(u32x4*)(Mb + row * DM + col) = pack8(o); } }
    }
};
struct Epi4 {
    const float* xp; const float* xs; float* H32;
    __device__ __forceinline__ void operator()(const f32x4 (&acc)[2][2][4][2], const Unit& u, int wr, int wc, int fr, int fq) const {
        const int row0 = u.pm * BM + wr * 64 + fr, col0 = u.pn * BM + wc * 32 + 8 * fq;
        const float* xb = (u.pm < 32) ? xp : (xs - (size_t)TP * DM);
#pragma unroll
        for (int ai = 0; ai < 2; ++ai)
#pragma unroll
            for (int m = 0; m < 4; ++m) { const size_t row = (size_t)(row0 + ai * HALF + m * 16);
#pragma unroll
                for (int bj = 0; bj < 2; ++bj) { const int col = col0 + bj * HALF;
                    const f32x4 x0 = *(const f32x4*)(xb + row * DM + col), x1 = *(const f32x4*)(xb + row * DM + col + 4);
                    *(f32x4*)(H32 + row * DM + col) = x0 * ALPHA + acc[ai][bj][m][0];
                    *(f32x4*)(H32 + row * DM + col + 4) = x1 * ALPHA + acc[ai][bj][m][1]; } }
    }
};
}

template <bool REMAP>
__device__ __forceinline__ void transpose_item(const float* W, int K, int Nsrc, int Ndst, bf16_t* WT, LAS float* scr, int item, int lane) {
    const int nblk = Ndst / 32, kb = item / nblk, nb = item % nblk, k0 = 64 * kb, n0 = 32 * nb;
    int d = n0 + (lane & 31), s = d; bool valid = true;
    if (REMAP) { if (d < C_GATEC) s = d; else if (d < C_AB) s = d + 16; else if (d < C_AB + 16) s = 8192 + (d - C_AB); else { s = 0; valid = false; } }
#pragma unroll 8
    for (int i = 0; i < 32; ++i) { const int kk = 2 * i + (lane >> 5); scr[kk * 33 + (lane & 31)] = valid ? W[(size_t)(k0 + kk) * Nsrc + s] : 0.f; }
    LDS_WAIT();
    const int c = lane & 7;
#pragma unroll
    for (int j = 0; j < 4; ++j) { const int n = (lane >> 3) + 8 * j; const LAS float* sp = scr + (8 * c) * 33 + n;
        u32x4 o; o.x = pk2(sp[0 * 33], sp[1 * 33]); o.y = pk2(sp[2 * 33], sp[3 * 33]); o.z = pk2(sp[4 * 33], sp[5 * 33]); o.w = pk2(sp[6 * 33], sp[7 * 33]);
        *(u32x4*)(WT + (size_t)(n0 + n) * K + k0 + 8 * c) = o; }
    LDS_WAIT();
}

__device__ __forceinline__ void phase_convert(CArgs& a, LAS unsigned char* lds, int G, int vb, const int tid) {
    const int lane = tid & 63, wave = tid >> 6;
    LAS float* scr = (LAS float*)(lds + wave * 16384);
    const int gw = vb * 8 + wave, NGW = G * 8;
    constexpr int I_IN = (DM / 64) * (NP / 32), I_GLU = (1024 / 64) * (1024 / 32), I_P = (1024 / 64) * (DM / 32), I_OUT = (DM / 64) * (DM / 32);
    constexpr int I_L = I_IN + I_GLU + 3 * I_P + I_OUT;
    for (int it = gw; it < 2 * I_L; it += NGW) {
        const int l = it / I_L; int r = it - l * I_L;
        unsigned char* wb = a.ws + WS_W0 + (size_t)l * WS_WL;
        if (r < I_IN) { transpose_item<true>(a.in[6] + (size_t)l * DM * NIN, DM, NIN, NP, (bf16_t*)(wb + WO_IN), scr, r, lane); continue; } r -= I_IN;
        if (r < I_GLU) { transpose_item<false>(a.in[16] + (size_t)l * 1024 * 1024, 1024, 1024, 1024, (bf16_t*)(wb + WO_GLU), scr, r, lane); continue; } r -= I_GLU;
        if (r < I_P) { transpose_item<false>(a.in[18] + (size_t)l * 1024 * DM, 1024, DM, DM, (bf16_t*)(wb + WO_PA), scr, r, lane); continue; } r -= I_P;
        if (r < I_P) { transpose_item<false>(a.in[23] + (size_t)l * 1024 * DM, 1024, DM, DM, (bf16_t*)(wb + WO_PB), scr, r, lane); continue; } r -= I_P;
        if (r < I_P) { transpose_item<false>(a.in[28] + (size_t)l * 1024 * DM, 1024, DM, DM, (bf16_t*)(wb + WO_PC), scr, r, lane); continue; } r -= I_P;
        transpose_item<false>(a.in[29] + (size_t)l * DM * DM, DM, DM, DM, (bf16_t*)(wb + WO_OUT), scr, r, lane);
    }
    bf16_t* Xb = (bf16_t*)(a.ws + WS_XB);
    for (int m = gw; m < MT; m += NGW) {
        const float* xr = (m < TP) ? a.in[0] + (size_t)m * DM : a.in[1] + (size_t)(m - TP) * DM;
        const f32x4* xv = (const f32x4*)xr + lane; u32x2* o = (u32x2*)(Xb + (size_t)m * DM) + lane;
#pragma unroll
        for (int j = 0; j < 8; ++j) { const f32x4 v = xv[64 * j]; u32x2 w; w.x = pk2(v.x, v.y); w.y = pk2(v.z, v.w); o[64 * j] = w; }
    }
}

__device__ __forceinline__ void phase_ln(CArgs& a, int layer, int G, int vb, const int tid) {
    const int lane = tid & 63, wave = tid >> 6;
    const int gw = vb * 8 + wave, NGW = G * 8;
    const float* H32 = (const float*)(a.ws + WS_H32);
    const float* lg = a.in[30] + layer * DM; const float* lb = a.in[31] + layer * DM;
    bf16_t* Xb = (bf16_t*)(a.ws + WS_XB);
    for (int m = gw; m < MT; m += NGW) {
        const f32x4* xv = (const f32x4*)(H32 + (size_t)m * DM) + lane;
        f32x4 v[8]; float s = 0.f;
#pragma unroll
        for (int j = 0; j < 8; ++j) { v[j] = xv[64 * j]; s += (v[j].x + v[j].y) + (v[j].z + v[j].w); }
        const float mean = wave_sum(s) * (1.f / DM); float s2 = 0.f;
#pragma unroll
        for (int j = 0; j < 8; ++j) { v[j] = v[j] - mean; s2 += (v[j].x * v[j].x + v[j].y * v[j].y) + (v[j].z * v[j].z + v[j].w * v[j].w); }
        const float rstd = 1.f / sqrtf(wave_sum(s2) * (1.f / DM) + 1e-5f);
        float* dst = (layer == 0) ? (float*)(a.ws + WS_X32) + (size_t)m * DM : (m < TP ? a.out + O_YP + (size_t)m * DM : a.out + O_YS + (size_t)(m - TP) * DM);
#pragma unroll
        for (int j = 0; j < 8; ++j) { const f32x4 gg = *((const f32x4*)lg + lane + 64 * j), bb = *((const f32x4*)lb + lane + 64 * j);
            const f32x4 y = v[j] * rstd * gg + bb; *((f32x4*)dst + lane + 64 * j) = y;
            if (layer == 0) { u32x2 w; w.x = pk2(y.x, y.y); w.y = pk2(y.z, y.w); *((u32x2*)(Xb + (size_t)m * DM) + lane + 64 * j) = w; } }
    }
}

constexpr int S5_BUS = 128;
constexpr int S5_SROW = 272;
constexpr int S5_WLDS = 32 * S5_BUS * 4 + 32 * S5_SROW;
template <bool SAMPLE>
__device__ __forceinline__ void s5_item(int layer, int item, int wlo, int lane) {
    CArgs& a = kargs(); LAS unsigned char* wl = lds_base() + wlo;
    const int g = SAMPLE ? item : (item & 63), b = SAMPLE ? 0 : (item >> 6);
    const float* lam_re = a.in[8] + layer * 4096 + g * 64; const float* lam_im = a.in[9] + layer * 4096 + g * 64;
    const float dt = expf(a.in[10][layer * 64 + g]);
    const float* b_re = a.in[11] + (size_t)(layer * 64 + g) * 1024; const float* b_im = a.in[12] + (size_t)(layer * 64 + g) * 1024;
    const float* c_re = a.in[13] + (size_t)(layer * 64 + g) * 1024; const float* c_im = a.in[14] + (size_t)(layer * 64 + g) * 1024;
    const float dch = a.in[15][layer * 1024 + g * 16 + (lane & 15)];
    const bf16_t* P = (const bf16_t*)(a.ws + WS_P); bf16_t* Zb = (bf16_t*)(a.ws + WS_ZB);
    LAS float* BU = (LAS float*)wl; LAS unsigned char* Sb = wl + 32 * S5_BUS * 4;
    float ar, ai;
    { const float lr = lam_re[lane], li = lam_im[lane]; const float mag = expf(lr * dt); float sn, cs; sincosf(li * dt, &sn, &cs); ar = mag * cs; ai = mag * sn; }
    bf16x8 Bf[4];
    { const int h = lane >> 5;
#pragma unroll
      for (int q = 0; q < 2; ++q) { const int pp = q * 32 + (lane & 31);
        const float lr = lam_re[pp], li = lam_im[pp]; const float mag = expf(lr * dt); float sn, cs; sincosf(li * dt, &sn, &cs);
        const float abr = mag * cs, abi = mag * sn, den = lr * lr + li * li, nr = abr - 1.f, ni = abi;
        const float f_r = (nr * lr + ni * li) / den, f_i = (ni * lr - nr * li) / den;
        float br8[8], bi8[8], or8[8], oi8[8];
        *(f32x4*)&br8[0] = *(const f32x4*)(b_re + pp * 16 + 8 * h); *(f32x4*)&br8[4] = *(const f32x4*)(b_re + pp * 16 + 8 * h + 4);
        *(f32x4*)&bi8[0] = *(const f32x4*)(b_im + pp * 16 + 8 * h); *(f32x4*)&bi8[4] = *(const f32x4*)(b_im + pp * 16 + 8 * h + 4);
#pragma unroll
        for (int e = 0; e < 8; ++e) { or8[e] = f_r * br8[e] - f_i * bi8[e]; oi8[e] = f_r * bi8[e] + f_i * br8[e]; }
        Bf[q] = __builtin_bit_cast(bf16x8, pack8(or8)); Bf[2 + q] = __builtin_bit_cast(bf16x8, pack8(oi8)); } }
    bf16x8 Cf[4];
    { const int c = lane & 15;
#pragma unroll
      for (int ks = 0; ks < 4; ++ks) { const int p0 = 16 * ks + 4 * (lane >> 4);
        const f32x4 cr = *(const f32x4*)(c_re + c * 64 + p0), ci = *(const f32x4*)(c_im + c * 64 + p0);
        float o[8] = {cr[0], -ci[0], cr[1], -ci[1], cr[2], -ci[2], cr[3], -ci[3]};
        Cf[ks] = __builtin_bit_cast(bf16x8, pack8(o)); } }
    float sr = 0.f, si = 0.f;
    const int nsc = SAMPLE ? 16 : 64;
    const float* h_re = a.in[2] + (size_t)layer * 128 * 4096 + g * 64 + lane; const float* h_im = a.in[3] + (size_t)layer * 128 * 4096 + g * 64 + lane;
    float* o_re = a.out + O_SRS + (size_t)layer * 128 * 4096 + g * 64 + lane; float* o_im = a.out + O_SIS + (size_t)layer * 128 * 4096 + g * 64 + lane;
    for (int sc = 0; sc < nsc; ++sc) {
        const int row0 = SAMPLE ? TP + sc * 32 : b * 2048 + sc * 32;
        const bf16x8 Af = *(const bf16x8*)(P + (size_t)(row0 + (lane & 31)) * NP + C_XA + g * 16 + 8 * (lane >> 5));
#pragma unroll
        for (int nb = 0; nb < 4; ++nb) {
            f32x16 acc;
#pragma unroll
            for (int r = 0; r < 16; ++r) acc[r] = 0.f;
            acc = __builtin_amdgcn_mfma_f32_32x32x16_bf16(Af, Bf[nb], acc, 0, 0, 0);
#pragma unroll
            for (int r = 0; r < 16; ++r) { const int t = (r & 3) + 8 * (r >> 2) + 4 * (lane >> 5); BU[t * S5_BUS + 32 * nb + (lane & 31)] = acc[r]; }
        }
        LDS_WAIT();
#pragma unroll 4
        for (int t = 0; t < 32; ++t) {
            if (SAMPLE && (t & 3) == 0) { const int bi = sc * 8 + (t >> 2); sr = h_re[(size_t)bi * 4096]; si = h_im[(size_t)bi * 4096]; }
            const float bur = BU[t * S5_BUS + lane], bui = BU[t * S5_BUS + 64 + lane];
            const float nsr = ar * sr - ai * si + bur, nsi = ar * si + ai * sr + bui;
            sr = nsr; si = nsi;
            *(LAS unsigned*)(Sb + t * S5_SROW + 4 * lane) = pk2(sr, si);
            if (SAMPLE && (t & 3) == 3) { const int bi = sc * 8 + (t >> 2); o_re[(size_t)bi * 4096] = sr; o_im[(size_t)bi * 4096] = si; }
        }
        LDS_WAIT();
#pragma unroll
        for (int mb = 0; mb < 2; ++mb) {
            f32x4 y = (f32x4){0.f, 0.f, 0.f, 0.f};
#pragma unroll
            for (int ks = 0; ks < 4; ++ks) { const bf16x8 Sf = *(const LAS bf16x8*)(Sb + (16 * mb + (lane & 15)) * S5_SROW + 64 * ks + 16 * (lane >> 4));
                y = __builtin_amdgcn_mfma_f32_16x16x32_bf16(Sf, Cf[ks], y, 0, 0, 0); }
#pragma unroll
            for (int r = 0; r < 4; ++r) { const size_t row = (size_t)(row0 + 16 * mb + 4 * (lane >> 4) + r);
                const float xa = bf2f(P[row * NP + C_XA + g * 16 + (lane & 15)]);
                Zb[row * 1024 + g * 16 + (lane & 15)] = (bf16_t)f2bf(gelu_tanh(y[r] + dch * xa)); }
        }
        LDS_WAIT();
    }
    if (!SAMPLE) { a.out[O_SRP + (size_t)((layer * 4 + b) * 64 + g) * 64 + lane] = sr; a.out[O_SIP + (size_t)((layer * 4 + b) * 64 + g) * 64 + lane] = si; }
}

constexpr int GM_TROW = 80;
__device__ __forceinline__ void gmlp_prompt_item(int layer, int item, const int tid) {
    CArgs& a = kargs(); LAS unsigned char* lds = lds_base();
    const int lane = tid & 63, w = tid >> 6;
    const bf16_t* P = (const bf16_t*)(a.ws + WS_P); bf16_t* YB = (bf16_t*)(a.ws + WS_YB);
    const float* lng = a.in[19] + layer * 1024; const float* lnb = a.in[20] + layer * 1024;
    const int r0 = item * 128;
    LAS f32x2* stats = (LAS f32x2*)lds;
    LAS unsigned char* vt = lds + 1024 + w * (32 * GM_TROW);
    __syncthreads();
    for (int i = 0; i < 16; ++i) { const int t = 16 * w + i; const bf16_t* rp = P + (size_t)(r0 + t) * NP + C_VB + lane * 16;
        float x[16]; { float t8[8]; unpack8(*(const u32x4*)rp, t8);
#pragma unroll
            for (int e = 0; e < 8; ++e) x[e] = t8[e];
            unpack8(*(const u32x4*)(rp + 8), t8);
#pragma unroll
            for (int e = 0; e < 8; ++e) x[8 + e] = t8[e]; }
        float s = 0.f;
#pragma unroll
        for (int e = 0; e < 16; ++e) s += x[e];
        const float mean = wave_sum(s) * (1.f / 1024.f); float s2 = 0.f;
#pragma unroll
        for (int e = 0; e < 16; ++e) { const float d = x[e] - mean; s2 += d * d; }
        const float rstd = 1.f / sqrtf(wave_sum(s2) * (1.f / 1024.f) + 1e-5f);
        if (lane == 0) stats[t] = (f32x2){mean, rstd}; }
    __syncthreads();
    for (int rnd = 0; rnd < 4; ++rnd) {
        const int wi = rnd * 8 + w, g = wi >> 2, cbase = g * 128 + (wi & 3) * 32;
        const float* Ws = a.in[21] + (size_t)(layer * 8 + g) * 128 * 128;
        f32x4 acc[2][8];
#pragma unroll
        for (int cb = 0; cb < 2; ++cb)
#pragma unroll
            for (int ib = 0; ib < 8; ++ib) acc[cb][ib] = (f32x4){0.f, 0.f, 0.f, 0.f};
#pragma unroll 1
        for (int kb = 0; kb < 4; ++kb) {
#pragma unroll 1
            for (int q = 0; q < 2; ++q) { const int j = (lane >> 2) + 16 * q, cg = lane & 3;
                float x[8]; unpack8(*(const u32x4*)(P + (size_t)(r0 + 32 * kb + j) * NP + C_VB + cbase + cg * 8), x);
                const f32x2 st = stats[32 * kb + j];
                const f32x4 g0 = *(const f32x4*)(lng + cbase + cg * 8), g1 = *(const f32x4*)(lng + cbase + cg * 8 + 4);
                const f32x4 b0 = *(const f32x4*)(lnb + cbase + cg * 8), b1 = *(const f32x4*)(lnb + cbase + cg * 8 + 4);
#pragma unroll
                for (int e = 0; e < 8; ++e) { const float gg = e < 4 ? g0[e & 3] : g1[e & 3], bb = e < 4 ? b0[e & 3] : b1[e & 3];
                    const float v = (x[e] - st.x) * st.y * gg + bb;
                    *(LAS bf16_t*)(vt + (cg * 8 + e) * GM_TROW + 2 * j) = (bf16_t)f2bf(v); } }
            LDS_WAIT();
            bf16x8 Af[2];
#pragma unroll
            for (int cb = 0; cb < 2; ++cb) Af[cb] = *(const LAS bf16x8*)(vt + (16 * cb + (lane & 15)) * GM_TROW + 16 * (lane >> 4));
#pragma unroll
            for (int ib = 0; ib < 8; ++ib) {
                if (ib >= 2 * kb) {
                    const int i = 16 * ib + (lane & 15), j0 = 32 * kb + 8 * (lane >> 4);
                    const f32x4 w0 = *(const f32x4*)(Ws + i * 128 + j0), w1 = *(const f32x4*)(Ws + i * 128 + j0 + 4);
                    float wv[8];
#pragma unroll
                    for (int e = 0; e < 8; ++e) { const float x = e < 4 ? w0[e & 3] : w1[e & 3]; wv[e] = (j0 + e <= i) ? x : 0.f; }
                    const bf16x8 Bw = __builtin_bit_cast(bf16x8, pack8(wv));
#pragma unroll
                    for (int cb = 0; cb < 2; ++cb) acc[cb][ib] = __builtin_amdgcn_mfma_f32_16x16x32_bf16(Af[cb], Bw, acc[cb][ib], 0, 0, 0);
                }
            }
            LDS_WAIT();
        }
        const float* bsp = a.in[22] + (size_t)(layer * 8 + g) * 128;
#pragma unroll
        for (int ib = 0; ib < 8; ++ib) { const int i = 16 * ib + (lane & 15); const float bs = bsp[i]; const size_t row = (size_t)(r0 + i);
#pragma unroll
            for (int cb = 0; cb < 2; ++cb) { const int ch = cbase + 16 * cb + 4 * (lane >> 4);
                const u32x2 uw = *(const u32x2*)(P + row * NP + C_UB + ch), gw = *(const u32x2*)(P + row * NP + C_GB + ch);
                const f32x4 s = acc[cb][ib] + bs;
                u32x2 o; o.x = pk2(bflo(uw.x) * s[0] * silu(bflo(gw.x)), bfhi(uw.x) * s[1] * silu(bfhi(gw.x)));
                o.y = pk2(bflo(uw.y) * s[2] * silu(bflo(gw.y)), bfhi(uw.y) * s[3] * silu(bfhi(gw.y)));
                *(u32x2*)(YB + row * 1024 + ch) = o; } }
    }
}
__device__ __forceinline__ void gmlp_sample_item(int layer, int b, int lane) {
    CArgs& a = kargs();
    const bf16_t* P = (const bf16_t*)(a.ws + WS_P); bf16_t* YB = (bf16_t*)(a.ws + WS_YB);
    const float* lng = a.in[19] + layer * 1024 + lane * 16; const float* lnb = a.in[20] + layer * 1024 + lane * 16;
    const int g = lane >> 3;
    const float* Ws = a.in[21] + (size_t)(layer * 8 + g) * 128 * 128; const float* bsp = a.in[22] + (size_t)(layer * 8 + g) * 128;
    float vn[4][16];
#pragma unroll
    for (int t = 0; t < 4; ++t) { const size_t row = (size_t)(TP + b * 4 + t); const bf16_t* rp = P + row * NP + C_VB + lane * 16;
        float x[16]; { float t8[8]; unpack8(*(const u32x4*)rp, t8);
#pragma unroll
            for (int e = 0; e < 8; ++e) x[e] = t8[e];
            unpack8(*(const u32x4*)(rp + 8), t8);
#pragma unroll
            for (int e = 0; e < 8; ++e) x[8 + e] = t8[e]; }
        float s = 0.f;
#pragma unroll
        for (int e = 0; e < 16; ++e) s += x[e];
        const float mean = wave_sum(s) * (1.f / 1024.f); float s2 = 0.f;
#pragma unroll
        for (int e = 0; e < 16; ++e) { const float d = x[e] - mean; s2 += d * d; }
        const float rstd = 1.f / sqrtf(wave_sum(s2) * (1.f / 1024.f) + 1e-5f);
        float* ov = a.out + O_GV + ((size_t)(layer * 128 + b) * 4 + t) * 1024 + lane * 16;
#pragma unroll
        for (int e = 0; e < 16; ++e) vn[t][e] = (x[e] - mean) * rstd * lng[e] + lnb[e];
#pragma unroll
        for (int e = 0; e < 16; e += 4) *(f32x4*)(ov + e) = (f32x4){vn[t][e], vn[t][e + 1], vn[t][e + 2], vn[t][e + 3]}; }
#pragma unroll
    for (int i = 0; i < 4; ++i) { const size_t row = (size_t)(TP + b * 4 + i);
        float s[16]; const float bs = bsp[i];
#pragma unroll
        for (int e = 0; e < 16; ++e) s[e] = bs;
#pragma unroll
        for (int j = 0; j < 4; ++j) if (j <= i) { const float wv = Ws[i * 128 + j];
#pragma unroll
            for (int e = 0; e < 16; ++e) s[e] += wv * vn[j][e]; }
        float ub[16], gb[16];
        { float t8[8]; unpack8(*(const u32x4*)(P + row * NP + C_UB + lane * 16), t8);
#pragma unroll
          for (int e = 0; e < 8; ++e) ub[e] = t8[e];
          unpack8(*(const u32x4*)(P + row * NP + C_UB + lane * 16 + 8), t8);
#pragma unroll
          for (int e = 0; e < 8; ++e) ub[8 + e] = t8[e];
          unpack8(*(const u32x4*)(P + row * NP + C_GB + lane * 16), t8);
#pragma unroll
          for (int e = 0; e < 8; ++e) gb[e] = t8[e];
          unpack8(*(const u32x4*)(P + row * NP + C_GB + lane * 16 + 8), t8);
#pragma unroll
          for (int e = 0; e < 8; ++e) gb[8 + e] = t8[e]; }
        float o0[8], o1[8];
#pragma unroll
        for (int e = 0; e < 8; ++e) { o0[e] = ub[e] * s[e] * silu(gb[e]); o1[e] = ub[8 + e] * s[8 + e] * silu(gb[8 + e]); }
        *(u32x4*)(YB + row * 1024 + lane * 16) = pack8(o0); *(u32x4*)(YB + row * 1024 + lane * 16 + 8) = pack8(o1); }
}

template <bool SAMPLE>
__device__ __forceinline__ void gdn_item_v1(int layer, int item, const int tid) {
    CArgs& a = kargs(); LAS unsigned char* lds = lds_base();
    const int lane = tid & 63, w = tid >> 6;
    const int b = item >> 3, h = item & 7;
    const int T = SAMPLE ? 4 : 2048, rbase = SAMPLE ? TP + b * 4 : b * 2048, NB = SAMPLE ? 128 : 4;
    const bf16_t* P = (const bf16_t*)(a.ws + WS_P); const float* AB = (const float*)(a.ws + WS_AB); bf16_t* YC = (bf16_t*)(a.ws + WS_YC);
    const float* convw = a.in[24] + (size_t)layer * 4 * 3072;
    const float* sconv = a.in[5] + (size_t)(layer * 128 + b) * 3 * 3072;
    LAS float* qs = (LAS float*)lds; LAS float* ks = qs + 64 * 128; LAS float* vs = ks + 64 * 128;
    LAS float* red = vs + 64 * 128; LAS float* red2 = red + 512; LAS float* av = red2 + 512; LAS float* bv = av + 64;
    const int dv = (w & 1) * 64 + lane, sl = w >> 1, dk0 = sl * 32;
    float S[32];
    if (SAMPLE) { const float* s0 = a.in[4] + ((size_t)((layer * 128 + b) * 8 + h) * 128 + dk0) * 128 + dv;
#pragma unroll
        for (int i = 0; i < 32; ++i) S[i] = s0[(size_t)i * 128]; }
    else {
#pragma unroll
        for (int i = 0; i < 32; ++i) S[i] = 0.f; }
    const float Aexp = expf(a.in[25][layer * 8 + h]), dtb = a.in[26][layer * 8 + h];
    for (int c0 = 0; c0 < T; c0 += 64) {
        const int n = (T - c0) < 64 ? (T - c0) : 64;
        __syncthreads();
        for (int idx = tid; idx < n * 384; idx += 512) {
            const int t = idx / 384, ch = idx - t * 384, sec = ch >> 7, cc = ch & 127, col = sec * 1024 + h * 128 + cc, tg = c0 + t;
            float accv = 0.f;
#pragma unroll
            for (int j = 0; j < 4; ++j) { const int tt = tg - 3 + j; float x;
                if (tt >= 0) x = bf2f(P[(size_t)(rbase + tt) * NP + C_QKV + col]);
                else x = SAMPLE ? sconv[(3 + tt) * 3072 + col] : 0.f;
                accv += convw[j * 3072 + col] * x; }
            const float y = silu(accv);
            LAS float* dst = sec == 0 ? qs : (sec == 1 ? ks : vs); dst[t * 128 + cc] = y;
        }
        if (tid < n) { const size_t row = (size_t)(rbase + c0 + tid); const float ac = AB[row * 16 + h], bc = AB[row * 16 + 8 + h];
            const float gg = -Aexp * softplus(ac + dtb); av[tid] = expf(gg); bv[tid] = sigm(bc); }
        __syncthreads();
        for (int t = w; t < n; t += 8) {
            { const float q0 = qs[t * 128 + lane], q1 = qs[t * 128 + 64 + lane]; const float ss = wave_sum(q0 * q0 + q1 * q1);
              const float r = (1.f / sqrtf(ss + 1e-6f)) * 0.08838834764831845f; qs[t * 128 + lane] = q0 * r; qs[t * 128 + 64 + lane] = q1 * r; }
            { const float k0 = ks[t * 128 + lane], k1 = ks[t * 128 + 64 + lane]; const float ss = wave_sum(k0 * k0 + k1 * k1);
              const float r = 1.f / sqrtf(ss + 1e-6f); ks[t * 128 + lane] = k0 * r; ks[t * 128 + 64 + lane] = k1 * r; }
        }
        __syncthreads();
        for (int t = 0; t < n; ++t) {
            const float at = av[t], bt = bv[t];
            float p = 0.f;
#pragma unroll
            for (int i = 0; i < 32; i += 4) { const f32x4 kk = *(const LAS f32x4*)(ks + t * 128 + dk0 + i);
                p += kk[0] * S[i] + kk[1] * S[i + 1] + kk[2] * S[i + 2] + kk[3] * S[i + 3]; }
            red[sl * 128 + dv] = p;
            __syncthreads();
            const float kS = (red[dv] + red[128 + dv]) + (red[256 + dv] + red[384 + dv]);
            const float vnew = bt * (vs[t * 128 + dv] - at * kS);
            float po = 0.f;
#pragma unroll
            for (int i = 0; i < 32; i += 4) { const f32x4 kk = *(const LAS f32x4*)(ks + t * 128 + dk0 + i), qq = *(const LAS f32x4*)(qs + t * 128 + dk0 + i);
#pragma unroll
                for (int e = 0; e < 4; ++e) { S[i + e] = at * S[i + e] + kk[e] * vnew; po += qq[e] * S[i + e]; } }
            red2[sl * 128 + dv] = po;
            __syncthreads();
            if (sl == 0) vs[t * 128 + dv] = (red2[dv] + red2[128 + dv]) + (red2[256 + dv] + red2[384 + dv]);
        }
        __syncthreads();
        const float* ng = a.in[27] + layer * 128;
        for (int t = w; t < n; t += 8) {
            const float o0 = vs[t * 128 + lane], o1 = vs[t * 128 + 64 + lane]; const float ss = wave_sum(o0 * o0 + o1 * o1);
            const float r = 1.f / sqrtf(ss * (1.f / 128.f) + 1e-6f); const size_t row = (size_t)(rbase + c0 + t);
            const float g0 = bf2f(P[row * NP + C_GATEC + h * 128 + lane]), g1 = bf2f(P[row * NP + C_GATEC + h * 128 + 64 + lane]);
            YC[row * 1024 + h * 128 + lane] = (bf16_t)f2bf(o0 * r * ng[lane] * silu(g0));
            YC[row * 1024 + h * 128 + 64 + lane] = (bf16_t)f2bf(o1 * r * ng[64 + lane] * silu(g1));
        }
    }
    { float* so = a.out + (SAMPLE ? O_DS : O_DP) + ((size_t)((layer * NB + b) * 8 + h) * 128 + dk0) * 128 + dv;
#pragma unroll
      for (int i = 0; i < 32; ++i) so[(size_t)i * 128] = S[i]; }
    { float* co = a.out + (SAMPLE ? O_CS : O_CP) + (size_t)(layer * NB + b) * 3 * 3072;
      for (int idx = tid; idx < 3 * 384; idx += 512) { const int r = idx / 384, ch = idx - r * 384, col = (ch >> 7) * 1024 + h * 128 + (ch & 127);
          co[r * 3072 + col] = bf2f(P[(size_t)(rbase + T - 3 + r) * NP + C_QKV + col]); } }
}

__device__ __forceinline__ void phase_mixers(int layer, int G, int bid, int tid0) {
#ifndef PROBE_MIX
#define PROBE_MIX -1
#endif
#define PM(x) (PROBE_MIX == -1 || PROBE_MIX == (x))
    if (bid < 32) { const int tid = launder_v(tid0); if (PM(0)) gdn_item_v1<false>(layer, launder_s(bid), tid); return; }
    if (bid < 112) {
        const int tid = launder_v(tid0), lane = tid & 63, w = __builtin_amdgcn_readfirstlane(tid >> 6);
        if (w < 4) { const int it = launder_s((launder_s(bid) - 32) * 4 + w);
            if (it < 256) { if (PM(1)) s5_item<false>(layer, it, w * S5_WLDS, lane); }
            else if (it < 320) { if (PM(2)) s5_item<true>(layer, it - 256, w * S5_WLDS, lane); } }
        return;
    }
    const int nw = G - 112;
    for (int it = bid - 112; it < 64 + 16 + 1024; it += nw) {
        const int tid = launder_v(tid0), lane = tid & 63, w = tid >> 6;
        if (it < 64) { if (PM(3)) gmlp_prompt_item(layer, launder_s(it), tid); }
        else if (it < 80) { if (PM(4)) gmlp_sample_item(layer, (launder_s(it) - 64) * 8 + w, lane); }
        else { if (PM(5)) gdn_item_v1<true>(layer, launder_s(it) - 80, tid); }
    }
}

__global__ void __launch_bounds__(512, 2) mega(Args karg) {
    const int ph_lo = karg.ph_lo, ph_hi = karg.ph_hi;
    for (int ph = ph_lo; ph < ph_hi; ++ph) {
        if (ph > ph_lo) { cg::this_grid().sync(); }
        const int G = launder_s((int)gridDim.x), bid = launder_s((int)blockIdx.x), tid = launder_v((int)threadIdx.x);
        CArgs& a = kargs(); LAS unsigned char* lds = lds_base();
        unsigned char* ws = a.ws;
#ifndef PROBE_SUB
#define PROBE_SUB -1
#endif
#define PS(x) (PROBE_SUB == -1 || PROBE_SUB == (x))
        if (ph == 0) { if (PS(6)) phase_convert(a, lds, G, bid, tid); continue; }
        const int layer = (ph - 1) / 6, sub = (ph - 1) % 6;
        unsigned char* wb = ws + WS_W0 + (size_t)layer * WS_WL;
        if (PS(0) && sub == 0) {
            pg8::Gemm g{(const bf16_t*)(ws + WS_XB), nullptr, nullptr, (const bf16_t*)(wb + WO_IN), nullptr, nullptr, DM};
            pg8::Sched S; S.init(MT / 256, NP / 256, 1, G, bid);
            pg8::Epi1 E{(bf16_t*)(ws + WS_P), (float*)(ws + WS_AB)};
            pg8::gemm_phase(lds, g, S, E, tid);
        } else if (PS(1) && sub == 1) {
            phase_mixers(layer, G, bid, tid);
        } else if (PS(2) && sub == 2) {
            pg8::Gemm g{(const bf16_t*)(ws + WS_ZB), nullptr, nullptr, (const bf16_t*)(wb + WO_GLU), nullptr, nullptr, 1024};
            pg8::Sched S; S.init(MT / 256, 4, 1, G, bid);
            pg8::Epi2 E{(const bf16_t*)(ws + WS_ZB), (const bf16_t*)(ws + WS_P), a.in[17] + layer * 1024, (bf16_t*)(ws + WS_YA)};
            pg8::gemm_phase(lds, g, S, E, tid);
        } else if (PS(3) && sub == 3) {
            pg8::Gemm g{(const bf16_t*)(ws + WS_YA), (const bf16_t*)(ws + WS_YB), (const bf16_t*)(ws + WS_YC),
                        (const bf16_t*)(wb + WO_PA), (const bf16_t*)(wb + WO_PB), (const bf16_t*)(wb + WO_PC), 1024};
            pg8::Sched S; S.init(MT / 256, 8, 3, G, bid);
            pg8::Epi3 E{(const bf16_t*)(ws + WS_P), a.in[7] + layer * 3 * DM, (float*)(ws + WS_M32), (bf16_t*)(ws + WS_MB)};
            pg8::gemm_phase(lds, g, S, E, tid);
        } else if (PS(4) && sub == 4) {
            pg8::Gemm g{(const bf16_t*)(ws + WS_MB), nullptr, nullptr, (const bf16_t*)(wb + WO_OUT), nullptr, nullptr, DM};
            pg8::Sched S; S.init(MT / 256, 8, 1, G, bid);
            const float* xp = layer == 0 ? a.in[0] : (const float*)(ws + WS_X32);
            const float* xs = layer == 0 ? a.in[1] : (const float*)(ws + WS_X32) + (size_t)TP * DM;
            pg8::Epi4 E{xp, xs, (float*)(ws + WS_H32)};
            pg8::gemm_phase(lds, g, S, E, tid);
        } else if (PS(5) && sub == 5) {
            phase_ln(a, layer, G, bid, tid);
        }
    }
}

extern "C" void kernel_launch(void* const* d_in, const int* in_sizes, int n_in, void* d_out, int out_size, void* d_ws, size_t ws_size, hipStream_t stream) {
    static int grid = 0;
    if (grid == 0) {
        if (n_in != 32 || (size_t)out_size != O_END || ws_size < WS_END) {
            fprintf(stderr, "kernel_launch: unexpected problem: n_in %d out %d ws %zu (need %zu)\n", n_in, out_size, ws_size, (size_t)WS_END); grid = -1; return; }
        int dev = 0, cus = 0, per_cu = 0;
        if (hipGetDevice(&dev) != hipSuccess || hipDeviceGetAttribute(&cus, hipDeviceAttributeMultiprocessorCount, dev) != hipSuccess) { grid = -1; return; }
        if (hipFuncSetAttribute((const void*)mega, hipFuncAttributeMaxDynamicSharedMemorySize, LDS_BYTES) != hipSuccess) { fprintf(stderr, "kernel_launch: hipFuncSetAttribute failed\n"); grid = -1; return; }
        if (hipOccupancyMaxActiveBlocksPerMultiprocessor(&per_cu, (const void*)mega, 512, LDS_BYTES) != hipSuccess || per_cu < 1) {
            fprintf(stderr, "kernel_launch: occupancy query says %d blocks per CU\n", per_cu); (void)hipGetLastError(); grid = -1; return; }
        grid = cus;
    }
    if (grid < 0) return;
    Args a{};
    for (int i = 0; i < 32; ++i) a.in[i] = (const float*)d_in[i];
    a.out = (float*)d_out; a.ws = (unsigned char*)d_ws;
#if MK_SINGLE
    a.ph_lo = 0; a.ph_hi = NPHASE;
    void* params[] = {&a};
    hipError_t e = hipLaunchCooperativeKernel((const void*)mega, dim3(grid), dim3(512), params, LDS_BYTES, stream);
    if (e != hipSuccess) fprintf(stderr, "kernel_launch: cooperative launch failed: %s (grid %d)\n", hipGetErrorString(e), grid);
#else
    for (int ph = 0; ph < NPHASE; ++ph) {
        a.ph_lo = ph; a.ph_hi = ph + 1;
        hipLaunchKernelGGL(mega, dim3(grid), dim3(512), LDS_BYTES, stream, a);
    }
#endif
}
```

```cpp
#include <hip/hip_runtime.h>
#include <hip/hip_cooperative_groups.h>
#include <cstdio>
#include <cstdint>
namespace cg = cooperative_groups;

#ifndef MK_SINGLE
#define MK_SINGLE 1
#endif

#define LAS __attribute__((address_space(3)))
typedef unsigned short bf16_t;
typedef short bf16x8 __attribute__((ext_vector_type(8)));
typedef float f32x4 __attribute__((ext_vector_type(4)));
typedef float f32x2 __attribute__((ext_vector_type(2)));
typedef float f32x16 __attribute__((ext_vector_type(16)));
typedef unsigned u32x4 __attribute__((ext_vector_type(4)));
typedef unsigned u32x2 __attribute__((ext_vector_type(2)));

constexpr int DM = 2048, TP = 8192, TS = 512, MT = TP + TS;
constexpr int NIN = 15376, NP = 15616;
constexpr int C_XA = 0, C_GA = 1024, C_UB = 2048, C_VB = 3072, C_GB = 4096, C_QKV = 5120, C_GATEC = 8192, C_ZG = 9216, C_AB = 15360;
constexpr int NPHASE = 13;
constexpr float ALPHA = 1.41421356237f;

constexpr size_t MiB = 1u << 20;
constexpr size_t WS_CTL = 0;
constexpr size_t WS_W0 = 1 * MiB, WS_WL = 83 * MiB;
constexpr size_t WO_IN = 0, WO_GLU = 61 * MiB, WO_PA = 63 * MiB, WO_PB = 67 * MiB, WO_PC = 71 * MiB, WO_OUT = 75 * MiB;
constexpr size_t WS_XB = 167 * MiB, WS_P = 201 * MiB, WS_AB = 461 * MiB, WS_ZB = 462 * MiB, WS_YA = 479 * MiB, WS_YB = 496 * MiB, WS_YC = 513 * MiB;
constexpr size_t WS_M32 = 530 * MiB, WS_MB = 598 * MiB, WS_H32 = 632 * MiB, WS_X32 = 700 * MiB, WS_END = 768 * MiB;

constexpr size_t O_YP = 0, O_YS = 16777216, O_SRP = 17825792, O_SIP = 17858560, O_DP = 17891328, O_CP = 18939904,
                 O_SRS = 19013632, O_SIS = 20062208, O_DS = 21110784, O_CS = 54665216, O_GV = 57024512, O_END = 58073088;

constexpr int LDS_BYTES = 147456;

struct Args { const float* in[32]; float* out; unsigned char* ws; int ph_lo, ph_hi; };
typedef const __attribute__((address_space(4))) Args CArgs;

__device__ __forceinline__ unsigned f2bf(float f) { unsigned u = __builtin_bit_cast(unsigned, f); return (u + 0x7fffu + ((u >> 16) & 1u)) >> 16; }
__device__ __forceinline__ unsigned pk2(float lo, float hi) { return f2bf(lo) | (f2bf(hi) << 16); }
__device__ __forceinline__ float bf2f(unsigned short h) { return __builtin_bit_cast(float, (unsigned)h << 16); }
__device__ __forceinline__ float bflo(unsigned w) { return __builtin_bit_cast(float, w << 16); }
__device__ __forceinline__ float bfhi(unsigned w) { return __builtin_bit_cast(float, w & 0xffff0000u); }
__device__ __forceinline__ float sigm(float x) { return 1.f / (1.f + __expf(-x)); }
__device__ __forceinline__ float silu(float x) { return x / (1.f + __expf(-x)); }
__device__ __forceinline__ float gelu_tanh(float x) { return x * sigm(1.5957691216f * (x + 0.044715f * x * x * x)); }
__device__ __forceinline__ float softplus(float x) { return x > 20.f ? x : log1pf(expf(x)); }
__device__ __forceinline__ float wave_sum(float v) {
#pragma unroll
    for (int o = 1; o < 64; o <<= 1) v += __shfl_xor(v, o);
    return v;
}
__device__ __forceinline__ void unpack8(const u32x4 w, float (&f)[8]) {
    f[0] = bflo(w.x); f[1] = bfhi(w.x); f[2] = bflo(w.y); f[3] = bfhi(w.y); f[4] = bflo(w.z); f[5] = bfhi(w.z); f[6] = bflo(w.w); f[7] = bfhi(w.w);
}
__device__ __forceinline__ u32x4 pack8(const float (&f)[8]) { u32x4 w; w.x = pk2(f[0], f[1]); w.y = pk2(f[2], f[3]); w.z = pk2(f[4], f[5]); w.w = pk2(f[6], f[7]); return w; }
#define LDS_WAIT() asm volatile("s_waitcnt lgkmcnt(0)" ::: "memory")
__device__ __forceinline__ int launder_v(int x) { asm volatile("" : "+v"(x)); return x; }
__device__ __forceinline__ int launder_s(int x) { asm volatile("" : "+s"(x)); return x; }
__device__ __forceinline__ CArgs& kargs() { int z; asm volatile("s_mov_b32 %0, 0" : "=s"(z));
    return *(CArgs*)((const __attribute__((address_space(4))) char*)__builtin_amdgcn_kernarg_segment_ptr() + z); }
__device__ __forceinline__ LAS unsigned char* lds_base() { extern __shared__ __attribute__((aligned(16))) unsigned char lds_raw[]; int z; asm volatile("s_mov_b32 %0, 0" : "=s"(z));
    return (LAS unsigned char*)lds_raw + z; }

namespace pg8 {
constexpr int BM = 256, BK = 64, HALF = 128, HTB = HALF * BK * 2, STAGE_BYTES = 8 * HTB, NXCD = 8, WGM = 8;
__device__ __forceinline__ int lds_byte(int r, int c) { const int st = (r >> 4) * 2 + (c >> 5), rr = r & 15, cc = c & 31, ob = rr * 64 + cc * 2; return st * 1024 + (ob ^ (((ob >> 9) & 1) << 5)); }
__device__ __forceinline__ void stage_rc(int b, int& R, int& C) { const int st = b / 1024, sb = b % 1024, swz = sb ^ (((sb >> 9) & 1) << 5); R = (st >> 1) * 16 + swz / 64; C = (st & 1) * 32 + (swz % 64) / 2; }
__device__ __forceinline__ int perm32(int rho) { const int n = rho >> 4, i = rho & 15; return 8 * (i >> 2) + 4 * n + (i & 3); }

struct Unit { int pm, pn, br; };
struct Gemm { const bf16_t* A0; const bf16_t* A1; const bf16_t* A2; const bf16_t* B0; const bf16_t* B1; const bf16_t* B2; int K; };

struct Sched {
    int nM, nN, nbr, nwg, G, c;
    __device__ __forceinline__ void init(int nM_, int nN_, int nbr_, int G_, int c_) { nM = nM_; nN = nN_; nbr = nbr_; nwg = nM * nN; G = G_; c = c_; }
    __device__ __forceinline__ bool next(int i, Unit& u) const {
        const int ti = i / nbr; u.br = i - ti * nbr;
        const long L = (long)ti * G + c; if (L >= nwg) return false;
        int wgid = (int)L; { const int q = nwg / NXCD, r = nwg % NXCD, xcd = wgid % NXCD, off = wgid / NXCD; wgid = (xcd < r ? xcd * (q + 1) : r * (q + 1) + (xcd - r) * q) + off; }
        const int nig = WGM * nN, gid = wgid / nig, fm = gid * WGM, gsz = (nM - fm) < WGM ? (nM - fm) : WGM;
        u.pm = fm + ((wgid % nig) % gsz); u.pn = (wgid % nig) / gsz; return true;
    }
};

template <class Epi>
__device__ __forceinline__ void gemm_phase(LAS unsigned char* lds, const Gemm g, const Sched& S, const Epi& E, const int tid) {
    const int wid = __builtin_amdgcn_readfirstlane(tid >> 6), lane = tid & 63, wr = wid >> 2, wc = wid & 3, fr = lane & 15, fq = lane >> 4;
    const int K = g.K, nt = K / BK;
    unsigned voffA[2], voffB[2];
#pragma unroll
    for (int i = 0; i < 2; ++i) { int R, C; stage_rc(tid * 16 + i * 8192, R, C); const int Rb = (R & ~31) + perm32(R & 31);
        voffA[i] = (unsigned)(R * K + C) * 2u; voffB[i] = (unsigned)(Rb * K + C) * 2u; }
    const size_t kstep = (size_t)(BK * 2);
    const size_t hstep = (size_t)HALF * K * 2;
    const size_t tstep = 2 * hstep;
    const unsigned ldsw = (unsigned)wid * 1024u;
    const int aoff = lds_byte(wr * 64 + fr, fq * 8), boff = lds_byte(wc * 32 + fr, fq * 8);
#define PG8_SA(b, h) (((b) * 2 + (h)) * HTB)
#define PG8_SB(b, h) ((4 + (b) * 2 + (h)) * HTB)
#define PG8_STAGE(bufoff, gbase, voff) do { _Pragma("unroll") for (int _i = 0; _i < 2; ++_i) \
        __builtin_amdgcn_global_load_lds((const unsigned*)((const char*)(gbase) + (voff)[_i]), (LAS unsigned*)(lds + (bufoff) + ldsw + _i * 8192), 16, 0, 0); } while (0)
#define PG8_LDA(dst, b, h) do { _Pragma("unroll") for (int m = 0; m < 4; ++m) _Pragma("unroll") for (int k = 0; k < 2; ++k) dst[m][k] = *(const LAS bf16x8*)(lds + PG8_SA(b, h) + aoff + m * 2048 + k * 1024); } while (0)
#define PG8_LDB(dst, b, h) do { _Pragma("unroll") for (int n = 0; n < 2; ++n) _Pragma("unroll") for (int k = 0; k < 2; ++k) dst[n][k] = *(const LAS bf16x8*)(lds + PG8_SB(b, h) + boff + n * 2048 + k * 1024); } while (0)
#define PG8_MMA(ai, bj, At, Bt) do { __builtin_amdgcn_s_setprio(1); _Pragma("unroll") for (int m = 0; m < 4; ++m) _Pragma("unroll") for (int n = 0; n < 2; ++n) _Pragma("unroll") for (int k = 0; k < 2; ++k) \
        acc[ai][bj][m][n] = __builtin_amdgcn_mfma_f32_16x16x32_bf16(Bt[n][k], At[m][k], acc[ai][bj][m][n], 0, 0, 0); __builtin_amdgcn_s_setprio(0); } while (0)
#define PG8_WAIT_V(n) asm volatile("s_waitcnt vmcnt(" #n ")" ::: "memory")
#define PG8_WAIT_L(n) asm volatile("s_waitcnt lgkmcnt(" #n ")" ::: "memory")
#define PG8_BAR __builtin_amdgcn_s_barrier()
#define PG8_SCHED __builtin_amdgcn_sched_barrier(0)
#define PG8_APTR(u) ((const char*)((u).br == 0 ? g.A0 : ((u).br == 1 ? g.A1 : g.A2)) + (size_t)(u).pm * tstep)
#define PG8_BPTR(u) ((const char*)((u).br == 0 ? g.B0 : ((u).br == 1 ? g.B1 : g.B2)) + (size_t)(u).pn * tstep)
    Unit cur, nxt; int ui = 0;
    if (!S.next(0, cur)) return;
    f32x4 acc[2][2][4][2];
#pragma unroll
    for (int a = 0; a < 2; ++a)
#pragma unroll
        for (int b = 0; b < 2; ++b)
#pragma unroll
            for (int m = 0; m < 4; ++m)
#pragma unroll
                for (int n = 0; n < 2; ++n) acc[a][b][m][n] = (f32x4){0.f, 0.f, 0.f, 0.f};
    bf16x8 At[4][2], B0[2][2], B1[2][2];
    const char* cA = PG8_APTR(cur); const char* cB = PG8_BPTR(cur);
    PG8_STAGE(PG8_SB(0, 0), cB, voffB); PG8_STAGE(PG8_SB(0, 1), cB + hstep, voffB); PG8_STAGE(PG8_SA(0, 0), cA, voffA); PG8_STAGE(PG8_SA(0, 1), cA + hstep, voffA);
    if (wr == 1) PG8_BAR;
    PG8_WAIT_V(2); PG8_BAR;
    PG8_STAGE(PG8_SB(1, 0), cB + kstep, voffB); PG8_STAGE(PG8_SA(1, 0), cA + kstep, voffA); PG8_STAGE(PG8_SB(1, 1), cB + hstep + kstep, voffB);
    PG8_WAIT_V(6); PG8_BAR;
    for (;;) {
        const bool has_next = S.next(ui + 1, nxt);
        const char* nA = has_next ? PG8_APTR(nxt) : cA; const char* nB = has_next ? PG8_BPTR(nxt) : cB;
        for (int t = 0; t < nt; t += 2) {
            const bool last = (t == nt - 2);
            const char* a1 = cA + (size_t)(t + 1) * kstep;
            const char* a2 = last ? nA : cA + (size_t)(t + 2) * kstep; const char* b2 = last ? nB : cB + (size_t)(t + 2) * kstep;
            const char* a3 = a2 + kstep; const char* b3 = b2 + kstep;
            PG8_LDB(B0, 0, 0); PG8_LDB(B1, 0, 1); PG8_SCHED; PG8_LDA(At, 0, 0); PG8_STAGE(PG8_SA(1, 1), a1 + hstep, voffA);
            PG8_WAIT_V(8); PG8_WAIT_L(0); PG8_BAR; PG8_MMA(0, 0, At, B0); PG8_MMA(0, 1, At, B1); PG8_BAR; PG8_SCHED;
            PG8_LDA(At, 0, 1); PG8_STAGE(PG8_SB(0, 0), b2, voffB); PG8_STAGE(PG8_SB(0, 1), b2 + hstep, voffB); PG8_STAGE(PG8_SA(0, 0), a2, voffA);
            PG8_WAIT_V(8); PG8_WAIT_L(0); PG8_BAR; PG8_MMA(1, 0, At, B0); PG8_MMA(1, 1, At, B1); PG8_BAR; PG8_SCHED;
            PG8_LDB(B0, 1, 0); PG8_LDB(B1, 1, 1); PG8_SCHED; PG8_LDA(At, 1, 0); PG8_STAGE(PG8_SA(0, 1), a2 + hstep, voffA);
            PG8_WAIT_V(8); PG8_WAIT_L(0); PG8_BAR; PG8_MMA(0, 0, At, B0); PG8_MMA(0, 1, At, B1); PG8_BAR; PG8_SCHED;
            PG8_LDA(At, 1, 1); PG8_STAGE(PG8_SB(1, 0), b3, voffB); PG8_STAGE(PG8_SB(1, 1), b3 + hstep, voffB); PG8_STAGE(PG8_SA(1, 0), a3, voffA);
            PG8_WAIT_V(8); PG8_WAIT_L(0); PG8_BAR; PG8_MMA(1, 0, At, B0); PG8_MMA(1, 1, At, B1); PG8_BAR; PG8_SCHED;
        }
        if (wr == 0) PG8_BAR;
        E(acc, cur, wr, wc, fr, fq);
        if (!has_next) break;
#pragma unroll
        for (int a = 0; a < 2; ++a)
#pragma unroll
            for (int b = 0; b < 2; ++b)
#pragma unroll
                for (int m = 0; m < 4; ++m)
#pragma unroll
                    for (int n = 0; n < 2; ++n) acc[a][b][m][n] = (f32x4){0.f, 0.f, 0.f, 0.f};
        cur = nxt; cA = nA; cB = nB; ++ui;
        if (wr == 1) PG8_BAR;
    }
    PG8_WAIT_V(0);
    PG8_BAR;
#undef PG8_SA
#undef PG8_SB
#undef PG8_STAGE
#undef PG8_LDA
#undef PG8_LDB
#undef PG8_MMA
#undef PG8_WAIT_V
#undef PG8_WAIT_L
#undef PG8_BAR
#undef PG8_SCHED
#undef PG8_APTR
#undef PG8_BPTR
}

struct Epi1 {
    bf16_t* P; float* AB;
    __device__ __forceinline__ void operator()(const f32x4 (&acc)[2][2][4][2], const Unit& u, int wr, int wc, int fr, int fq) const {
        const int row0 = u.pm * BM + wr * 64 + fr, col0 = u.pn * BM + wc * 32 + 8 * fq;
#pragma unroll
        for (int ai = 0; ai < 2; ++ai)
#pragma unroll
            for (int m = 0; m < 4; ++m) { bf16_t* rowp = P + (size_t)(row0 + ai * HALF + m * 16) * NP + col0;
#pragma unroll
                for (int bj = 0; bj < 2; ++bj) { const f32x4 v0 = acc[ai][bj][m][0], v1 = acc[ai][bj][m][1];
                    u32x4 w; w.x = pk2(v0[0], v0[1]); w.y = pk2(v0[2], v0[3]); w.z = pk2(v1[0], v1[1]); w.w = pk2(v1[2], v1[3]);
                    *(u32x4*)(rowp + bj * HALF) = w; } }
        if (u.pn == 60 && wc == 0 && fq < 2) {
#pragma unroll
            for (int ai = 0; ai < 2; ++ai)
#pragma unroll
                for (int m = 0; m < 4; ++m) { float* ab = AB + (size_t)(row0 + ai * HALF + m * 16) * 16 + 8 * fq;
                    *(f32x4*)ab = acc[ai][0][m][0]; *(f32x4*)(ab + 4) = acc[ai][0][m][1]; }
        }
    }
};
struct Epi2 {
    const bf16_t* Zb; const bf16_t* P; const float* bglu; bf16_t* YA;
    __device__ __forceinline__ void operator()(const f32x4 (&acc)[2][2][4][2], const Unit& u, int wr, int wc, int fr, int fq) const {
        const int row0 = u.pm * BM + wr * 64 + fr, col0 = u.pn * BM + wc * 32 + 8 * fq;
#pragma unroll
        for (int bj = 0; bj < 2; ++bj) { const int col = col0 + bj * HALF;
            const f32x4 b0 = *(const f32x4*)(bglu + col), b1 = *(const f32x4*)(bglu + col + 4);
#pragma unroll
            for (int ai = 0; ai < 2; ++ai)
#pragma unroll
                for (int m = 0; m < 4; ++m) { const size_t row = (size_t)(row0 + ai * HALF + m * 16);
                    float z[8], ga[8], o[8];
                    unpack8(*(const u32x4*)(Zb + row * 1024 + col), z); unpack8(*(const u32x4*)(P + row * NP + C_GA + col), ga);
                    const f32x4 v0 = acc[ai][bj][m][0] + b0, v1 = acc[ai][bj][m][1] + b1;
#pragma unroll
                    for (int e = 0; e < 4; ++e) { o[e] = z[e] * sigm(v0[e]) * silu(ga[e]); o[4 + e] = z[4 + e] * sigm(v1[e]) * silu(ga[4 + e]); }
                    *(u32x4*)(YA + row * 1024 + col) = pack8(o); } }
    }
};
struct Epi3 {
    const bf16_t* P; const float* bgate; float* M32; bf16_t* Mb;
    __device__ __forceinline__ void operator()(const f32x4 (&acc)[2][2][4][2], const Unit& u, int wr, int wc, int fr, int fq) const {
        const int row0 = u.pm * BM + wr * 64 + fr, col0 = u.pn * BM + wc * 32 + 8 * fq, br = u.br;
#pragma unroll
        for (int bj = 0; bj < 2; ++bj) { const int col = col0 + bj * HALF;
            const f32x4 g0 = *(const f32x4*)(bgate + br * DM + col), g1 = *(const f32x4*)(bgate + br * DM + col + 4);
#pragma unroll
            for (int ai = 0; ai < 2; ++ai)
#pragma unroll
                for (int m = 0; m < 4; ++m) { const size_t row = (size_t)(row0 + ai * HALF + m * 16);
                    float zg[8], o[8];
                    unpack8(*(const u32x4*)(P + row * NP + C_ZG + br * DM + col), zg);
                    const f32x4 a0 = acc[ai][bj][m][0], a1 = acc[ai][bj][m][1];
#pragma unroll
                    for (int e = 0; e < 4; ++e) { o[e] = sigm(zg[e] + g0[e]) * a0[e]; o[4 + e] = sigm(zg[4 + e] + g1[e]) * a1[e]; }
                    float* mp = M32 + row * DM + col;
                    if (br > 0) { const f32x4 p0 = *(const f32x4*)mp, p1 = *(const f32x4*)(mp + 4);
#pragma unroll
                        for (int e = 0; e < 4; ++e) { o[e] += p0[e]; o[4 + e] += p1[e]; } }
                    if (br < 2) { *(f32x4*)mp = (f32x4){o[0], o[1], o[2], o[3]}; *(f32x4*)(mp + 4) = (f32x4){o[4], o[5], o[6], o[7]}; }
                    else *(u32x4*)(Mb + row * DM + col) = pack8(o); } }
    }
};
struct Epi4 {
    const float* xp; const float* xs; float* H32;
    __device__ __forceinline__ void operator()(const f32x4 (&acc)[2][2][4][2], const Unit& u, int wr, int wc, int fr, int fq) const {
        const int row0 = u.pm * BM + wr * 64 + fr, col0 = u.pn * BM + wc * 32 + 8 * fq;
        const float* xb = (u.pm < 32) ? xp : (xs - (size_t)TP * DM);
#pragma unroll
        for (int ai = 0; ai < 2; ++ai)
#pragma unroll
            for (int m = 0; m < 4; ++m) { const size_t row = (size_t)(row0 + ai * HALF + m * 16);
#pragma unroll
                for (int bj = 0; bj < 2; ++bj) { const int col = col0 + bj * HALF;
                    const f32x4 x0 = *(const f32x4*)(xb + row * DM + col), x1 = *(const f32x4*)(xb + row * DM + col + 4);
                    *(f32x4*)(H32 + row * DM + col) = x0 * ALPHA + acc[ai][bj][m][0];
                    *(f32x4*)(H32 + row * DM + col + 4) = x1 * ALPHA + acc[ai][bj][m][1]; } }
    }
};
}

template <bool REMAP>
__device__ __forceinline__ void transpose_item(const float* W, int K, int Nsrc, int Ndst, bf16_t* WT, LAS float* scr, int item, int lane) {
    const int nblk = Ndst / 32, kb = item / nblk, nb = item % nblk, k0 = 64 * kb, n0 = 32 * nb;
    int d = n0 + (lane & 31), s = d; bool valid = true;
    if (REMAP) { if (d < C_GATEC) s = d; else if (d < C_AB) s = d + 16; else if (d < C_AB + 16) s = 8192 + (d - C_AB); else { s = 0; valid = false; } }
#pragma unroll 8
    for (int i = 0; i < 32; ++i) { const int kk = 2 * i + (lane >> 5); scr[kk * 33 + (lane & 31)] = valid ? W[(size_t)(k0 + kk) * Nsrc + s] : 0.f; }
    LDS_WAIT();
    const int c = lane & 7;
#pragma unroll
    for (int j = 0; j < 4; ++j) { const int n = (lane >> 3) + 8 * j; const LAS float* sp = scr + (8 * c) * 33 + n;
        u32x4 o; o.x = pk2(sp[0 * 33], sp[1 * 33]); o.y = pk2(sp[2 * 33], sp[3 * 33]); o.z = pk2(sp[4 * 33], sp[5 * 33]); o.w = pk2(sp[6 * 33], sp[7 * 33]);
        *(u32x4*)(WT + (size_t)(n0 + n) * K + k0 + 8 * c) = o; }
    LDS_WAIT();
}

__device__ __forceinline__ void phase_convert(CArgs& a, LAS unsigned char* lds, int G, int vb, const int tid) {
    const int lane = tid & 63, wave = tid >> 6;
    LAS float* scr = (LAS float*)(lds + wave * 16384);
    const int gw = vb * 8 + wave, NGW = G * 8;
    constexpr int I_IN = (DM / 64) * (NP / 32), I_GLU = (1024 / 64) * (1024 / 32), I_P = (1024 / 64) * (DM / 32), I_OUT = (DM / 64) * (DM / 32);
    constexpr int I_L = I_IN + I_GLU + 3 * I_P + I_OUT;
    for (int it = gw; it < 2 * I_L; it += NGW) {
        const int l = it / I_L; int r = it - l * I_L;
        unsigned char* wb = a.ws + WS_W0 + (size_t)l * WS_WL;
        if (r < I_IN) { transpose_item<true>(a.in[6] + (size_t)l * DM * NIN, DM, NIN, NP, (bf16_t*)(wb + WO_IN), scr, r, lane); continue; } r -= I_IN;
        if (r < I_GLU) { transpose_item<false>(a.in[16] + (size_t)l * 1024 * 1024, 1024, 1024, 1024, (bf16_t*)(wb + WO_GLU), scr, r, lane); continue; } r -= I_GLU;
        if (r < I_P) { transpose_item<false>(a.in[18] + (size_t)l * 1024 * DM, 1024, DM, DM, (bf16_t*)(wb + WO_PA), scr, r, lane); continue; } r -= I_P;
        if (r < I_P) { transpose_item<false>(a.in[23] + (size_t)l * 1024 * DM, 1024, DM, DM, (bf16_t*)(wb + WO_PB), scr, r, lane); continue; } r -= I_P;
        if (r < I_P) { transpose_item<false>(a.in[28] + (size_t)l * 1024 * DM, 1024, DM, DM, (bf16_t*)(wb + WO_PC), scr, r, lane); continue; } r -= I_P;
        transpose_item<false>(a.in[29] + (size_t)l * DM * DM, DM, DM, DM, (bf16_t*)(wb + WO_OUT), scr, r, lane);
    }
    bf16_t* Xb = (bf16_t*)(a.ws + WS_XB);
    for (int m = gw; m < MT; m += NGW) {
        const float* xr = (m < TP) ? a.in[0] + (size_t)m * DM : a.in[1] + (size_t)(m - TP) * DM;
        const f32x4* xv = (const f32x4*)xr + lane; u32x2* o = (u32x2*)(Xb + (size_t)m * DM) + lane;
#pragma unroll
        for (int j = 0; j < 8; ++j) { const f32x4 v = xv[64 * j]; u32x2 w; w.x = pk2(v.x, v.y); w.y = pk2(v.z, v.w); o[64 * j] = w; }
    }
}

__device__ __forceinline__ void phase_ln(CArgs& a, int layer, int G, int vb, const int tid) {
    const int lane = tid & 63, wave = tid >> 6;
    const int gw = vb * 8 + wave, NGW = G * 8;
    const float* H32 = (const float*)(a.ws + WS_H32);
    const float* lg = a.in[30] + layer * DM; const float* lb = a.in[31] + layer * DM;
    bf16_t* Xb = (bf16_t*)(a.ws + WS_XB);
    for (int m = gw; m < MT; m += NGW) {
        const f32x4* xv = (const f32x4*)(H32 + (size_t)m * DM) + lane;
        f32x4 v[8]; float s = 0.f;
#pragma unroll
        for (int j = 0; j < 8; ++j) { v[j] = xv[64 * j]; s += (v[j].x + v[j].y) + (v[j].z + v[j].w); }
        const float mean = wave_sum(s) * (1.f / DM); float s2 = 0.f;
#pragma unroll
        for (int j = 0; j < 8; ++j) { v[j] = v[j] - mean; s2 += (v[j].x * v[j].x + v[j].y * v[j].y) + (v[j].z * v[j].z + v[j].w * v[j].w); }
        const float rstd = 1.f / sqrtf(wave_sum(s2) * (1.f / DM) + 1e-5f);
        float* dst = (layer == 0) ? (float*)(a.ws + WS_X32) + (size_t)m * DM : (m < TP ? a.out + O_YP + (size_t)m * DM : a.out + O_YS + (size_t)(m - TP) * DM);
#pragma unroll
        for (int j = 0; j < 8; ++j) { const f32x4 gg = *((const f32x4*)lg + lane + 64 * j), bb = *((const f32x4*)lb + lane + 64 * j);
            const f32x4 y = v[j] * rstd * gg + bb; *((f32x4*)dst + lane + 64 * j) = y;
            if (layer == 0) { u32x2 w; w.x = pk2(y.x, y.y); w.y = pk2(y.z, y.w); *((u32x2*)(Xb + (size_t)m * DM) + lane + 64 * j) = w; } }
    }
}

constexpr int S5_BUS = 128;
constexpr int S5_SROW = 272;
constexpr int S5_WLDS = 32 * S5_BUS * 4 + 32 * S5_SROW;
template <bool SAMPLE>
__device__ __forceinline__ void s5_item(int layer, int item, int wlo, int lane) {
    CArgs& a = kargs(); LAS unsigned char* wl = lds_base() + wlo;
    const int g = SAMPLE ? item : (item & 63), b = SAMPLE ? 0 : (item >> 6);
    const float* lam_re = a.in[8] + layer * 4096 + g * 64; const float* lam_im = a.in[9] + layer * 4096 + g * 64;
    const float dt = expf(a.in[10][layer * 64 + g]);
    const float* b_re = a.in[11] + (size_t)(layer * 64 + g) * 1024; const float* b_im = a.in[12] + (size_t)(layer * 64 + g) * 1024;
    const float* c_re = a.in[13] + (size_t)(layer * 64 + g) * 1024; const float* c_im = a.in[14] + (size_t)(layer * 64 + g) * 1024;
    const float dch = a.in[15][layer * 1024 + g * 16 + (lane & 15)];
    const bf16_t* P = (const bf16_t*)(a.ws + WS_P); bf16_t* Zb = (bf16_t*)(a.ws + WS_ZB);
    LAS float* BU = (LAS float*)wl; LAS unsigned char* Sb = wl + 32 * S5_BUS * 4;
    float ar, ai;
    { const float lr = lam_re[lane], li = lam_im[lane]; const float mag = expf(lr * dt); float sn, cs; sincosf(li * dt, &sn, &cs); ar = mag * cs; ai = mag * sn; }
    bf16x8 Bf[4];
    { const int h = lane >> 5;
#pragma unroll
      for (int q = 0; q < 2; ++q) { const int pp = q * 32 + (lane & 31);
        const float lr = lam_re[pp], li = lam_im[pp]; const float mag = expf(lr * dt); float sn, cs; sincosf(li * dt, &sn, &cs);
        const float abr = mag * cs, abi = mag * sn, den = lr * lr + li * li, nr = abr - 1.f, ni = abi;
        const float f_r = (nr * lr + ni * li) / den, f_i = (ni * lr - nr * li) / den;
        float br8[8], bi8[8], or8[8], oi8[8];
        *(f32x4*)&br8[0] = *(const f32x4*)(b_re + pp * 16 + 8 * h); *(f32x4*)&br8[4] = *(const f32x4*)(b_re + pp * 16 + 8 * h + 4);
        *(f32x4*)&bi8[0] = *(const f32x4*)(b_im + pp * 16 + 8 * h); *(f32x4*)&bi8[4] = *(const f32x4*)(b_im + pp * 16 + 8 * h + 4);
#pragma unroll
        for (int e = 0; e < 8; ++e) { or8[e] = f_r * br8[e] - f_i * bi8[e]; oi8[e] = f_r * bi8[e] + f_i * br8[e]; }
        Bf[q] = __builtin_bit_cast(bf16x8, pack8(or8)); Bf[2 + q] = __builtin_bit_cast(bf16x8, pack8(oi8)); } }
    bf16x8 Cf[4];
    { const int c = lane & 15;
#pragma unroll
      for (int ks = 0; ks < 4; ++ks) { const int p0 = 16 * ks + 4 * (lane >> 4);
        const f32x4 cr = *(const f32x4*)(c_re + c * 64 + p0), ci = *(const f32x4*)(c_im + c * 64 + p0);
        float o[8] = {cr[0], -ci[0], cr[1], -ci[1], cr[2], -ci[2], cr[3], -ci[3]};
        Cf[ks] = __builtin_bit_cast(bf16x8, pack8(o)); } }
    float sr = 0.f, si = 0.f;
    const int nsc = SAMPLE ? 16 : 64;
    const float* h_re = a.in[2] + (size_t)layer * 128 * 4096 + g * 64 + lane; const float* h_im = a.in[3] + (size_t)layer * 128 * 4096 + g * 64 + lane;
    float* o_re = a.out + O_SRS + (size_t)layer * 128 * 4096 + g * 64 + lane; float* o_im = a.out + O_SIS + (size_t)layer * 128 * 4096 + g * 64 + lane;
    for (int sc = 0; sc < nsc; ++sc) {
        const int row0 = SAMPLE ? TP + sc * 32 : b * 2048 + sc * 32;
        const bf16x8 Af = *(const bf16x8*)(P + (size_t)(row0 + (lane & 31)) * NP + C_XA + g * 16 + 8 * (lane >> 5));
#pragma unroll
        for (int nb = 0; nb < 4; ++nb) {
            f32x16 acc;
#pragma unroll
            for (int r = 0; r < 16; ++r) acc[r] = 0.f;
            acc = __builtin_amdgcn_mfma_f32_32x32x16_bf16(Af, Bf[nb], acc, 0, 0, 0);
#pragma unroll
            for (int r = 0; r < 16; ++r) { const int t = (r & 3) + 8 * (r >> 2) + 4 * (lane >> 5); BU[t * S5_BUS + 32 * nb + (lane & 31)] = acc[r]; }
        }
        LDS_WAIT();
#pragma unroll 4
        for (int t = 0; t < 32; ++t) {
            if (SAMPLE && (t & 3) == 0) { const int bi = sc * 8 + (t >> 2); sr = h_re[(size_t)bi * 4096]; si = h_im[(size_t)bi * 4096]; }
            const float bur = BU[t * S5_BUS + lane], bui = BU[t * S5_BUS + 64 + lane];
            const float nsr = ar * sr - ai * si + bur, nsi = ar * si + ai * sr + bui;
            sr = nsr; si = nsi;
            *(LAS unsigned*)(Sb + t * S5_SROW + 4 * lane) = pk2(sr, si);
            if (SAMPLE && (t & 3) == 3) { const int bi = sc * 8 + (t >> 2); o_re[(size_t)bi * 4096] = sr; o_im[(size_t)bi * 4096] = si; }
        }
        LDS_WAIT();
#pragma unroll
        for (int mb = 0; mb < 2; ++mb) {
            f32x4 y = (f32x4){0.f, 0.f, 0.f, 0.f};
#pragma unroll
            for (int ks = 0; ks < 4; ++ks) { const bf16x8 Sf = *(const LAS bf16x8*)(Sb + (16 * mb + (lane & 15)) * S5_SROW + 64 * ks + 16 * (lane >> 4));
                y = __builtin_amdgcn_mfma_f32_16x16x32_bf16(Sf, Cf[ks], y, 0, 0, 0); }
#pragma unroll
            for (int r = 0; r < 4; ++r) { const size_t row = (size_t)(row0 + 16 * mb + 4 * (lane >> 4) + r);
                const float xa = bf2f(P[row * NP + C_XA + g * 16 + (lane & 15)]);
                Zb[row * 1024 + g * 16 + (lane & 15)] = (bf16_t)f2bf(gelu_tanh(y[r] + dch * xa)); }
        }
        LDS_WAIT();
    }
    if (!SAMPLE) { a.out[O_SRP + (size_t)((layer * 4 + b) * 64 + g) * 64 + lane] = sr; a.out[O_SIP + (size_t)((layer * 4 + b) * 64 + g) * 64 + lane] = si; }
}

constexpr int GM_TROW = 80;
__device__ __forceinline__ void gmlp_prompt_item(int layer, int item, const int tid) {
    CArgs& a = kargs(); LAS unsigned char* lds = lds_base();
    const int lane = tid & 63, w = tid >> 6;
    const bf16_t* P = (const bf16_t*)(a.ws + WS_P); bf16_t* YB = (bf16_t*)(a.ws + WS_YB);
    const float* lng = a.in[19] + layer * 1024; const float* lnb = a.in[20] + layer * 1024;
    const int r0 = item * 128;
    LAS f32x2* stats = (LAS f32x2*)lds;
    LAS unsigned char* vt = lds + 1024 + w * (32 * GM_TROW);
    __syncthreads();
    for (int i = 0; i < 16; ++i) { const int t = 16 * w + i; const bf16_t* rp = P + (size_t)(r0 + t) * NP + C_VB + lane * 16;
        float x[16]; { float t8[8]; unpack8(*(const u32x4*)rp, t8);
#pragma unroll
            for (int e = 0; e < 8; ++e) x[e] = t8[e];
            unpack8(*(const u32x4*)(rp + 8), t8);
#pragma unroll
            for (int e = 0; e < 8; ++e) x[8 + e] = t8[e]; }
        float s = 0.f;
#pragma unroll
        for (int e = 0; e < 16; ++e) s += x[e];
        const float mean = wave_sum(s) * (1.f / 1024.f); float s2 = 0.f;
#pragma unroll
        for (int e = 0; e < 16; ++e) { const float d = x[e] - mean; s2 += d * d; }
        const float rstd = 1.f / sqrtf(wave_sum(s2) * (1.f / 1024.f) + 1e-5f);
        if (lane == 0) stats[t] = (f32x2){mean, rstd}; }
    __syncthreads();
    for (int rnd = 0; rnd < 4; ++rnd) {
        const int wi = rnd * 8 + w, g = wi >> 2, cbase = g * 128 + (wi & 3) * 32;
        const float* Ws = a.in[21] + (size_t)(layer * 8 + g) * 128 * 128;
        f32x4 acc[2][8];
#pragma unroll
        for (int cb = 0; cb < 2; ++cb)
#pragma unroll
            for (int ib = 0; ib < 8; ++ib) acc[cb][ib] = (f32x4){0.f, 0.f, 0.f, 0.f};
#pragma unroll 1
        for (int kb = 0; kb < 4; ++kb) {
#pragma unroll 1
            for (int q = 0; q < 2; ++q) { const int j = (lane >> 2) + 16 * q, cg = lane & 3;
                float x[8]; unpack8(*(const u32x4*)(P + (size_t)(r0 + 32 * kb + j) * NP + C_VB + cbase + cg * 8), x);
                const f32x2 st = stats[32 * kb + j];
                const f32x4 g0 = *(const f32x4*)(lng + cbase + cg * 8), g1 = *(const f32x4*)(lng + cbase + cg * 8 + 4);
                const f32x4 b0 = *(const f32x4*)(lnb + cbase + cg * 8), b1 = *(const f32x4*)(lnb + cbase + cg * 8 + 4);
#pragma unroll
                for (int e = 0; e < 8; ++e) { const float gg = e < 4 ? g0[e & 3] : g1[e & 3], bb = e < 4 ? b0[e & 3] : b1[e & 3];
                    const float v = (x[e] - st.x) * st.y * gg + bb;
                    *(LAS bf16_t*)(vt + (cg * 8 + e) * GM_TROW + 2 * j) = (bf16_t)f2bf(v); } }
            LDS_WAIT();
            bf16x8 Af[2];
#pragma unroll
            for (int cb = 0; cb < 2; ++cb) Af[cb] = *(const LAS bf16x8*)(vt + (16 * cb + (lane & 15)) * GM_TROW + 16 * (lane >> 4));
#pragma unroll
            for (int ib = 0; ib < 8; ++ib) {
                if (ib >= 2 * kb) {
                    const int i = 16 * ib + (lane & 15), j0 = 32 * kb + 8 * (lane >> 4);
                    const f32x4 w0 = *(const f32x4*)(Ws + i * 128 + j0), w1 = *(const f32x4*)(Ws + i * 128 + j0 + 4);
                    float wv[8];
#pragma unroll
                    for (int e = 0; e < 8; ++e) { const float x = e < 4 ? w0[e & 3] : w1[e & 3]; wv[e] = (j0 + e <= i) ? x : 0.f; }
                    const bf16x8 Bw = __builtin_bit_cast(bf16x8, pack8(wv));
#pragma unroll
                    for (int cb = 0; cb < 2; ++cb) acc[cb][ib] = __builtin_amdgcn_mfma_f32_16x16x32_bf16(Af[cb], Bw, acc[cb][ib], 0, 0, 0);
                }
            }
            LDS_WAIT();
        }
        const float* bsp = a.in[22] + (size_t)(layer * 8 + g) * 128;
#pragma unroll
        for (int ib = 0; ib < 8; ++ib) { const int i = 16 * ib + (lane & 15); const float bs = bsp[i]; const size_t row = (size_t)(r0 + i);
#pragma unroll
            for (int cb = 0; cb < 2; ++cb) { const int ch = cbase + 16 * cb + 4 * (lane >> 4);
                const u32x2 uw = *(const u32x2*)(P + row * NP + C_UB + ch), gw = *(const u32x2*)(P + row * NP + C_GB + ch);
                const f32x4 s = acc[cb][ib] + bs;
                u32x2 o; o.x = pk2(bflo(uw.x) * s[0] * silu(bflo(gw.x)), bfhi(uw.x) * s[1] * silu(bfhi(gw.x)));
                o.y = pk2(bflo(uw.y) * s[2] * silu(bflo(gw.y)), bfhi(uw.y) * s[3] * silu(bfhi(gw.y)));
                *(u32x2*)(YB + row * 1024 + ch) = o; } }
    }
}
__device__ __forceinline__ void gmlp_sample_item(int layer, int b, int lane) {
    CArgs& a = kargs();
    const bf16_t* P = (const bf16_t*)(a.ws + WS_P); bf16_t* YB = (bf16_t*)(a.ws + WS_YB);
    const float* lng = a.in[19] + layer * 1024 + lane * 16; const float* lnb = a.in[20] + layer * 1024 + lane * 16;
    const int g = lane >> 3;
    const float* Ws = a.in[21] + (size_t)(layer * 8 + g) * 128 * 128; const float* bsp = a.in[22] + (size_t)(layer * 8 + g) * 128;
    float vn[4][16];
#pragma unroll
    for (int t = 0; t < 4; ++t) { const size_t row = (size_t)(TP + b * 4 + t); const bf16_t* rp = P + row * NP + C_VB + lane * 16;
        float x[16]; { float t8[8]; unpack8(*(const u32x4*)rp, t8);
#pragma unroll
            for (int e = 0; e < 8; ++e) x[e] = t8[e];
            unpack8(*(const u32x4*)(rp + 8), t8);
#pragma unroll
            for (int e = 0; e < 8; ++e) x[8 + e] = t8[e]; }
        float s = 0.f;
#pragma unroll
        for (int e = 0; e < 16; ++e) s += x[e];
        const float mean = wave_sum(s) * (1.f / 1024.f); float s2 = 0.f;
#pragma unroll
        for (int e = 0; e < 16; ++e) { const float d = x[e] - mean; s2 += d * d; }
        const float rstd = 1.f / sqrtf(wave_sum(s2) * (1.f / 1024.f) + 1e-5f);
        float* ov = a.out + O_GV + ((size_t)(layer * 128 + b) * 4 + t) * 1024 + lane * 16;
#pragma unroll
        for (int e = 0; e < 16; ++e) vn[t][e] = (x[e] - mean) * rstd * lng[e] + lnb[e];
#pragma unroll
        for (int e = 0; e < 16; e += 4) *(f32x4*)(ov + e) = (f32x4){vn[t][e], vn[t][e + 1], vn[t][e + 2], vn[t][e + 3]}; }
#pragma unroll
    for (int i = 0; i < 4; ++i) { const size_t row = (size_t)(TP + b * 4 + i);
        float s[16]; const float bs = bsp[i];
#pragma unroll
        for (int e = 0; e < 16; ++e) s[e] = bs;
#pragma unroll
        for (int j = 0; j < 4; ++j) if (j <= i) { const float wv = Ws[i * 128 + j];
#pragma unroll
            for (int e = 0; e < 16; ++e) s[e] += wv * vn[j][e]; }
        float ub[16], gb[16];
        { float t8[8]; unpack8(*(const u32x4*)(P + row * NP + C_UB + lane * 16), t8);
#pragma unroll
          for (int e = 0; e < 8; ++e) ub[e] = t8[e];
          unpack8(*(const u32x4*)(P + row * NP + C_UB + lane * 16 + 8), t8);
#pragma unroll
          for (int e = 0; e < 8; ++e) ub[8 + e] = t8[e];
          unpack8(*(const u32x4*)(P + row * NP + C_GB + lane * 16), t8);
#pragma unroll
          for (int e = 0; e < 8; ++e) gb[e] = t8[e];
          unpack8(*(const u32x4*)(P + row * NP + C_GB + lane * 16 + 8), t8);
#pragma unroll
          for (int e = 0; e < 8; ++e) gb[8 + e] = t8[e]; }
        float o0[8], o1[8];
#pragma unroll
        for (int e = 0; e < 8; ++e) { o0[e] = ub[e] * s[e] * silu(gb[e]); o1[e] = ub[8 + e] * s[8 + e] * silu(gb[8 + e]); }
        *(u32x4*)(YB + row * 1024 + lane * 16) = pack8(o0); *(u32x4*)(YB + row * 1024 + lane * 16 + 8) = pack8(o1); }
}

template <bool SAMPLE>
__device__ __forceinline__ void gdn_item_v1(int layer, int item, const int tid) {
    CArgs& a = kargs(); LAS unsigned char* lds = lds_base();
    const int lane = tid & 63, w = tid >> 6;
    const int b = item >> 3, h = item & 7;
    const int T = SAMPLE ? 4 : 2048, rbase = SAMPLE ? TP + b * 4 : b * 2048, NB = SAMPLE ? 128 : 4;
    const bf16_t* P = (const bf16_t*)(a.ws + WS_P); const float* AB = (const float*)(a.ws + WS_AB); bf16_t* YC = (bf16_t*)(a.ws + WS_YC);
    const float* convw = a.in[24] + (size_t)layer * 4 * 3072;
    const float* sconv = a.in[5] + (size_t)(layer * 128 + b) * 3 * 3072;
    LAS float* qs = (LAS float*)lds; LAS float* ks = qs + 64 * 128; LAS float* vs = ks + 64 * 128;
    LAS float* red = vs + 64 * 128; LAS float* red2 = red + 512; LAS float* av = red2 + 512; LAS float* bv = av + 64;
    const int dv = (w & 1) * 64 + lane, sl = w >> 1, dk0 = sl * 32;
    float S[32];
    if (SAMPLE) { const float* s0 = a.in[4] + ((size_t)((layer * 128 + b) * 8 + h) * 128 + dk0) * 128 + dv;
#pragma unroll
        for (int i = 0; i < 32; ++i) S[i] = s0[(size_t)i * 128]; }
    else {
#pragma unroll
        for (int i = 0; i < 32; ++i) S[i] = 0.f; }
    const float Aexp = expf(a.in[25][layer * 8 + h]), dtb = a.in[26][layer * 8 + h];
    for (int c0 = 0; c0 < T; c0 += 64) {
        const int n = (T - c0) < 64 ? (T - c0) : 64;
        __syncthreads();
        for (int idx = tid; idx < n * 384; idx += 512) {
            const int t = idx / 384, ch = idx - t * 384, sec = ch >> 7, cc = ch & 127, col = sec * 1024 + h * 128 + cc, tg = c0 + t;
            float accv = 0.f;
#pragma unroll
            for (int j = 0; j < 4; ++j) { const int tt = tg - 3 + j; float x;
                if (tt >= 0) x = bf2f(P[(size_t)(rbase + tt) * NP + C_QKV + col]);
                else x = SAMPLE ? sconv[(3 + tt) * 3072 + col] : 0.f;
                accv += convw[j * 3072 + col] * x; }
            const float y = silu(accv);
            LAS float* dst = sec == 0 ? qs : (sec == 1 ? ks : vs); dst[t * 128 + cc] = y;
        }
        if (tid < n) { const size_t row = (size_t)(rbase + c0 + tid); const float ac = AB[row * 16 + h], bc = AB[row * 16 + 8 + h];
            const float gg = -Aexp * softplus(ac + dtb); av[tid] = expf(gg); bv[tid] = sigm(bc); }
        __syncthreads();
        for (int t = w; t < n; t += 8) {
            { const float q0 = qs[t * 128 + lane], q1 = qs[t * 128 + 64 + lane]; const float ss = wave_sum(q0 * q0 + q1 * q1);
              const float r = (1.f / sqrtf(ss + 1e-6f)) * 0.08838834764831845f; qs[t * 128 + lane] = q0 * r; qs[t * 128 + 64 + lane] = q1 * r; }
            { const float k0 = ks[t * 128 + lane], k1 = ks[t * 128 + 64 + lane]; const float ss = wave_sum(k0 * k0 + k1 * k1);
              const float r = 1.f / sqrtf(ss + 1e-6f); ks[t * 128 + lane] = k0 * r; ks[t * 128 + 64 + lane] = k1 * r; }
        }
        __syncthreads();
        for (int t = 0; t < n; ++t) {
            const float at = av[t], bt = bv[t];
            float p = 0.f;
#pragma unroll
            for (int i = 0; i < 32; i += 4) { const f32x4 kk = *(const LAS f32x4*)(ks + t * 128 + dk0 + i);
                p += kk[0] * S[i] + kk[1] * S[i + 1] + kk[2] * S[i + 2] + kk[3] * S[i + 3]; }
            red[sl * 128 + dv] = p;
            __syncthreads();
            const float kS = (red[dv] + red[128 + dv]) + (red[256 + dv] + red[384 + dv]);
            const float vnew = bt * (vs[t * 128 + dv] - at * kS);
            float po = 0.f;
#pragma unroll
            for (int i = 0; i < 32; i += 4) { const f32x4 kk = *(const LAS f32x4*)(ks + t * 128 + dk0 + i), qq = *(const LAS f32x4*)(qs + t * 128 + dk0 + i);
#pragma unroll
                for (int e = 0; e < 4; ++e) { S[i + e] = at * S[i + e] + kk[e] * vnew; po += qq[e] * S[i + e]; } }
            red2[sl * 128 + dv] = po;
            __syncthreads();
            if (sl == 0) vs[t * 128 + dv] = (red2[dv] + red2[128 + dv]) + (red2[256 + dv] + red2[384 + dv]);
        }
        __syncthreads();
        const float* ng = a.in[27] + layer * 128;
        for (int t = w; t < n; t += 8) {
            const float o0 = vs[t * 128 + lane], o1 = vs[t * 128 + 64 + lane]; const float ss = wave_sum(o0 * o0 + o1 * o1);
            const float r = 1.f / sqrtf(ss * (1.f / 128.f) + 1e-6f); const size_t row = (size_t)(rbase + c0 + t);
            const float g0 = bf2f(P[row * NP + C_GATEC + h * 128 + lane]), g1 = bf2f(P[row * NP + C_GATEC + h * 128 + 64 + lane]);
            YC[row * 1024 + h * 128 + lane] = (bf16_t)f2bf(o0 * r * ng[lane] * silu(g0));
            YC[row * 1024 + h * 128 + 64 + lane] = (bf16_t)f2bf(o1 * r * ng[64 + lane] * silu(g1));
        }
    }
    { float* so = a.out + (SAMPLE ? O_DS : O_DP) + ((size_t)((layer * NB + b) * 8 + h) * 128 + dk0) * 128 + dv;
#pragma unroll
      for (int i = 0; i < 32; ++i) so[(size_t)i * 128] = S[i]; }
    { float* co = a.out + (SAMPLE ? O_CS : O_CP) + (size_t)(layer * NB + b) * 3 * 3072;
      for (int idx = tid; idx < 3 * 384; idx += 512) { const int r = idx / 384, ch = idx - r * 384, col = (ch >> 7) * 1024 + h * 128 + (ch & 127);
          co[r * 3072 + col] = bf2f(P[(size_t)(rbase + T - 3 + r) * NP + C_QKV + col]); } }
}


constexpr size_t WS_GC = WS_M32;
constexpr int GC_STRIDE = 98304, GC_WN = 0, GC_QG = 16384, GC_KG = 32768, GC_AT = 49152, GC_U = 57344, GC_GAMMA = 90112, GC_OPS = 57344;
static_assert(WS_GC + (size_t)1024 * GC_STRIDE <= WS_H32, "chunk buffers fit in the M32|MB overlay");
constexpr int GP_QR = 0, GP_KR = 17408, GP_KBR = 34816, GP_VT = 52224, GP_KGT = 70656, GP_KT2 = 89088, GP_LM = 107520, GP_TM = 124928, GP_AS = 134144,
              GP_GC = 143360, GP_BETA = 143616, GP_GRAW = 143872, GP_WST = 0;
#define MFMA32(a, b, c) __builtin_amdgcn_mfma_f32_32x32x16_bf16((a), (b), (c), 0, 0, 0)

__device__ __forceinline__ void gdn_prep_item(int layer, int item, const int tid) {
    CArgs& a = kargs(); LAS unsigned char* lds = lds_base();
    const int lane = tid & 63, w = __builtin_amdgcn_readfirstlane(tid >> 6), hh = lane >> 5, l31 = lane & 31;
    const int b = item >> 8, h = (item >> 5) & 7, n = item & 31;
    const bf16_t* P = (const bf16_t*)(a.ws + WS_P); const float* AB = (const float*)(a.ws + WS_AB);
    unsigned char* gc = a.ws + WS_GC + (size_t)item * GC_STRIDE;
    const int t = tid >> 3, cg = tid & 7;
    const int r0 = b * 2048 + n * 64;
    __syncthreads();
    float qv[16], kv[16], vv[16];
    {
        const float* convw = a.in[24] + (size_t)layer * 4 * 3072;
#pragma unroll
        for (int sec = 0; sec < 3; ++sec) {
            const int ch = sec * 1024 + h * 128 + 16 * cg;
            float acc[16];
#pragma unroll
            for (int e = 0; e < 16; ++e) acc[e] = 0.f;
#pragma unroll
            for (int j = 0; j < 4; ++j) {
                const int tt = n * 64 + t - 3 + j;
                float x[16];
                if (tt >= 0) { const bf16_t* rp = P + (size_t)(b * 2048 + tt) * NP + C_QKV + ch; float t8[8];
                    unpack8(*(const u32x4*)rp, t8);
#pragma unroll
                    for (int e = 0; e < 8; ++e) x[e] = t8[e];
                    unpack8(*(const u32x4*)(rp + 8), t8);
#pragma unroll
                    for (int e = 0; e < 8; ++e) x[8 + e] = t8[e]; }
                else {
#pragma unroll
                    for (int e = 0; e < 16; ++e) x[e] = 0.f; }
                const float* wp = convw + j * 3072 + ch;
#pragma unroll
                for (int e = 0; e < 16; e += 4) { const f32x4 wv = *(const f32x4*)(wp + e);
                    acc[e] += wv[0] * x[e]; acc[e + 1] += wv[1] * x[e + 1]; acc[e + 2] += wv[2] * x[e + 2]; acc[e + 3] += wv[3] * x[e + 3]; }
                if (j == 3 && n == 31 && t >= 61) { float* co = a.out + O_CP + ((size_t)(layer * 4 + b) * 3 + (t - 61)) * 3072 + ch;
#pragma unroll
                    for (int e = 0; e < 16; e += 4) *(f32x4*)(co + e) = (f32x4){x[e], x[e + 1], x[e + 2], x[e + 3]}; }
            }
            float ss = 0.f;
#pragma unroll
            for (int e = 0; e < 16; ++e) { acc[e] = silu(acc[e]); ss += acc[e] * acc[e]; }
            if (sec < 2) { ss += __shfl_xor(ss, 1); ss += __shfl_xor(ss, 2); ss += __shfl_xor(ss, 4);
                const float r = (1.f / sqrtf(ss + 1e-6f)) * (sec == 0 ? 0.08838834764831845f : 1.f);
#pragma unroll
                for (int e = 0; e < 16; ++e) { if (sec == 0) qv[e] = acc[e] * r; else kv[e] = acc[e] * r; } }
            else {
#pragma unroll
                for (int e = 0; e < 16; ++e) vv[e] = acc[e]; }
        }
        if (cg == 0) { const size_t row = (size_t)(r0 + t); const float ac = AB[row * 16 + h], bc = AB[row * 16 + 8 + h];
            const float Aexp = expf(a.in[25][layer * 8 + h]), dtb = a.in[26][layer * 8 + h];
            *(LAS float*)(lds + GP_GRAW + 4 * t) = -Aexp * softplus(ac + dtb); *(LAS float*)(lds + GP_BETA + 4 * t) = sigm(bc); }
    }
    __syncthreads();
    if (w == 0) { float g = *(LAS float*)(lds + GP_GRAW + 4 * lane);
#pragma unroll
        for (int o = 1; o < 64; o <<= 1) { const float y = __shfl_up(g, o); if (lane >= o) g += y; }
        *(LAS float*)(lds + GP_GC + 4 * lane) = g; }
    __syncthreads();
    {
        const float gct = *(LAS float*)(lds + GP_GC + 4 * t), bt = *(LAS float*)(lds + GP_BETA + 4 * t), gl = *(LAS float*)(lds + GP_GC + 4 * 63);
        const float eg = expf(gct), egl = expf(gl - gct);
        float tq[8], tk[8], tb[8];
#pragma unroll
        for (int half = 0; half < 2; ++half) {
#pragma unroll
            for (int e = 0; e < 8; ++e) { tq[e] = qv[8 * half + e]; tk[e] = kv[8 * half + e]; tb[e] = kv[8 * half + e] * bt; }
            *(LAS u32x4*)(lds + GP_QR + t * 272 + (16 * cg + 8 * half) * 2) = pack8(tq);
            *(LAS u32x4*)(lds + GP_KR + t * 272 + (16 * cg + 8 * half) * 2) = pack8(tk);
            *(LAS u32x4*)(lds + GP_KBR + t * 272 + (16 * cg + 8 * half) * 2) = pack8(tb);
        }
#pragma unroll
        for (int d = 0; d < 16; ++d) { const int rowd = 16 * cg + d;
            *(LAS bf16_t*)(lds + GP_VT + rowd * 144 + 2 * t) = (bf16_t)f2bf(vv[d] * bt);
            *(LAS bf16_t*)(lds + GP_KGT + rowd * 144 + 2 * t) = (bf16_t)f2bf(kv[d] * bt * eg);
            *(LAS bf16_t*)(lds + GP_KT2 + rowd * 144 + 2 * t) = (bf16_t)f2bf(kv[d] * egl); }
#pragma unroll
        for (int hq = 0; hq < 2; ++hq) { float o8[8];
#pragma unroll
            for (int j = 0; j < 8; ++j) o8[j] = qv[8 * (j >> 2) + 4 * hq + (j & 3)] * eg;
            *(u32x4*)(gc + GC_QG + ((((t >> 5) * 4 + (cg >> 1)) * 2 + (cg & 1)) * 64 + (t & 31) + 32 * hq) * 16) = pack8(o8); }
        if (tid == 0) *(float*)(gc + GC_GAMMA) = expf(gl);
    }
    __syncthreads();
    {
        const int typ = w >> 2, mi = (w >> 1) & 1, nj = w & 1;
        f32x16 acc;
#pragma unroll
        for (int r = 0; r < 16; ++r) acc[r] = 0.f;
        if (!(mi == 0 && nj == 1)) {
            const LAS unsigned char* Ab = lds + (typ ? GP_QR : GP_KBR) + (32 * mi + l31) * 272 + 16 * hh;
            const LAS unsigned char* Bb = lds + GP_KR + (32 * nj + l31) * 272 + 16 * hh;
#pragma unroll
            for (int ks = 0; ks < 8; ++ks) acc = MFMA32(*(const LAS bf16x8*)(Ab + 32 * ks), *(const LAS bf16x8*)(Bb + 32 * ks), acc);
        }
        const int j = 32 * nj + l31; const float gcj = *(LAS float*)(lds + GP_GC + 4 * j);
#pragma unroll
        for (int r = 0; r < 16; ++r) { const int i = 32 * mi + (r & 3) + 8 * (r >> 2) + 4 * hh;
            const float gci = *(LAS float*)(lds + GP_GC + 4 * i);
            const float d = (i >= j) ? expf(gci - gcj) : 0.f;
            if (typ == 0) *(LAS float*)(lds + GP_LM + i * 272 + 4 * j) = (i > j) ? acc[r] * d : 0.f;
            else *(LAS bf16_t*)(lds + GP_AS + i * 144 + 2 * j) = (bf16_t)f2bf((i >= j) ? acc[r] * d : 0.f); }
    }
    __syncthreads();
    if (w == 0) {
        float x[64];
#pragma unroll
        for (int i = 0; i < 64; ++i) {
            float s0 = (i == lane) ? 1.f : 0.f, s1 = 0.f;
#pragma unroll
            for (int j4 = 0; j4 < (i + 3) / 4; ++j4) { const f32x4 l4 = *(const LAS f32x4*)(lds + GP_LM + i * 272 + 16 * j4);
#pragma unroll
                for (int e = 0; e < 4; ++e) { const int j = 4 * j4 + e; if (j < i) { if (e & 1) s1 -= l4[e] * x[j]; else s0 -= l4[e] * x[j]; } } }
            x[i] = s0 + s1;
        }
#pragma unroll
        for (int i = 0; i < 64; ++i) *(LAS bf16_t*)(lds + GP_TM + i * 144 + 2 * lane) = (bf16_t)f2bf(x[i]);
    } else {
        for (int task = tid - 64; task < 1536; task += 448) {
            const int ll = task & 63, hq = ll >> 5;
            if (task < 1024) { const int f = task >> 6, db = f >> 2, tb = (f >> 1) & 1, s = f & 1, dk = 32 * db + (ll & 31), t0 = 32 * tb + 16 * s + 4 * hq;
                const u32x2 lo = *(const LAS u32x2*)(lds + GP_KT2 + dk * 144 + 2 * t0), hi = *(const LAS u32x2*)(lds + GP_KT2 + dk * 144 + 2 * (t0 + 8));
                *(u32x4*)(gc + GC_KG + (f * 64 + ll) * 16) = (u32x4){lo.x, lo.y, hi.x, hi.y}; }
            else { const int f = (task - 1024) >> 6, mb = f >> 2, tb = (f >> 1) & 1, s = f & 1, i = 32 * mb + (ll & 31), j0 = 32 * tb + 16 * s + 4 * hq;
                const u32x2 lo = *(const LAS u32x2*)(lds + GP_AS + i * 144 + 2 * j0), hi = *(const LAS u32x2*)(lds + GP_AS + i * 144 + 2 * (j0 + 8));
                *(u32x4*)(gc + GC_AT + (f * 64 + ll) * 16) = (u32x4){lo.x, lo.y, hi.x, hi.y}; }
        }
    }
    __syncthreads();
    {
        const LAS unsigned char* Bb = lds + (w < 4 ? GP_VT : GP_KGT) + (32 * (w & 3) + l31) * 144 + 16 * hh;
#pragma unroll
        for (int mb = 0; mb < 2; ++mb) {
            f32x16 acc;
#pragma unroll
            for (int r = 0; r < 16; ++r) acc[r] = 0.f;
            const LAS unsigned char* Ab = lds + GP_TM + (32 * mb + l31) * 144 + 16 * hh;
#pragma unroll
            for (int ks = 0; ks < 4; ++ks) acc = MFMA32(*(const LAS bf16x8*)(Ab + 32 * ks), *(const LAS bf16x8*)(Bb + 32 * ks), acc);
            if (w < 4) { float* up = (float*)(gc + GC_U) + ((w * 2 + mb) * 16) * 64 + lane;
#pragma unroll
                for (int r = 0; r < 16; ++r) up[r * 64] = acc[r]; }
            else {
#pragma unroll
                for (int r = 0; r < 16; ++r) { const int tt = 32 * mb + (r & 3) + 8 * (r >> 2) + 4 * hh;
                    *(LAS bf16_t*)(lds + GP_WST + tt * 272 + 2 * (32 * (w - 4) + l31)) = (bf16_t)f2bf(-acc[r]); } }
        }
    }
    __syncthreads();
#pragma unroll
    for (int q = 0; q < 2; ++q) { const int task = tid + 512 * q, f = task >> 6, ll = task & 63, hq = ll >> 5, mb = f >> 3, kb = (f >> 1) & 3, s = f & 1;
        const int tt = 32 * mb + (ll & 31), d0 = 32 * kb + 16 * s + 4 * hq;
        const u32x2 lo = *(const LAS u32x2*)(lds + GP_WST + tt * 272 + 2 * d0), hi = *(const LAS u32x2*)(lds + GP_WST + tt * 272 + 2 * (d0 + 8));
        *(u32x4*)(gc + GC_WN + (f * 64 + ll) * 16) = (u32x4){lo.x, lo.y, hi.x, hi.y}; }
}

__device__ __forceinline__ bf16x8 cvt_frag(const f32x16& v, int s) {
    u32x4 w; w.x = pk2(v[8 * s], v[8 * s + 1]); w.y = pk2(v[8 * s + 2], v[8 * s + 3]); w.z = pk2(v[8 * s + 4], v[8 * s + 5]); w.w = pk2(v[8 * s + 6], v[8 * s + 7]);
    return __builtin_bit_cast(bf16x8, w);
}
constexpr int CH_OB = 2 * GC_OPS;
__device__ __forceinline__ void gdn_chain(int layer, int bh, const int tid) {
    CArgs& a = kargs(); LAS unsigned char* lds = lds_base();
    const int lane = tid & 63, w = __builtin_amdgcn_readfirstlane(tid >> 6), hh = lane >> 5, l31 = lane & 31;
    const int b = bh >> 3, h = bh & 7;
    const unsigned char* gcb = a.ws + WS_GC + (size_t)bh * 32 * GC_STRIDE;
    __syncthreads();
    if (w >= 4) {
        const int lt = tid - 256;
        const bf16_t* P = (const bf16_t*)(a.ws + WS_P); bf16_t* YC = (bf16_t*)(a.ws + WS_YC);
        const float* ng = a.in[27] + layer * 128;
        {
#pragma unroll
            for (int i = 0; i < 14; ++i) *(LAS u32x4*)(lds + (i * 256 + lt) * 16) = *(const u32x4*)(gcb + (i * 256 + lt) * 16); }
        __syncthreads();
        for (int c = 0; c < 33; ++c) {
            if (c >= 1) {
                const int cc = c - 1, tt = lt >> 2, qd = lt & 3; const size_t row = (size_t)(b * 2048 + cc * 64 + tt);
                const LAS unsigned char* ob = lds + CH_OB + (cc & 1) * 16384 + tt * 256 + qd * 64;
                float o[32]; float ss = 0.f;
#pragma unroll
                for (int q = 0; q < 4; ++q) { float t8[8]; unpack8(*(const LAS u32x4*)(ob + 16 * q), t8);
#pragma unroll
                    for (int e = 0; e < 8; ++e) { o[8 * q + e] = t8[e]; ss += t8[e] * t8[e]; } }
                ss += __shfl_xor(ss, 1); ss += __shfl_xor(ss, 2);
                const float r = 1.f / sqrtf(ss * (1.f / 128.f) + 1e-6f);
                const bf16_t* gp = P + row * NP + C_GATEC + h * 128 + qd * 32; bf16_t* yp = YC + row * 1024 + h * 128 + qd * 32;
#pragma unroll
                for (int q = 0; q < 4; ++q) { float g8[8], o8[8]; unpack8(*(const u32x4*)(gp + 8 * q), g8);
                    const f32x4 n0 = *(const f32x4*)(ng + qd * 32 + 8 * q), n1 = *(const f32x4*)(ng + qd * 32 + 8 * q + 4);
#pragma unroll
                    for (int e = 0; e < 8; ++e) o8[e] = o[8 * q + e] * r * (e < 4 ? n0[e & 3] : n1[e & 3]) * silu(g8[e]);
                    *(u32x4*)(yp + 8 * q) = pack8(o8); }
            }
            if (c + 1 < 32) { const unsigned char* src = gcb + (size_t)(c + 1) * GC_STRIDE; LAS unsigned char* dst = lds + ((c + 1) & 1) * GC_OPS;
#pragma unroll
                for (int i = 0; i < 14; ++i) *(LAS u32x4*)(dst + (i * 256 + lt) * 16) = *(const u32x4*)(src + (i * 256 + lt) * 16); }
            if (c < 32) __syncthreads();
        }
    } else {
        f32x16 S[4];
#pragma unroll
        for (int kb = 0; kb < 4; ++kb)
#pragma unroll
            for (int r = 0; r < 16; ++r) S[kb][r] = 0.f;
        f32x16 un[2];
        { const float* up = (const float*)(gcb + GC_U) + (w * 2 * 16) * 64 + lane;
#pragma unroll
          for (int mb = 0; mb < 2; ++mb)
#pragma unroll
            for (int r = 0; r < 16; ++r) un[mb][r] = up[(mb * 16 + r) * 64]; }
        __syncthreads();
        for (int c = 0; c < 32; ++c) {
            const LAS unsigned char* ops = lds + (c & 1) * GC_OPS + lane * 16;
            const float gamma = *(const float*)(gcb + (size_t)c * GC_STRIDE + GC_GAMMA);
            f32x16 va[2], oa[2];
            va[0] = un[0]; va[1] = un[1];
#pragma unroll
            for (int r = 0; r < 16; ++r) { oa[0][r] = 0.f; oa[1][r] = 0.f; }
            if (c + 1 < 32) { const float* up = (const float*)(gcb + (size_t)(c + 1) * GC_STRIDE + GC_U) + (w * 2 * 16) * 64 + lane;
#pragma unroll
                for (int mb = 0; mb < 2; ++mb)
#pragma unroll
                    for (int r = 0; r < 16; ++r) un[mb][r] = up[(mb * 16 + r) * 64]; }
#pragma unroll
            for (int kb = 0; kb < 4; ++kb)
#pragma unroll
                for (int s = 0; s < 2; ++s) { const bf16x8 Bs = cvt_frag(S[kb], s);
#pragma unroll
                    for (int mb = 0; mb < 2; ++mb) { const int f = (mb * 4 + kb) * 2 + s;
                        va[mb] = MFMA32(*(const LAS bf16x8*)(ops + GC_WN + f * 1024), Bs, va[mb]);
                        oa[mb] = MFMA32(*(const LAS bf16x8*)(ops + GC_QG + f * 1024), Bs, oa[mb]); } }
#pragma unroll
            for (int kb = 0; kb < 4; ++kb)
#pragma unroll
                for (int r = 0; r < 16; ++r) S[kb][r] *= gamma;
#pragma unroll
            for (int tb = 0; tb < 2; ++tb)
#pragma unroll
                for (int s = 0; s < 2; ++s) { const bf16x8 Bv = cvt_frag(va[tb], s);
#pragma unroll
                    for (int kb = 0; kb < 4; ++kb) S[kb] = MFMA32(*(const LAS bf16x8*)(ops + GC_KG + ((kb * 2 + tb) * 2 + s) * 1024), Bv, S[kb]);
#pragma unroll
                    for (int mb = 0; mb < 2; ++mb) if (mb >= tb) oa[mb] = MFMA32(*(const LAS bf16x8*)(ops + GC_AT + ((mb * 2 + tb) * 2 + s) * 1024), Bv, oa[mb]); }
            LAS unsigned char* ob = lds + CH_OB + (c & 1) * 16384;
#pragma unroll
            for (int mb = 0; mb < 2; ++mb)
#pragma unroll
                for (int r = 0; r < 16; ++r) { const int tt = 32 * mb + (r & 3) + 8 * (r >> 2) + 4 * hh;
                    *(LAS bf16_t*)(ob + tt * 256 + 2 * (32 * w + l31)) = (bf16_t)f2bf(oa[mb][r]); }
            __syncthreads();
        }
        float* so = a.out + O_DP + (size_t)((layer * 4 + b) * 8 + h) * 128 * 128 + 32 * w + l31;
#pragma unroll
        for (int kb = 0; kb < 4; ++kb)
#pragma unroll
            for (int r = 0; r < 16; ++r) so[(size_t)(32 * kb + (r & 3) + 8 * (r >> 2) + 4 * hh) * 128] = S[kb][r];
    }
}

__device__ __forceinline__ void gdn_sample_item(int layer, int item, const int tid) {
    CArgs& a = kargs(); LAS unsigned char* lds = lds_base();
    const int lane = tid & 63, w = __builtin_amdgcn_readfirstlane(tid >> 6);
    const int b = item >> 3, h = item & 7, rbase = TP + b * 4;
    const bf16_t* P = (const bf16_t*)(a.ws + WS_P); const float* AB = (const float*)(a.ws + WS_AB); bf16_t* YC = (bf16_t*)(a.ws + WS_YC);
    LAS float* qs = (LAS float*)lds; LAS float* ks = qs + 512; LAS float* vs = ks + 512;
    LAS float* red = vs + 512;
    LAS float* dots = red + 4096; LAS float* gcv = dots + 32; LAS float* btv = gcv + 4; LAS float* ob = btv + 4;
    const int dv = (w & 1) * 64 + lane, sl = w >> 1, dk0 = sl * 32;
    float S[32];
    { const float* s0 = a.in[4] + ((size_t)((layer * 128 + b) * 8 + h) * 128 + dk0) * 128 + dv;
#pragma unroll
      for (int i = 0; i < 32; ++i) S[i] = s0[(size_t)i * 128]; }
    __syncthreads();
    {
        const float* convw = a.in[24] + (size_t)layer * 4 * 3072; const float* sconv = a.in[5] + (size_t)(layer * 128 + b) * 3 * 3072;
        float* co = a.out + O_CS + (size_t)(layer * 128 + b) * 3 * 3072;
        for (int idx = tid; idx < 4 * 384; idx += 512) {
            const int t = idx / 384, ch = idx - t * 384, sec = ch >> 7, cc = ch & 127, col = sec * 1024 + h * 128 + cc;
            float accv = 0.f;
#pragma unroll
            for (int j = 0; j < 4; ++j) { const int tt = t - 3 + j;
                const float x = (tt >= 0) ? bf2f(P[(size_t)(rbase + tt) * NP + C_QKV + col]) : sconv[(3 + tt) * 3072 + col];
                if (j == 3 && t >= 1) co[(t - 1) * 3072 + col] = x;
                accv += convw[j * 3072 + col] * x; }
            LAS float* dst = sec == 0 ? qs : (sec == 1 ? ks : vs); dst[t * 128 + cc] = silu(accv);
        }
        if (tid < 4) { const size_t row = (size_t)(rbase + tid); const float ac = AB[row * 16 + h], bc = AB[row * 16 + 8 + h];
            gcv[tid] = -expf(a.in[25][layer * 8 + h]) * softplus(ac + a.in[26][layer * 8 + h]); btv[tid] = sigm(bc); }
    }
    __syncthreads();
    if (w < 4) { const int t = w;
        { const float q0 = qs[t * 128 + lane], q1 = qs[t * 128 + 64 + lane]; const float ss = wave_sum(q0 * q0 + q1 * q1);
          const float r = (1.f / sqrtf(ss + 1e-6f)) * 0.08838834764831845f; qs[t * 128 + lane] = q0 * r; qs[t * 128 + 64 + lane] = q1 * r; }
        { const float k0 = ks[t * 128 + lane], k1 = ks[t * 128 + 64 + lane]; const float ss = wave_sum(k0 * k0 + k1 * k1);
          const float r = 1.f / sqrtf(ss + 1e-6f); ks[t * 128 + lane] = k0 * r; ks[t * 128 + 64 + lane] = k1 * r; } }
    __syncthreads();
    {
#pragma unroll
        for (int q = 0; q < 4; ++q) { const int id = w * 4 + q, typ = id >> 4, i = (id >> 2) & 3, j = id & 3;
            const LAS float* xa = (typ ? qs : ks) + i * 128; const LAS float* xb = ks + j * 128;
            const float d = wave_sum(xa[lane] * xb[lane] + xa[64 + lane] * xb[64 + lane]);
            if (lane == 0) dots[id] = d; }
        float pk[4], pq[4];
#pragma unroll
        for (int j = 0; j < 4; ++j) { pk[j] = 0.f; pq[j] = 0.f; }
#pragma unroll
        for (int i = 0; i < 32; i += 4)
#pragma unroll
            for (int j = 0; j < 4; ++j) { const f32x4 kk = *(const LAS f32x4*)(ks + j * 128 + dk0 + i), qq = *(const LAS f32x4*)(qs + j * 128 + dk0 + i);
                pk[j] += kk[0] * S[i] + kk[1] * S[i + 1] + kk[2] * S[i + 2] + kk[3] * S[i + 3];
                pq[j] += qq[0] * S[i] + qq[1] * S[i + 1] + qq[2] * S[i + 2] + qq[3] * S[i + 3]; }
#pragma unroll
        for (int j = 0; j < 4; ++j) { red[(j * 4 + sl) * 128 + dv] = pk[j]; red[((4 + j) * 4 + sl) * 128 + dv] = pq[j]; }
    }
    __syncthreads();
    {
        float gc[4], bt[4];
        gc[0] = gcv[0]; gc[1] = gc[0] + gcv[1]; gc[2] = gc[1] + gcv[2]; gc[3] = gc[2] + gcv[3];
#pragma unroll
        for (int j = 0; j < 4; ++j) bt[j] = btv[j];
        float L[4][4], Tm[4][4];
#pragma unroll
        for (int i = 0; i < 4; ++i)
#pragma unroll
            for (int j = 0; j < 4; ++j) L[i][j] = (i > j) ? bt[i] * dots[i * 4 + j] * expf(gc[i] - gc[j]) : 0.f;
#pragma unroll
        for (int i = 0; i < 4; ++i)
#pragma unroll
            for (int c = 0; c < 4; ++c) { float s = (i == c) ? 1.f : 0.f;
#pragma unroll
                for (int j = 0; j < 4; ++j) if (j < i) s -= L[i][j] * Tm[j][c];
                Tm[i][c] = s; }
        float kS[4], qS[4], rhs[4], vn[4];
#pragma unroll
        for (int j = 0; j < 4; ++j) { kS[j] = (red[(j * 4 + 0) * 128 + dv] + red[(j * 4 + 1) * 128 + dv]) + (red[(j * 4 + 2) * 128 + dv] + red[(j * 4 + 3) * 128 + dv]);
            qS[j] = (red[((4 + j) * 4 + 0) * 128 + dv] + red[((4 + j) * 4 + 1) * 128 + dv]) + (red[((4 + j) * 4 + 2) * 128 + dv] + red[((4 + j) * 4 + 3) * 128 + dv]);
            rhs[j] = bt[j] * (vs[j * 128 + dv] - expf(gc[j]) * kS[j]); }
#pragma unroll
        for (int i = 0; i < 4; ++i) { float s = 0.f;
#pragma unroll
            for (int j = 0; j < 4; ++j) if (j <= i) s += Tm[i][j] * rhs[j];
            vn[i] = s; }
        if (sl == 0) {
#pragma unroll
            for (int i = 0; i < 4; ++i) { float o = expf(gc[i]) * qS[i];
#pragma unroll
                for (int j = 0; j < 4; ++j) if (j <= i) o += dots[16 + i * 4 + j] * expf(gc[i] - gc[j]) * vn[j];
                ob[i * 128 + dv] = o; } }
        const float gl = gc[3], egl = expf(gl);
        float cf[4];
#pragma unroll
        for (int j = 0; j < 4; ++j) cf[j] = expf(gl - gc[j]) * vn[j];
        float* so = a.out + O_DS + ((size_t)((layer * 128 + b) * 8 + h) * 128 + dk0) * 128 + dv;
#pragma unroll
        for (int i = 0; i < 32; ++i) { float s = egl * S[i];
#pragma unroll
            for (int j = 0; j < 4; ++j) s += ks[j * 128 + dk0 + i] * cf[j];
            so[(size_t)i * 128] = s; }
    }
    __syncthreads();
    if (w < 4) { const int t = w; const float* ng = a.in[27] + layer * 128;
        const float o0 = ob[t * 128 + lane], o1 = ob[t * 128 + 64 + lane]; const float ss = wave_sum(o0 * o0 + o1 * o1);
        const float r = 1.f / sqrtf(ss * (1.f / 128.f) + 1e-6f); const size_t row = (size_t)(rbase + t);
        const float g0 = bf2f(P[row * NP + C_GATEC + h * 128 + lane]), g1 = bf2f(P[row * NP + C_GATEC + h * 128 + 64 + lane]);
        YC[row * 1024 + h * 128 + lane] = (bf16_t)f2bf(o0 * r * ng[lane] * silu(g0));
        YC[row * 1024 + h * 128 + 64 + lane] = (bf16_t)f2bf(o1 * r * ng[64 + lane] * silu(g1)); }
}

__device__ __forceinline__ void phase_mixers(int layer, int G, int bid, int tid0) {
#ifndef PROBE_MIX
#define PROBE_MIX -1
#endif
#define PM(x) (PROBE_MIX == -1 || PROBE_MIX == (x))
    if (bid < 80) {
        const int tid = launder_v(tid0), lane = tid & 63, w = __builtin_amdgcn_readfirstlane(tid >> 6);
        if (w < 4) { const int it = launder_s(launder_s(bid) * 4 + w);
            if (it < 256) { if (PM(1)) s5_item<false>(layer, it, w * S5_WLDS, lane); }
            else if (it < 320) { if (PM(2)) s5_item<true>(layer, it - 256, w * S5_WLDS, lane); } }
        return;
    }
    const int nw = G - 80;
    for (int it = bid - 80; it < 1024 + 64 + 16 + 1024; it += nw) {
        const int tid = launder_v(tid0), lane = tid & 63, w = tid >> 6;
        if (it < 1024) { if (PM(0)) gdn_prep_item(layer, launder_s(it), tid); }
        else if (it < 1088) { if (PM(3)) gmlp_prompt_item(layer, launder_s(it) - 1024, tid); }
        else if (it < 1104) { if (PM(4)) gmlp_sample_item(layer, (launder_s(it) - 1088) * 8 + w, lane); }
        else { if (PM(5)) gdn_sample_item(layer, launder_s(it) - 1104, tid); }
    }
}

__global__ void __launch_bounds__(512, 2) mega(Args karg) {
    const int ph_lo = karg.ph_lo, ph_hi = karg.ph_hi;
    for (int ph = ph_lo; ph < ph_hi; ++ph) {
        if (ph > ph_lo) { cg::this_grid().sync(); }
        const int G = launder_s((int)gridDim.x), bid = launder_s((int)blockIdx.x), tid = launder_v((int)threadIdx.x);
        CArgs& a = kargs(); LAS unsigned char* lds = lds_base();
        unsigned char* ws = a.ws;
#ifndef PROBE_SUB
#define PROBE_SUB -1
#endif
#define PS(x) (PROBE_SUB == -1 || PROBE_SUB == (x))
        if (ph == 0) { if (PS(6)) phase_convert(a, lds, G, bid, tid); continue; }
        const int layer = (ph - 1) / 6, sub = (ph - 1) % 6;
        unsigned char* wb = ws + WS_W0 + (size_t)layer * WS_WL;
        if (PS(0) && sub == 0) {
            pg8::Gemm g{(const bf16_t*)(ws + WS_XB), nullptr, nullptr, (const bf16_t*)(wb + WO_IN), nullptr, nullptr, DM};
            pg8::Sched S; S.init(MT / 256, NP / 256, 1, G, bid);
            pg8::Epi1 E{(bf16_t*)(ws + WS_P), (float*)(ws + WS_AB)};
            pg8::gemm_phase(lds, g, S, E, tid);
        } else if (PS(1) && sub == 1) {
            phase_mixers(layer, G, bid, tid);
        } else if (PS(2) && sub == 2) {
            if (bid < 32) { gdn_chain(layer, bid, tid); continue; }
            pg8::Gemm g{(const bf16_t*)(ws + WS_ZB), nullptr, nullptr, (const bf16_t*)(wb + WO_GLU), nullptr, nullptr, 1024};
            pg8::Sched S; S.init(MT / 256, 4, 1, G - 32, bid - 32);
            pg8::Epi2 E{(const bf16_t*)(ws + WS_ZB), (const bf16_t*)(ws + WS_P), a.in[17] + layer * 1024, (bf16_t*)(ws + WS_YA)};
            pg8::gemm_phase(lds, g, S, E, tid);
        } else if (PS(3) && sub == 3) {
            pg8::Gemm g{(const bf16_t*)(ws + WS_YA), (const bf16_t*)(ws + WS_YB), (const bf16_t*)(ws + WS_YC),
                        (const bf16_t*)(wb + WO_PA), (const bf16_t*)(wb + WO_PB), (const bf16_t*)(wb + WO_PC), 1024};
            pg8::Sched S; S.init(MT / 256, 8, 3, G, bid);
            pg8::Epi3 E{(const bf16_t*)(ws + WS_P), a.in[7] + layer * 3 * DM, (float*)(ws + WS_M32), (bf16_t*)(ws + WS_MB)};
            pg8::gemm_phase(lds, g, S, E, tid);
        } else if (PS(4) && sub == 4) {
            pg8::Gemm g{(const bf16_t*)(ws + WS_MB), nullptr, nullptr, (const bf16_t*)(wb + WO_OUT), nullptr, nullptr, DM};
            pg8::Sched S; S.init(MT / 256, 8, 1, G, bid);
            const float* xp = layer == 0 ? a.in[0] : (const float*)(ws + WS_X32);
            const float* xs = layer == 0 ? a.in[1] : (const float*)(ws + WS_X32) + (size_t)TP * DM;
            pg8::Epi4 E{xp, xs, (float*)(ws + WS_H32)};
            pg8::gemm_phase(lds, g, S, E, tid);
        } else if (PS(5) && sub == 5) {
            phase_ln(a, layer, G, bid, tid);
        }
    }
}

extern "C" void kernel_launch(void* const* d_in, const int* in_sizes, int n_in, void* d_out, int out_size, void* d_ws, size_t ws_size, hipStream_t stream) {
    static int grid = 0;
    if (grid == 0) {
        if (n_in != 32 || (size_t)out_size != O_END || ws_size < WS_END) {
            fprintf(stderr, "kernel_launch: unexpected problem: n_in %d out %d ws %zu (need %zu)\n", n_in, out_size, ws_size, (size_t)WS_END); grid = -1; return; }
        int dev = 0, cus = 0, per_cu = 0;
        if (hipGetDevice(&dev) != hipSuccess || hipDeviceGetAttribute(&cus, hipDeviceAttributeMultiprocessorCount, dev) != hipSuccess) { grid = -1; return; }
        if (hipFuncSetAttribute((const void*)mega, hipFuncAttributeMaxDynamicSharedMemorySize, LDS_BYTES) != hipSuccess) { fprintf(stderr, "kernel_launch: hipFuncSetAttribute failed\n"); grid = -1; return; }
        if (hipOccupancyMaxActiveBlocksPerMultiprocessor(&per_cu, (const void*)mega, 512, LDS_BYTES) != hipSuccess || per_cu < 1) {
            fprintf(stderr, "kernel_launch: occupancy query says %d blocks per CU\n", per_cu); (void)hipGetLastError(); grid = -1; return; }
        grid = cus;
    }
    if (grid < 0) return;
    Args a{};
    for (int i = 0; i < 32; ++i) a.in[i] = (const float*)d_in[i];
    a.out = (float*)d_out; a.ws = (unsigned char*)d_ws;
#if MK_SINGLE
    a.ph_lo = 0; a.ph_hi = NPHASE;
    void* params[] = {&a};
    hipError_t e = hipLaunchCooperativeKernel((const void*)mega, dim3(grid), dim3(512), params, LDS_BYTES, stream);
    if (e != hipSuccess) fprintf(stderr, "kernel_launch: cooperative launch failed: %s (grid %d)\n", hipGetErrorString(e), grid);
#else
    for (int ph = 0; ph < NPHASE; ++ph) {
        a.ph_lo = ph; a.ph_hi = ph + 1;
        hipLaunchKernelGGL(mega, dim3(grid), dim3(512), LDS_BYTES, stream, a);
    }
#endif
}
```

```cpp
#include <hip/hip_runtime.h>
#include <hip/hip_cooperative_groups.h>
#include <cstdio>
#include <cstdint>
namespace cg = cooperative_groups;

#ifndef MK_SINGLE
#define MK_SINGLE 1
#endif

#define LAS __attribute__((address_space(3)))
typedef unsigned short bf16_t;
typedef short bf16x8 __attribute__((ext_vector_type(8)));
typedef float f32x4 __attribute__((ext_vector_type(4)));
typedef float f32x2 __attribute__((ext_vector_type(2)));
typedef float f32x16 __attribute__((ext_vector_type(16)));
typedef unsigned u32x4 __attribute__((ext_vector_type(4)));
typedef unsigned u32x2 __attribute__((ext_vector_type(2)));

constexpr int DM = 2048, TP = 8192, TS = 512, MT = TP + TS;
constexpr int NIN = 15376, NP = 15616;
constexpr int C_XA = 0, C_GA = 1024, C_UB = 2048, C_VB = 3072, C_GB = 4096, C_QKV = 5120, C_GATEC = 8192, C_ZG = 9216, C_AB = 15360;
constexpr int NPHASE = 13;
constexpr float ALPHA = 1.41421356237f;

constexpr size_t MiB = 1u << 20;
constexpr size_t WS_CTL = 0;
constexpr size_t WS_W0 = 1 * MiB, WS_WL = 83 * MiB;
constexpr size_t WO_IN = 0, WO_GLU = 61 * MiB, WO_PA = 63 * MiB, WO_PB = 67 * MiB, WO_PC = 71 * MiB, WO_OUT = 75 * MiB;
constexpr size_t WS_XB = 167 * MiB, WS_P = 201 * MiB, WS_AB = 461 * MiB, WS_ZB = 462 * MiB, WS_YA = 479 * MiB, WS_YB = 496 * MiB, WS_YC = 513 * MiB;
constexpr size_t WS_M32 = 530 * MiB, WS_MB = 598 * MiB, WS_H32 = 632 * MiB, WS_X32 = 700 * MiB, WS_END = 768 * MiB;

constexpr size_t O_YP = 0, O_YS = 16777216, O_SRP = 17825792, O_SIP = 17858560, O_DP = 17891328, O_CP = 18939904,
                 O_SRS = 19013632, O_SIS = 20062208, O_DS = 21110784, O_CS = 54665216, O_GV = 57024512, O_END = 58073088;

constexpr int LDS_BYTES = 147456;

struct Args { const float* in[32]; float* out; unsigned char* ws; int ph_lo, ph_hi; };
typedef const __attribute__((address_space(4))) Args CArgs;

__device__ __forceinline__ unsigned f2bf(float f) { unsigned u = __builtin_bit_cast(unsigned, f); return (u + 0x7fffu + ((u >> 16) & 1u)) >> 16; }
__device__ __forceinline__ unsigned pk2(float lo, float hi) { return f2bf(lo) | (f2bf(hi) << 16); }
__device__ __forceinline__ float bf2f(unsigned short h) { return __builtin_bit_cast(float, (unsigned)h << 16); }
__device__ __forceinline__ float bflo(unsigned w) { return __builtin_bit_cast(float, w << 16); }
__device__ __forceinline__ float bfhi(unsigned w) { return __builtin_bit_cast(float, w & 0xffff0000u); }
__device__ __forceinline__ float sigm(float x) { return 1.f / (1.f + __expf(-x)); }
__device__ __forceinline__ float silu(float x) { return x / (1.f + __expf(-x)); }
__device__ __forceinline__ float gelu_tanh(float x) { return x * sigm(1.5957691216f * (x + 0.044715f * x * x * x)); }
__device__ __forceinline__ float softplus(float x) { return x > 20.f ? x : log1pf(expf(x)); }
__device__ __forceinline__ float wave_sum(float v) {
#pragma unroll
    for (int o = 1; o < 64; o <<= 1) v += __shfl_xor(v, o);
    return v;
}
__device__ __forceinline__ void unpack8(const u32x4 w, float (&f)[8]) {
    f[0] = bflo(w.x); f[1] = bfhi(w.x); f[2] = bflo(w.y); f[3] = bfhi(w.y); f[4] = bflo(w.z); f[5] = bfhi(w.z); f[6] = bflo(w.w); f[7] = bfhi(w.w);
}
__device__ __forceinline__ u32x4 pack8(const float (&f)[8]) { u32x4 w; w.x = pk2(f[0], f[1]); w.y = pk2(f[2], f[3]); w.z = pk2(f[4], f[5]); w.w = pk2(f[6], f[7]); return w; }
#define LDS_WAIT() asm volatile("s_waitcnt lgkmcnt(0)" ::: "memory")
__device__ __forceinline__ int launder_v(int x) { asm volatile("" : "+v"(x)); return x; }
__device__ __forceinline__ int launder_s(int x) { asm volatile("" : "+s"(x)); return x; }
__device__ __forceinline__ CArgs& kargs() { int z; asm volatile("s_mov_b32 %0, 0" : "=s"(z));
    return *(CArgs*)((const __attribute__((address_space(4))) char*)__builtin_amdgcn_kernarg_segment_ptr() + z); }
__device__ __forceinline__ LAS unsigned char* lds_base() { extern __shared__ __attribute__((aligned(16))) unsigned char lds_raw[]; int z; asm volatile("s_mov_b32 %0, 0" : "=s"(z));
    return (LAS unsigned char*)lds_raw + z; }

namespace pg8 {
constexpr int BM = 256, BK = 64, HALF = 128, HTB = HALF * BK * 2, STAGE_BYTES = 8 * HTB, NXCD = 8, WGM = 8;
__device__ __forceinline__ int lds_byte(int r, int c) { const int st = (r >> 4) * 2 + (c >> 5), rr = r & 15, cc = c & 31, ob = rr * 64 + cc * 2; return st * 1024 + (ob ^ (((ob >> 9) & 1) << 5)); }
__device__ __forceinline__ void stage_rc(int b, int& R, int& C) { const int st = b / 1024, sb = b % 1024, swz = sb ^ (((sb >> 9) & 1) << 5); R = (st >> 1) * 16 + swz / 64; C = (st & 1) * 32 + (swz % 64) / 2; }
__device__ __forceinline__ int perm32(int rho) { const int n = rho >> 4, i = rho & 15; return 8 * (i >> 2) + 4 * n + (i & 3); }

struct Unit { int pm, pn, br; };
struct Gemm { const bf16_t* A0; const bf16_t* A1; const bf16_t* A2; const bf16_t* B0; const bf16_t* B1; const bf16_t* B2; int K; };

struct Sched {
    int nM, nN, nbr, nwg, G, c;
    __device__ __forceinline__ void init(int nM_, int nN_, int nbr_, int G_, int c_) { nM = nM_; nN = nN_; nbr = nbr_; nwg = nM * nN; G = G_; c = c_; }
    __device__ __forceinline__ bool next(int i, Unit& u) const {
        const int ti = i / nbr; u.br = i - ti * nbr;
        const long L = (long)ti * G + c; if (L >= nwg) return false;
        int wgid = (int)L; { const int q = nwg / NXCD, r = nwg % NXCD, xcd = wgid % NXCD, off = wgid / NXCD; wgid = (xcd < r ? xcd * (q + 1) : r * (q + 1) + (xcd - r) * q) + off; }
        const int nig = WGM * nN, gid = wgid / nig, fm = gid * WGM, gsz = (nM - fm) < WGM ? (nM - fm) : WGM;
        u.pm = fm + ((wgid % nig) % gsz); u.pn = (wgid % nig) / gsz; return true;
    }
};

template <class Epi>
__device__ __forceinline__ void gemm_phase(LAS unsigned char* lds, const Gemm g, const Sched& S, const Epi& E, const int tid) {
    const int wid = __builtin_amdgcn_readfirstlane(tid >> 6), lane = tid & 63, wr = wid >> 2, wc = wid & 3, fr = lane & 15, fq = lane >> 4;
    const int K = g.K, nt = K / BK;
    unsigned voffA[2], voffB[2];
#pragma unroll
    for (int i = 0; i < 2; ++i) { int R, C; stage_rc(tid * 16 + i * 8192, R, C); const int Rb = (R & ~31) + perm32(R & 31);
        voffA[i] = (unsigned)(R * K + C) * 2u; voffB[i] = (unsigned)(Rb * K + C) * 2u; }
    const size_t kstep = (size_t)(BK * 2);
    const size_t hstep = (size_t)HALF * K * 2;
    const size_t tstep = 2 * hstep;
    const unsigned ldsw = (unsigned)wid * 1024u;
    const int aoff = lds_byte(wr * 64 + fr, fq * 8), boff = lds_byte(wc * 32 + fr, fq * 8);
#define PG8_SA(b, h) (((b) * 2 + (h)) * HTB)
#define PG8_SB(b, h) ((4 + (b) * 2 + (h)) * HTB)
#define PG8_STAGE(bufoff, gbase, voff) do { _Pragma("unroll") for (int _i = 0; _i < 2; ++_i) \
        __builtin_amdgcn_global_load_lds((const unsigned*)((const char*)(gbase) + (voff)[_i]), (LAS unsigned*)(lds + (bufoff) + ldsw + _i * 8192), 16, 0, 0); } while (0)
#define PG8_LDA(dst, b, h) do { _Pragma("unroll") for (int m = 0; m < 4; ++m) _Pragma("unroll") for (int k = 0; k < 2; ++k) dst[m][k] = *(const LAS bf16x8*)(lds + PG8_SA(b, h) + aoff + m * 2048 + k * 1024); } while (0)
#define PG8_LDB(dst, b, h) do { _Pragma("unroll") for (int n = 0; n < 2; ++n) _Pragma("unroll") for (int k = 0; k < 2; ++k) dst[n][k] = *(const LAS bf16x8*)(lds + PG8_SB(b, h) + boff + n * 2048 + k * 1024); } while (0)
#define PG8_MMA(ai, bj, At, Bt) do { __builtin_amdgcn_s_setprio(1); _Pragma("unroll") for (int m = 0; m < 4; ++m) _Pragma("unroll") for (int n = 0; n < 2; ++n) _Pragma("unroll") for (int k = 0; k < 2; ++k) \
        acc[ai][bj][m][n] = __builtin_amdgcn_mfma_f32_16x16x32_bf16(Bt[n][k], At[m][k], acc[ai][bj][m][n], 0, 0, 0); __builtin_amdgcn_s_setprio(0); } while (0)
#define PG8_WAIT_V(n) asm volatile("s_waitcnt vmcnt(" #n ")" ::: "memory")
#define PG8_WAIT_L(n) asm volatile("s_waitcnt lgkmcnt(" #n ")" ::: "memory")
#define PG8_BAR __builtin_amdgcn_s_barrier()
#define PG8_SCHED __builtin_amdgcn_sched_barrier(0)
#define PG8_APTR(u) ((const char*)((u).br == 0 ? g.A0 : ((u).br == 1 ? g.A1 : g.A2)) + (size_t)(u).pm * tstep)
#define PG8_BPTR(u) ((const char*)((u).br == 0 ? g.B0 : ((u).br == 1 ? g.B1 : g.B2)) + (size_t)(u).pn * tstep)
    Unit cur, nxt; int ui = 0;
    if (!S.next(0, cur)) return;
    f32x4 acc[2][2][4][2];
#pragma unroll
    for (int a = 0; a < 2; ++a)
#pragma unroll
        for (int b = 0; b < 2; ++b)
#pragma unroll
            for (int m = 0; m < 4; ++m)
#pragma unroll
                for (int n = 0; n < 2; ++n) acc[a][b][m][n] = (f32x4){0.f, 0.f, 0.f, 0.f};
    bf16x8 At[4][2], B0[2][2], B1[2][2];
    const char* cA = PG8_APTR(cur); const char* cB = PG8_BPTR(cur);
    PG8_STAGE(PG8_SB(0, 0), cB, voffB); PG8_STAGE(PG8_SB(0, 1), cB + hstep, voffB); PG8_STAGE(PG8_SA(0, 0), cA, voffA); PG8_STAGE(PG8_SA(0, 1), cA + hstep, voffA);
    if (wr == 1) PG8_BAR;
    PG8_WAIT_V(2); PG8_BAR;
    PG8_STAGE(PG8_SB(1, 0), cB + kstep, voffB); PG8_STAGE(PG8_SA(1, 0), cA + kstep, voffA); PG8_STAGE(PG8_SB(1, 1), cB + hstep + kstep, voffB);
    PG8_WAIT_V(6); PG8_BAR;
    for (;;) {
        const bool has_next = S.next(ui + 1, nxt);
        const char* nA = has_next ? PG8_APTR(nxt) : cA; const char* nB = has_next ? PG8_BPTR(nxt) : cB;
        for (int t = 0; t < nt; t += 2) {
            const bool last = (t == nt - 2);
            const char* a1 = cA + (size_t)(t + 1) * kstep;
            const char* a2 = last ? nA : cA + (size_t)(t + 2) * kstep; const char* b2 = last ? nB : cB + (size_t)(t + 2) * kstep;
            const char* a3 = a2 + kstep; const char* b3 = b2 + kstep;
            PG8_LDB(B0, 0, 0); PG8_LDB(B1, 0, 1); PG8_SCHED; PG8_LDA(At, 0, 0); PG8_STAGE(PG8_SA(1, 1), a1 + hstep, voffA);
            PG8_WAIT_V(8); PG8_WAIT_L(0); PG8_BAR; PG8_MMA(0, 0, At, B0); PG8_MMA(0, 1, At, B1); PG8_BAR; PG8_SCHED;
            PG8_LDA(At, 0, 1); PG8_STAGE(PG8_SB(0, 0), b2, voffB); PG8_STAGE(PG8_SB(0, 1), b2 + hstep, voffB); PG8_STAGE(PG8_SA(0, 0), a2, voffA);
            PG8_WAIT_V(8); PG8_WAIT_L(0); PG8_BAR; PG8_MMA(1, 0, At, B0); PG8_MMA(1, 1, At, B1); PG8_BAR; PG8_SCHED;
            PG8_LDB(B0, 1, 0); PG8_LDB(B1, 1, 1); PG8_SCHED; PG8_LDA(At, 1, 0); PG8_STAGE(PG8_SA(0, 1), a2 + hstep, voffA);
            PG8_WAIT_V(8); PG8_WAIT_L(0); PG8_BAR; PG8_MMA(0, 0, At, B0); PG8_MMA(0, 1, At, B1); PG8_BAR; PG8_SCHED;
            PG8_LDA(At, 1, 1); PG8_STAGE(PG8_SB(1, 0), b3, voffB); PG8_STAGE(PG8_SB(1, 1), b3 + hstep, voffB); PG8_STAGE(PG8_SA(1, 0), a3, voffA);
            PG8_WAIT_V(8); PG8_WAIT_L(0); PG8_BAR; PG8_MMA(1, 0, At, B0); PG8_MMA(1, 1, At, B1); PG8_BAR; PG8_SCHED;
        }
        if (wr == 0) PG8_BAR;
        E(acc, cur, wr, wc, fr, fq);
        if (!has_next) break;
#pragma unroll
        for (int a = 0; a < 2; ++a)
#pragma unroll
            for (int b = 0; b < 2; ++b)
#pragma unroll
                for (int m = 0; m < 4; ++m)
#pragma unroll
                    for (int n = 0; n < 2; ++n) acc[a][b][m][n] = (f32x4){0.f, 0.f, 0.f, 0.f};
        cur = nxt; cA = nA; cB = nB; ++ui;
        if (wr == 1) PG8_BAR;
    }
    PG8_WAIT_V(0);
    PG8_BAR;
#undef PG8_SA
#undef PG8_SB
#undef PG8_STAGE
#undef PG8_LDA
#undef PG8_LDB
#undef PG8_MMA
#undef PG8_WAIT_V
#undef PG8_WAIT_L
#undef PG8_BAR
#undef PG8_SCHED
#undef PG8_APTR
#undef PG8_BPTR
}

struct Epi1 {
    bf16_t* P; float* AB;
    __device__ __forceinline__ void operator()(const f32x4 (&acc)[2][2][4][2], const Unit& u, int wr, int wc, int fr, int fq) const {
        const int row0 = u.pm * BM + wr * 64 + fr, col0 = u.pn * BM + wc * 32 + 8 * fq;
#pragma unroll
        for (int ai = 0; ai < 2; ++ai)
#pragma unroll
            for (int m = 0; m < 4; ++m) { bf16_t* rowp = P + (size_t)(row0 + ai * HALF + m * 16) * NP + col0;
#pragma unroll
                for (int bj = 0; bj < 2; ++bj) { const f32x4 v0 = acc[ai][bj][m][0], v1 = acc[ai][bj][m][1];
                    u32x4 w; w.x = pk2(v0[0], v0[1]); w.y = pk2(v0[2], v0[3]); w.z = pk2(v1[0], v1[1]); w.w = pk2(v1[2], v1[3]);
                    *(u32x4*)(rowp + bj * HALF) = w; } }
        if (u.pn == 60 && wc == 0 && fq < 2) {
#pragma unroll
            for (int ai = 0; ai < 2; ++ai)
#pragma unroll
                for (int m = 0; m < 4; ++m) { float* ab = AB + (size_t)(row0 + ai * HALF + m * 16) * 16 + 8 * fq;
                    *(f32x4*)ab = acc[ai][0][m][0]; *(f32x4*)(ab + 4) = acc[ai][0][m][1]; }
        }
    }
};
struct Epi2 {
    const bf16_t* Zb; const bf16_t* P; const float* bglu; bf16_t* YA;
    __device__ __forceinline__ void operator()(const f32x4 (&acc)[2][2][4][2], const Unit& u, int wr, int wc, int fr, int fq) const {
        const int row0 = u.pm * BM + wr * 64 + fr, col0 = u.pn * BM + wc * 32 + 8 * fq;
#pragma unroll
        for (int bj = 0; bj < 2; ++bj) { const int col = col0 + bj * HALF;
            const f32x4 b0 = *(const f32x4*)(bglu + col), b1 = *(const f32x4*)(bglu + col + 4);
#pragma unroll
            for (int ai = 0; ai < 2; ++ai)
#pragma unroll
                for (int m = 0; m < 4; ++m) { const size_t row = (size_t)(row0 + ai * HALF + m * 16);
                    float z[8], ga[8], o[8];
                    unpack8(*(const u32x4*)(Zb + row * 1024 + col), z); unpack8(*(const u32x4*)(P + row * NP + C_GA + col), ga);
                    const f32x4 v0 = acc[ai][bj][m][0] + b0, v1 = acc[ai][bj][m][1] + b1;
#pragma unroll
                    for (int e = 0; e < 4; ++e) { o[e] = z[e] * sigm(v0[e]) * silu(ga[e]); o[4 + e] = z[4 + e] * sigm(v1[e]) * silu(ga[4 + e]); }
                    *(u32x4*)(YA + row * 1024 + col) = pack8(o); } }
    }
};
struct Epi3 {
    const bf16_t* P; const float* bgate; float* M32; bf16_t* Mb;
    __device__ __forceinline__ void operator()(const f32x4 (&acc)[2][2][4][2], const Unit& u, int wr, int wc, int fr, int fq) const {
        const int row0 = u.pm * BM + wr * 64 + fr, col0 = u.pn * BM + wc * 32 + 8 * fq, br = u.br;
#pragma unroll
        for (int bj = 0; bj < 2; ++bj) { const int col = col0 + bj * HALF;
            const f32x4 g0 = *(const f32x4*)(bgate + br * DM + col), g1 = *(const f32x4*)(bgate + br * DM + col + 4);
#pragma unroll
            for (int ai = 0; ai < 2; ++ai)
#pragma unroll
                for (int m = 0; m < 4; ++m) { const size_t row = (size_t)(row0 + ai * HALF + m * 16);
                    float zg[8], o[8];
                    unpack8(*(const u32x4*)(P + row * NP + C_ZG + br * DM + col), zg);
                    const f32x4 a0 = acc[ai][bj][m][0], a1 = acc[ai][bj][m][1];
#pragma unroll
                    for (int e = 0; e < 4; ++e) { o[e] = sigm(zg[e] + g0[e]) * a0[e]; o[4 + e] = sigm(zg[4 + e] + g1[e]) * a1[e]; }
                    float* mp = M32 + row * DM + col;
                    if (br > 0) { const f32x4 p0 = *(const f32x4*)mp, p1 = *(const f32x4*)(mp + 4);
#pragma unroll
                        for (int e = 0; e < 4; ++e) { o[e] += p0[e]; o[4 + e] += p1[e]; } }
                    if (br < 2) { *(f32x4*)mp = (f32x4){o[0], o[1], o[2], o[3]}; *(f32x4*)(mp + 4) = (f32x4){o[4], o[5], o[6], o[7]}; }
                    else *(u32x4*)(Mb + row * DM + col) = pack8(o); } }
    }
};
struct Epi4 {
    const float* xp; const float* xs; float* H32;
    __device__ __forceinline__ void operator()(const f32x4 (&acc)[2][2][4][2], const Unit& u, int wr, int wc, int fr, int fq) const {
        const int row0 = u.pm * BM + wr * 64 + fr, col0 = u.pn * BM + wc * 32 + 8 * fq;
        const float* xb = (u.pm < 32) ? xp : (xs - (size_t)TP * DM);
#pragma unroll
        for (int ai = 0; ai < 2; ++ai)
#pragma unroll
            for (int m = 0; m < 4; ++m) { const size_t row = (size_t)(row0 + ai * HALF + m * 16);
#pragma unroll
                for (int bj = 0; bj < 2; ++bj) { const int col = col0 + bj * HALF;
                    const f32x4 x0 = *(const f32x4*)(xb + row * DM + col), x1 = *(const f32x4*)(xb + row * DM + col + 4);
                    *(f32x4*)(H32 + row * DM + col) = x0 * ALPHA + acc[ai][bj][m][0];
                    *(f32x4*)(H32 + row * DM + col + 4) = x1 * ALPHA + acc[ai][bj][m][1]; } }
    }
};
}

template <bool REMAP>
__device__ __forceinline__ void transpose_item(const float* W, int K, int Nsrc, int Ndst, bf16_t* WT, LAS float* scr, int item, int lane) {
    const int nblk = Ndst / 32, kb = item / nblk, nb = item % nblk, k0 = 64 * kb, n0 = 32 * nb;
    int d = n0 + (lane & 31), s = d; bool valid = true;
    if (REMAP) { if (d < C_GATEC) s = d; else if (d < C_AB) s = d + 16; else if (d < C_AB + 16) s = 8192 + (d - C_AB); else { s = 0; valid = false; } }
#pragma unroll 8
    for (int i = 0; i < 32; ++i) { const int kk = 2 * i + (lane >> 5); scr[kk * 33 + (lane & 31)] = valid ? W[(size_t)(k0 + kk) * Nsrc + s] : 0.f; }
    LDS_WAIT();
    const int c = lane & 7;
#pragma unroll
    for (int j = 0; j < 4; ++j) { const int n = (lane >> 3) + 8 * j; const LAS float* sp = scr + (8 * c) * 33 + n;
        u32x4 o; o.x = pk2(sp[0 * 33], sp[1 * 33]); o.y = pk2(sp[2 * 33], sp[3 * 33]); o.z = pk2(sp[4 * 33], sp[5 * 33]); o.w = pk2(sp[6 * 33], sp[7 * 33]);
        *(u32x4*)(WT + (size_t)(n0 + n) * K + k0 + 8 * c) = o; }
    LDS_WAIT();
}

__device__ __forceinline__ void phase_convert(CArgs& a, LAS unsigned char* lds, int G, int vb, const int tid) {
    const int lane = tid & 63, wave = tid >> 6;
    LAS float* scr = (LAS float*)(lds + wave * 16384);
    const int gw = vb * 8 + wave, NGW = G * 8;
    constexpr int I_IN = (DM / 64) * (NP / 32), I_GLU = (1024 / 64) * (1024 / 32), I_P = (1024 / 64) * (DM / 32), I_OUT = (DM / 64) * (DM / 32);
    constexpr int I_L = I_IN + I_GLU + 3 * I_P + I_OUT;
    for (int it = gw; it < 2 * I_L; it += NGW) {
        const int l = it / I_L; int r = it - l * I_L;
        unsigned char* wb = a.ws + WS_W0 + (size_t)l * WS_WL;
        if (r < I_IN) { transpose_item<true>(a.in[6] + (size_t)l * DM * NIN, DM, NIN, NP, (bf16_t*)(wb + WO_IN), scr, r, lane); continue; } r -= I_IN;
        if (r < I_GLU) { transpose_item<false>(a.in[16] + (size_t)l * 1024 * 1024, 1024, 1024, 1024, (bf16_t*)(wb + WO_GLU), scr, r, lane); continue; } r -= I_GLU;
        if (r < I_P) { transpose_item<false>(a.in[18] + (size_t)l * 1024 * DM, 1024, DM, DM, (bf16_t*)(wb + WO_PA), scr, r, lane); continue; } r -= I_P;
        if (r < I_P) { transpose_item<false>(a.in[23] + (size_t)l * 1024 * DM, 1024, DM, DM, (bf16_t*)(wb + WO_PB), scr, r, lane); continue; } r -= I_P;
        if (r < I_P) { transpose_item<false>(a.in[28] + (size_t)l * 1024 * DM, 1024, DM, DM, (bf16_t*)(wb + WO_PC), scr, r, lane); continue; } r -= I_P;
        transpose_item<false>(a.in[29] + (size_t)l * DM * DM, DM, DM, DM, (bf16_t*)(wb + WO_OUT), scr, r, lane);
    }
    bf16_t* Xb = (bf16_t*)(a.ws + WS_XB);
    for (int m = gw; m < MT; m += NGW) {
        const float* xr = (m < TP) ? a.in[0] + (size_t)m * DM : a.in[1] + (size_t)(m - TP) * DM;
        const f32x4* xv = (const f32x4*)xr + lane; u32x2* o = (u32x2*)(Xb + (size_t)m * DM) + lane;
#pragma unroll
        for (int j = 0; j < 8; ++j) { const f32x4 v = xv[64 * j]; u32x2 w; w.x = pk2(v.x, v.y); w.y = pk2(v.z, v.w); o[64 * j] = w; }
    }
}

__device__ __forceinline__ void phase_ln(CArgs& a, int layer, int G, int vb, const int tid) {
    const int lane = tid & 63, wave = tid >> 6;
    const int gw = vb * 8 + wave, NGW = G * 8;
    const float* H32 = (const float*)(a.ws + WS_H32);
    const float* lg = a.in[30] + layer * DM; const float* lb = a.in[31] + layer * DM;
    bf16_t* Xb = (bf16_t*)(a.ws + WS_XB);
    for (int m = gw; m < MT; m += NGW) {
        const f32x4* xv = (const f32x4*)(H32 + (size_t)m * DM) + lane;
        f32x4 v[8]; float s = 0.f;
#pragma unroll
        for (int j = 0; j < 8; ++j) { v[j] = xv[64 * j]; s += (v[j].x + v[j].y) + (v[j].z + v[j].w); }
        const float mean = wave_sum(s) * (1.f / DM); float s2 = 0.f;
#pragma unroll
        for (int j = 0; j < 8; ++j) { v[j] = v[j] - mean; s2 += (v[j].x * v[j].x + v[j].y * v[j].y) + (v[j].z * v[j].z + v[j].w * v[j].w); }
        const float rstd = 1.f / sqrtf(wave_sum(s2) * (1.f / DM) + 1e-5f);
        float* dst = (layer == 0) ? (float*)(a.ws + WS_X32) + (size_t)m * DM : (m < TP ? a.out + O_YP + (size_t)m * DM : a.out + O_YS + (size_t)(m - TP) * DM);
#pragma unroll
        for (int j = 0; j < 8; ++j) { const f32x4 gg = *((const f32x4*)lg + lane + 64 * j), bb = *((const f32x4*)lb + lane + 64 * j);
            const f32x4 y = v[j] * rstd * gg + bb; *((f32x4*)dst + lane + 64 * j) = y;
            if (layer == 0) { u32x2 w; w.x = pk2(y.x, y.y); w.y = pk2(y.z, y.w); *((u32x2*)(Xb + (size_t)m * DM) + lane + 64 * j) = w; } }
    }
}

constexpr int S5_BUS = 128;
constexpr int S5_SROW = 272;
constexpr int S5_UB = 32 * S5_BUS * 4 + 32 * S5_SROW;
constexpr int S5_WLDS = S5_UB + 1024;
template <bool SAMPLE>
__device__ __forceinline__ void s5_item(int layer, int item, int wlo, int lane) {
    CArgs& a = kargs(); LAS unsigned char* wl = lds_base() + wlo;
    const int g = SAMPLE ? item : (item & 63), b = SAMPLE ? 0 : (item >> 6);
    const float* lam_re = a.in[8] + layer * 4096 + g * 64; const float* lam_im = a.in[9] + layer * 4096 + g * 64;
    const float dt = expf(a.in[10][layer * 64 + g]);
    const float* b_re = a.in[11] + (size_t)(layer * 64 + g) * 1024; const float* b_im = a.in[12] + (size_t)(layer * 64 + g) * 1024;
    const float* c_re = a.in[13] + (size_t)(layer * 64 + g) * 1024; const float* c_im = a.in[14] + (size_t)(layer * 64 + g) * 1024;
    const f32x4 dch = *(const f32x4*)(a.in[15] + layer * 1024 + g * 16 + 4 * (lane >> 4));
    const bf16_t* P = (const bf16_t*)(a.ws + WS_P); bf16_t* Zb = (bf16_t*)(a.ws + WS_ZB);
    LAS float* BU = (LAS float*)wl; LAS unsigned char* Sb = wl + 32 * S5_BUS * 4; LAS unsigned char* Ub = wl + S5_UB;
    float ar, ai;
    { const float lr = lam_re[lane], li = lam_im[lane]; const float mag = expf(lr * dt); float sn, cs; sincosf(li * dt, &sn, &cs); ar = mag * cs; ai = mag * sn; }
    bf16x8 Bf[4];
    { const int h = lane >> 5;
#pragma unroll
      for (int q = 0; q < 2; ++q) { const int pp = q * 32 + (lane & 31);
        const float lr = lam_re[pp], li = lam_im[pp]; const float mag = expf(lr * dt); float sn, cs; sincosf(li * dt, &sn, &cs);
        const float abr = mag * cs, abi = mag * sn, den = lr * lr + li * li, nr = abr - 1.f, ni = abi;
        const float f_r = (nr * lr + ni * li) / den, f_i = (ni * lr - nr * li) / den;
        float br8[8], bi8[8], or8[8], oi8[8];
        *(f32x4*)&br8[0] = *(const f32x4*)(b_re + pp * 16 + 8 * h); *(f32x4*)&br8[4] = *(const f32x4*)(b_re + pp * 16 + 8 * h + 4);
        *(f32x4*)&bi8[0] = *(const f32x4*)(b_im + pp * 16 + 8 * h); *(f32x4*)&bi8[4] = *(const f32x4*)(b_im + pp * 16 + 8 * h + 4);
#pragma unroll
        for (int e = 0; e < 8; ++e) { or8[e] = f_r * br8[e] - f_i * bi8[e]; oi8[e] = f_r * bi8[e] + f_i * br8[e]; }
        Bf[q] = __builtin_bit_cast(bf16x8, pack8(or8)); Bf[2 + q] = __builtin_bit_cast(bf16x8, pack8(oi8)); } }
    bf16x8 Cf[4];
    { const int c = lane & 15;
#pragma unroll
      for (int ks = 0; ks < 4; ++ks) { const int p0 = 16 * ks + 4 * (lane >> 4);
        const f32x4 cr = *(const f32x4*)(c_re + c * 64 + p0), ci = *(const f32x4*)(c_im + c * 64 + p0);
        float o[8] = {cr[0], -ci[0], cr[1], -ci[1], cr[2], -ci[2], cr[3], -ci[3]};
        Cf[ks] = __builtin_bit_cast(bf16x8, pack8(o)); } }
    float sr = 0.f, si = 0.f;
    const int nsc = SAMPLE ? 16 : 64;
    const float* h_re = a.in[2] + (size_t)layer * 128 * 4096 + g * 64 + lane; const float* h_im = a.in[3] + (size_t)layer * 128 * 4096 + g * 64 + lane;
    float* o_re = a.out + O_SRS + (size_t)layer * 128 * 4096 + g * 64 + lane; float* o_im = a.out + O_SIS + (size_t)layer * 128 * 4096 + g * 64 + lane;
    const bf16_t* up = P + (size_t)((SAMPLE ? TP : b * 2048) + (lane & 31)) * NP + C_XA + g * 16 + 8 * (lane >> 5);
    bf16x8 Af = *(const bf16x8*)up;
    float hr[8], hi[8];
    if (SAMPLE) {
#pragma unroll
        for (int q = 0; q < 8; ++q) { hr[q] = h_re[(size_t)q * 4096]; hi[q] = h_im[(size_t)q * 4096]; } }
    for (int sc = 0; sc < nsc; ++sc) {
        const int row0 = SAMPLE ? TP + sc * 32 : b * 2048 + sc * 32;
        const bf16x8 Ac = Af;
        float hcr[8], hci[8];
        if (SAMPLE) {
#pragma unroll
            for (int q = 0; q < 8; ++q) { hcr[q] = hr[q]; hci[q] = hi[q]; } }
        if (sc + 1 < nsc) { Af = *(const bf16x8*)(up + (size_t)(sc + 1) * 32 * NP);
            if (SAMPLE) {
#pragma unroll
                for (int q = 0; q < 8; ++q) { hr[q] = h_re[(size_t)((sc + 1) * 8 + q) * 4096]; hi[q] = h_im[(size_t)((sc + 1) * 8 + q) * 4096]; } } }
        *(LAS bf16x8*)(Ub + (lane & 31) * 32 + 16 * (lane >> 5)) = Ac;
#pragma unroll
        for (int nb = 0; nb < 4; ++nb) {
            f32x16 acc;
#pragma unroll
            for (int r = 0; r < 16; ++r) acc[r] = 0.f;
            acc = __builtin_amdgcn_mfma_f32_32x32x16_bf16(Ac, Bf[nb], acc, 0, 0, 0);
#pragma unroll
            for (int r = 0; r < 16; ++r) { const int t = (r & 3) + 8 * (r >> 2) + 4 * (lane >> 5); BU[t * S5_BUS + 32 * nb + (lane & 31)] = acc[r]; }
        }
        LDS_WAIT();
#pragma unroll
        for (int t = 0; t < 32; ++t) {
            if (SAMPLE && (t & 3) == 0) { sr = hcr[t >> 2]; si = hci[t >> 2]; }
            const float bur = BU[t * S5_BUS + lane], bui = BU[t * S5_BUS + 64 + lane];
            const float nsr = ar * sr - ai * si + bur, nsi = ar * si + ai * sr + bui;
            sr = nsr; si = nsi;
            *(LAS unsigned*)(Sb + t * S5_SROW + 4 * lane) = pk2(sr, si);
            if (SAMPLE && (t & 3) == 3) { const int bi = sc * 8 + (t >> 2); o_re[(size_t)bi * 4096] = sr; o_im[(size_t)bi * 4096] = si; }
        }
        LDS_WAIT();
#pragma unroll
        for (int mb = 0; mb < 2; ++mb) {
            f32x4 y = (f32x4){0.f, 0.f, 0.f, 0.f};
#pragma unroll
            for (int ks = 0; ks < 4; ++ks) { const bf16x8 Sf = *(const LAS bf16x8*)(Sb + (16 * mb + (lane & 15)) * S5_SROW + 64 * ks + 16 * (lane >> 4));
                y = __builtin_amdgcn_mfma_f32_16x16x32_bf16(Cf[ks], Sf, y, 0, 0, 0); }
            const int tt = 16 * mb + (lane & 15);
            const u32x2 xw = *(const LAS u32x2*)(Ub + tt * 32 + 8 * (lane >> 4));
            u32x2 o; o.x = pk2(gelu_tanh(y[0] + dch[0] * bflo(xw.x)), gelu_tanh(y[1] + dch[1] * bfhi(xw.x)));
            o.y = pk2(gelu_tanh(y[2] + dch[2] * bflo(xw.y)), gelu_tanh(y[3] + dch[3] * bfhi(xw.y)));
            *(u32x2*)(Zb + (size_t)(row0 + tt) * 1024 + g * 16 + 4 * (lane >> 4)) = o;
        }
        LDS_WAIT();
    }
    if (!SAMPLE) { a.out[O_SRP + (size_t)((layer * 4 + b) * 64 + g) * 64 + lane] = sr; a.out[O_SIP + (size_t)((layer * 4 + b) * 64 + g) * 64 + lane] = si; }
}

constexpr int GM_TROW = 80;
__device__ __forceinline__ void gmlp_prompt_item(int layer, int item, const int tid) {
    CArgs& a = kargs(); LAS unsigned char* lds = lds_base();
    const int lane = tid & 63, w = tid >> 6;
    const bf16_t* P = (const bf16_t*)(a.ws + WS_P); bf16_t* YB = (bf16_t*)(a.ws + WS_YB);
    const float* lng = a.in[19] + layer * 1024; const float* lnb = a.in[20] + layer * 1024;
    const int r0 = item * 128;
    LAS f32x2* stats = (LAS f32x2*)lds;
    LAS unsigned char* vt = lds + 1024 + w * (32 * GM_TROW);
    __syncthreads();
    for (int i = 0; i < 16; ++i) { const int t = 16 * w + i; const bf16_t* rp = P + (size_t)(r0 + t) * NP + C_VB + lane * 16;
        float x[16]; { float t8[8]; unpack8(*(const u32x4*)rp, t8);
#pragma unroll
            for (int e = 0; e < 8; ++e) x[e] = t8[e];
            unpack8(*(const u32x4*)(rp + 8), t8);
#pragma unroll
            for (int e = 0; e < 8; ++e) x[8 + e] = t8[e]; }
        float s = 0.f;
#pragma unroll
        for (int e = 0; e < 16; ++e) s += x[e];
        const float mean = wave_sum(s) * (1.f / 1024.f); float s2 = 0.f;
#pragma unroll
        for (int e = 0; e < 16; ++e) { const float d = x[e] - mean; s2 += d * d; }
        const float rstd = 1.f / sqrtf(wave_sum(s2) * (1.f / 1024.f) + 1e-5f);
        if (lane == 0) stats[t] = (f32x2){mean, rstd}; }
    __syncthreads();
    for (int rnd = 0; rnd < 4; ++rnd) {
        const int wi = rnd * 8 + w, g = wi >> 2, cbase = g * 128 + (wi & 3) * 32;
        const float* Ws = a.in[21] + (size_t)(layer * 8 + g) * 128 * 128;
        f32x4 acc[2][8];
#pragma unroll
        for (int cb = 0; cb < 2; ++cb)
#pragma unroll
            for (int ib = 0; ib < 8; ++ib) acc[cb][ib] = (f32x4){0.f, 0.f, 0.f, 0.f};
#pragma unroll 1
        for (int kb = 0; kb < 4; ++kb) {
#pragma unroll 1
            for (int q = 0; q < 2; ++q) { const int j = (lane >> 2) + 16 * q, cg = lane & 3;
                float x[8]; unpack8(*(const u32x4*)(P + (size_t)(r0 + 32 * kb + j) * NP + C_VB + cbase + cg * 8), x);
                const f32x2 st = stats[32 * kb + j];
                const f32x4 g0 = *(const f32x4*)(lng + cbase + cg * 8), g1 = *(const f32x4*)(lng + cbase + cg * 8 + 4);
                const f32x4 b0 = *(const f32x4*)(lnb + cbase + cg * 8), b1 = *(const f32x4*)(lnb + cbase + cg * 8 + 4);
#pragma unroll
                for (int e = 0; e < 8; ++e) { const float gg = e < 4 ? g0[e & 3] : g1[e & 3], bb = e < 4 ? b0[e & 3] : b1[e & 3];
                    const float v = (x[e] - st.x) * st.y * gg + bb;
                    *(LAS bf16_t*)(vt + (cg * 8 + e) * GM_TROW + 2 * j) = (bf16_t)f2bf(v); } }
            LDS_WAIT();
            bf16x8 Af[2];
#pragma unroll
            for (int cb = 0; cb < 2; ++cb) Af[cb] = *(const LAS bf16x8*)(vt + (16 * cb + (lane & 15)) * GM_TROW + 16 * (lane >> 4));
#pragma unroll
            for (int ib = 0; ib < 8; ++ib) {
                if (ib >= 2 * kb) {
                    const int i = 16 * ib + (lane & 15), j0 = 32 * kb + 8 * (lane >> 4);
                    const f32x4 w0 = *(const f32x4*)(Ws + i * 128 + j0), w1 = *(const f32x4*)(Ws + i * 128 + j0 + 4);
                    float wv[8];
#pragma unroll
                    for (int e = 0; e < 8; ++e) { const float x = e < 4 ? w0[e & 3] : w1[e & 3]; wv[e] = (j0 + e <= i) ? x : 0.f; }
                    const bf16x8 Bw = __builtin_bit_cast(bf16x8, pack8(wv));
#pragma unroll
                    for (int cb = 0; cb < 2; ++cb) acc[cb][ib] = __builtin_amdgcn_mfma_f32_16x16x32_bf16(Af[cb], Bw, acc[cb][ib], 0, 0, 0);
                }
            }
            LDS_WAIT();
        }
        const float* bsp = a.in[22] + (size_t)(layer * 8 + g) * 128;
#pragma unroll
        for (int ib = 0; ib < 8; ++ib) { const int i = 16 * ib + (lane & 15); const float bs = bsp[i]; const size_t row = (size_t)(r0 + i);
#pragma unroll
            for (int cb = 0; cb < 2; ++cb) { const int ch = cbase + 16 * cb + 4 * (lane >> 4);
                const u32x2 uw = *(const u32x2*)(P + row * NP + C_UB + ch), gw = *(const u32x2*)(P + row * NP + C_GB + ch);
                const f32x4 s = acc[cb][ib] + bs;
                u32x2 o; o.x = pk2(bflo(uw.x) * s[0] * silu(bflo(gw.x)), bfhi(uw.x) * s[1] * silu(bfhi(gw.x)));
                o.y = pk2(bflo(uw.y) * s[2] * silu(bflo(gw.y)), bfhi(uw.y) * s[3] * silu(bfhi(gw.y)));
                *(u32x2*)(YB + row * 1024 + ch) = o; } }
    }
}
__device__ __forceinline__ void gmlp_sample_item(int layer, int b, int lane) {
    CArgs& a = kargs();
    const bf16_t* P = (const bf16_t*)(a.ws + WS_P); bf16_t* YB = (bf16_t*)(a.ws + WS_YB);
    const float* lng = a.in[19] + layer * 1024 + lane * 16; const float* lnb = a.in[20] + layer * 1024 + lane * 16;
    const int g = lane >> 3;
    const float* Ws = a.in[21] + (size_t)(layer * 8 + g) * 128 * 128; const float* bsp = a.in[22] + (size_t)(layer * 8 + g) * 128;
    float vn[4][16];
#pragma unroll
    for (int t = 0; t < 4; ++t) { const size_t row = (size_t)(TP + b * 4 + t); const bf16_t* rp = P + row * NP + C_VB + lane * 16;
        float x[16]; { float t8[8]; unpack8(*(const u32x4*)rp, t8);
#pragma unroll
            for (int e = 0; e < 8; ++e) x[e] = t8[e];
            unpack8(*(const u32x4*)(rp + 8), t8);
#pragma unroll
            for (int e = 0; e < 8; ++e) x[8 + e] = t8[e]; }
        float s = 0.f;
#pragma unroll
        for (int e = 0; e < 16; ++e) s += x[e];
        const float mean = wave_sum(s) * (1.f / 1024.f); float s2 = 0.f;
#pragma unroll
        for (int e = 0; e < 16; ++e) { const float d = x[e] - mean; s2 += d * d; }
        const float rstd = 1.f / sqrtf(wave_sum(s2) * (1.f / 1024.f) + 1e-5f);
        float* ov = a.out + O_GV + ((size_t)(layer * 128 + b) * 4 + t) * 1024 + lane * 16;
#pragma unroll
        for (int e = 0; e < 16; ++e) vn[t][e] = (x[e] - mean) * rstd * lng[e] + lnb[e];
#pragma unroll
        for (int e = 0; e < 16; e += 4) *(f32x4*)(ov + e) = (f32x4){vn[t][e], vn[t][e + 1], vn[t][e + 2], vn[t][e + 3]}; }
#pragma unroll
    for (int i = 0; i < 4; ++i) { const size_t row = (size_t)(TP + b * 4 + i);
        float s[16]; const float bs = bsp[i];
#pragma unroll
        for (int e = 0; e < 16; ++e) s[e] = bs;
#pragma unroll
        for (int j = 0; j < 4; ++j) if (j <= i) { const float wv = Ws[i * 128 + j];
#pragma unroll
            for (int e = 0; e < 16; ++e) s[e] += wv * vn[j][e]; }
        float ub[16], gb[16];
        { float t8[8]; unpack8(*(const u32x4*)(P + row * NP + C_UB + lane * 16), t8);
#pragma unroll
          for (int e = 0; e < 8; ++e) ub[e] = t8[e];
          unpack8(*(const u32x4*)(P + row * NP + C_UB + lane * 16 + 8), t8);
#pragma unroll
          for (int e = 0; e < 8; ++e) ub[8 + e] = t8[e];
          unpack8(*(const u32x4*)(P + row * NP + C_GB + lane * 16), t8);
#pragma unroll
          for (int e = 0; e < 8; ++e) gb[e] = t8[e];
          unpack8(*(const u32x4*)(P + row * NP + C_GB + lane * 16 + 8), t8);
#pragma unroll
          for (int e = 0; e < 8; ++e) gb[8 + e] = t8[e]; }
        float o0[8], o1[8];
#pragma unroll
        for (int e = 0; e < 8; ++e) { o0[e] = ub[e] * s[e] * silu(gb[e]); o1[e] = ub[8 + e] * s[8 + e] * silu(gb[8 + e]); }
        *(u32x4*)(YB + row * 1024 + lane * 16) = pack8(o0); *(u32x4*)(YB + row * 1024 + lane * 16 + 8) = pack8(o1); }
}

template <bool SAMPLE>
__device__ __forceinline__ void gdn_item_v1(int layer, int item, const int tid) {
    CArgs& a = kargs(); LAS unsigned char* lds = lds_base();
    const int lane = tid & 63, w = tid >> 6;
    const int b = item >> 3, h = item & 7;
    const int T = SAMPLE ? 4 : 2048, rbase = SAMPLE ? TP + b * 4 : b * 2048, NB = SAMPLE ? 128 : 4;
    const bf16_t* P = (const bf16_t*)(a.ws + WS_P); const float* AB = (const float*)(a.ws + WS_AB); bf16_t* YC = (bf16_t*)(a.ws + WS_YC);
    const float* convw = a.in[24] + (size_t)layer * 4 * 3072;
    const float* sconv = a.in[5] + (size_t)(layer * 128 + b) * 3 * 3072;
    LAS float* qs = (LAS float*)lds; LAS float* ks = qs + 64 * 128; LAS float* vs = ks + 64 * 128;
    LAS float* red = vs + 64 * 128; LAS float* red2 = red + 512; LAS float* av = red2 + 512; LAS float* bv = av + 64;
    const int dv = (w & 1) * 64 + lane, sl = w >> 1, dk0 = sl * 32;
    float S[32];
    if (SAMPLE) { const float* s0 = a.in[4] + ((size_t)((layer * 128 + b) * 8 + h) * 128 + dk0) * 128 + dv;
#pragma unroll
        for (int i = 0; i < 32; ++i) S[i] = s0[(size_t)i * 128]; }
    else {
#pragma unroll
        for (int i = 0; i < 32; ++i) S[i] = 0.f; }
    const float Aexp = expf(a.in[25][layer * 8 + h]), dtb = a.in[26][layer * 8 + h];
    for (int c0 = 0; c0 < T; c0 += 64) {
        const int n = (T - c0) < 64 ? (T - c0) : 64;
        __syncthreads();
        for (int idx = tid; idx < n * 384; idx += 512) {
            const int t = idx / 384, ch = idx - t * 384, sec = ch >> 7, cc = ch & 127, col = sec * 1024 + h * 128 + cc, tg = c0 + t;
            float accv = 0.f;
#pragma unroll
            for (int j = 0; j < 4; ++j) { const int tt = tg - 3 + j; float x;
                if (tt >= 0) x = bf2f(P[(size_t)(rbase + tt) * NP + C_QKV + col]);
                else x = SAMPLE ? sconv[(3 + tt) * 3072 + col] : 0.f;
                accv += convw[j * 3072 + col] * x; }
            const float y = silu(accv);
            LAS float* dst = sec == 0 ? qs : (sec == 1 ? ks : vs); dst[t * 128 + cc] = y;
        }
        if (tid < n) { const size_t row = (size_t)(rbase + c0 + tid); const float ac = AB[row * 16 + h], bc = AB[row * 16 + 8 + h];
            const float gg = -Aexp * softplus(ac + dtb); av[tid] = expf(gg); bv[tid] = sigm(bc); }
        __syncthreads();
        for (int t = w; t < n; t += 8) {
            { const float q0 = qs[t * 128 + lane], q1 = qs[t * 128 + 64 + lane]; const float ss = wave_sum(q0 * q0 + q1 * q1);
              const float r = (1.f / sqrtf(ss + 1e-6f)) * 0.08838834764831845f; qs[t * 128 + lane] = q0 * r; qs[t * 128 + 64 + lane] = q1 * r; }
            { const float k0 = ks[t * 128 + lane], k1 = ks[t * 128 + 64 + lane]; const float ss = wave_sum(k0 * k0 + k1 * k1);
              const float r = 1.f / sqrtf(ss + 1e-6f); ks[t * 128 + lane] = k0 * r; ks[t * 128 + 64 + lane] = k1 * r; }
        }
        __syncthreads();
        for (int t = 0; t < n; ++t) {
            const float at = av[t], bt = bv[t];
            float p = 0.f;
#pragma unroll
            for (int i = 0; i < 32; i += 4) { const f32x4 kk = *(const LAS f32x4*)(ks + t * 128 + dk0 + i);
                p += kk[0] * S[i] + kk[1] * S[i + 1] + kk[2] * S[i + 2] + kk[3] * S[i + 3]; }
            red[sl * 128 + dv] = p;
            __syncthreads();
            const float kS = (red[dv] + red[128 + dv]) + (red[256 + dv] + red[384 + dv]);
            const float vnew = bt * (vs[t * 128 + dv] - at * kS);
            float po = 0.f;
#pragma unroll
            for (int i = 0; i < 32; i += 4) { const f32x4 kk = *(const LAS f32x4*)(ks + t * 128 + dk0 + i), qq = *(const LAS f32x4*)(qs + t * 128 + dk0 + i);
#pragma unroll
                for (int e = 0; e < 4; ++e) { S[i + e] = at * S[i + e] + kk[e] * vnew; po += qq[e] * S[i + e]; } }
            red2[sl * 128 + dv] = po;
            __syncthreads();
            if (sl == 0) vs[t * 128 + dv] = (red2[dv] + red2[128 + dv]) + (red2[256 + dv] + red2[384 + dv]);
        }
        __syncthreads();
        const float* ng = a.in[27] + layer * 128;
        for (int t = w; t < n; t += 8) {
            const float o0 = vs[t * 128 + lane], o1 = vs[t * 128 + 64 + lane]; const float ss = wave_sum(o0 * o0 + o1 * o1);
            const float r = 1.f / sqrtf(ss * (1.f / 128.f) + 1e-6f); const size_t row = (size_t)(rbase + c0 + t);
            const float g0 = bf2f(P[row * NP + C_GATEC + h * 128 + lane]), g1 = bf2f(P[row * NP + C_GATEC + h * 128 + 64 + lane]);
            YC[row * 1024 + h * 128 + lane] = (bf16_t)f2bf(o0 * r * ng[lane] * silu(g0));
            YC[row * 1024 + h * 128 + 64 + lane] = (bf16_t)f2bf(o1 * r * ng[64 + lane] * silu(g1));
        }
    }
    { float* so = a.out + (SAMPLE ? O_DS : O_DP) + ((size_t)((layer * NB + b) * 8 + h) * 128 + dk0) * 128 + dv;
#pragma unroll
      for (int i = 0; i < 32; ++i) so[(size_t)i * 128] = S[i]; }
    { float* co = a.out + (SAMPLE ? O_CS : O_CP) + (size_t)(layer * NB + b) * 3 * 3072;
      for (int idx = tid; idx < 3 * 384; idx += 512) { const int r = idx / 384, ch = idx - r * 384, col = (ch >> 7) * 1024 + h * 128 + (ch & 127);
          co[r * 3072 + col] = bf2f(P[(size_t)(rbase + T - 3 + r) * NP + C_QKV + col]); } }
}


constexpr size_t WS_GC = WS_M32;
constexpr int GC_STRIDE = 98304, GC_WN = 0, GC_QG = 16384, GC_KG = 32768, GC_AT = 49152, GC_U = 57344, GC_GAMMA = 90112, GC_OPS = 57344;
static_assert(WS_GC + (size_t)1024 * GC_STRIDE <= WS_H32, "chunk buffers fit in the M32|MB overlay");
constexpr int GP_QR = 0, GP_KR = 17408, GP_KBR = 34816, GP_VT = 52224, GP_KGT = 70656, GP_KT2 = 89088, GP_LM = 107520, GP_TM = 124928, GP_AS = 134144,
              GP_GC = 143360, GP_BETA = 143616, GP_GRAW = 143872, GP_WST = 0;
#define MFMA32(a, b, c) __builtin_amdgcn_mfma_f32_32x32x16_bf16((a), (b), (c), 0, 0, 0)

__device__ __forceinline__ void gdn_prep_item(int layer, int item, const int tid) {
    CArgs& a = kargs(); LAS unsigned char* lds = lds_base();
    const int lane = tid & 63, w = __builtin_amdgcn_readfirstlane(tid >> 6), hh = lane >> 5, l31 = lane & 31;
    const int b = item >> 8, h = (item >> 5) & 7, n = item & 31;
    const bf16_t* P = (const bf16_t*)(a.ws + WS_P); const float* AB = (const float*)(a.ws + WS_AB);
    unsigned char* gc = a.ws + WS_GC + (size_t)item * GC_STRIDE;
    const int t = tid >> 3, cg = tid & 7;
    const int r0 = b * 2048 + n * 64;
    __syncthreads();
    float qv[16], kv[16], vv[16];
    {
        const float* convw = a.in[24] + (size_t)layer * 4 * 3072;
#pragma unroll
        for (int sec = 0; sec < 3; ++sec) {
            const int ch = sec * 1024 + h * 128 + 16 * cg;
            float acc[16];
#pragma unroll
            for (int e = 0; e < 16; ++e) acc[e] = 0.f;
#pragma unroll
            for (int j = 0; j < 4; ++j) {
                const int tt = n * 64 + t - 3 + j;
                float x[16];
                if (tt >= 0) { const bf16_t* rp = P + (size_t)(b * 2048 + tt) * NP + C_QKV + ch; float t8[8];
                    unpack8(*(const u32x4*)rp, t8);
#pragma unroll
                    for (int e = 0; e < 8; ++e) x[e] = t8[e];
                    unpack8(*(const u32x4*)(rp + 8), t8);
#pragma unroll
                    for (int e = 0; e < 8; ++e) x[8 + e] = t8[e]; }
                else {
#pragma unroll
                    for (int e = 0; e < 16; ++e) x[e] = 0.f; }
                const float* wp = convw + j * 3072 + ch;
#pragma unroll
                for (int e = 0; e < 16; e += 4) { const f32x4 wv = *(const f32x4*)(wp + e);
                    acc[e] += wv[0] * x[e]; acc[e + 1] += wv[1] * x[e + 1]; acc[e + 2] += wv[2] * x[e + 2]; acc[e + 3] += wv[3] * x[e + 3]; }
                if (j == 3 && n == 31 && t >= 61) { float* co = a.out + O_CP + ((size_t)(layer * 4 + b) * 3 + (t - 61)) * 3072 + ch;
#pragma unroll
                    for (int e = 0; e < 16; e += 4) *(f32x4*)(co + e) = (f32x4){x[e], x[e + 1], x[e + 2], x[e + 3]}; }
            }
            float ss = 0.f;
#pragma unroll
            for (int e = 0; e < 16; ++e) { acc[e] = silu(acc[e]); ss += acc[e] * acc[e]; }
            if (sec < 2) { ss += __shfl_xor(ss, 1); ss += __shfl_xor(ss, 2); ss += __shfl_xor(ss, 4);
                const float r = (1.f / sqrtf(ss + 1e-6f)) * (sec == 0 ? 0.08838834764831845f : 1.f);
#pragma unroll
                for (int e = 0; e < 16; ++e) { if (sec == 0) qv[e] = acc[e] * r; else kv[e] = acc[e] * r; } }
            else {
#pragma unroll
                for (int e = 0; e < 16; ++e) vv[e] = acc[e]; }
        }
        if (cg == 0) { const size_t row = (size_t)(r0 + t); const float ac = AB[row * 16 + h], bc = AB[row * 16 + 8 + h];
            const float Aexp = expf(a.in[25][layer * 8 + h]), dtb = a.in[26][layer * 8 + h];
            *(LAS float*)(lds + GP_GRAW + 4 * t) = -Aexp * softplus(ac + dtb); *(LAS float*)(lds + GP_BETA + 4 * t) = sigm(bc); }
    }
    __syncthreads();
    if (w == 0) { float g = *(LAS float*)(lds + GP_GRAW + 4 * lane);
#pragma unroll
        for (int o = 1; o < 64; o <<= 1) { const float y = __shfl_up(g, o); if (lane >= o) g += y; }
        *(LAS float*)(lds + GP_GC + 4 * lane) = g; }
    __syncthreads();
    {
        const float gct = *(LAS float*)(lds + GP_GC + 4 * t), bt = *(LAS float*)(lds + GP_BETA + 4 * t), gl = *(LAS float*)(lds + GP_GC + 4 * 63);
        const float eg = expf(gct), egl = expf(gl - gct);
        float tq[8], tk[8], tb[8];
#pragma unroll
        for (int half = 0; half < 2; ++half) {
#pragma unroll
            for (int e = 0; e < 8; ++e) { tq[e] = qv[8 * half + e]; tk[e] = kv[8 * half + e]; tb[e] = kv[8 * half + e] * bt; }
            *(LAS u32x4*)(lds + GP_QR + t * 272 + (16 * cg + 8 * half) * 2) = pack8(tq);
            *(LAS u32x4*)(lds + GP_KR + t * 272 + (16 * cg + 8 * half) * 2) = pack8(tk);
            *(LAS u32x4*)(lds + GP_KBR + t * 272 + (16 * cg + 8 * half) * 2) = pack8(tb);
        }
#pragma unroll
        for (int d = 0; d < 16; ++d) { const int rowd = 16 * cg + d;
            *(LAS bf16_t*)(lds + GP_VT + rowd * 144 + 2 * t) = (bf16_t)f2bf(vv[d] * bt);
            *(LAS bf16_t*)(lds + GP_KGT + rowd * 144 + 2 * t) = (bf16_t)f2bf(kv[d] * bt * eg);
            *(LAS bf16_t*)(lds + GP_KT2 + rowd * 144 + 2 * t) = (bf16_t)f2bf(kv[d] * egl); }
#pragma unroll
        for (int hq = 0; hq < 2; ++hq) { float o8[8];
#pragma unroll
            for (int j = 0; j < 8; ++j) o8[j] = qv[8 * (j >> 2) + 4 * hq + (j & 3)] * eg;
            *(u32x4*)(gc + GC_QG + ((((t >> 5) * 4 + (cg >> 1)) * 2 + (cg & 1)) * 64 + (t & 31) + 32 * hq) * 16) = pack8(o8); }
        if (tid == 0) *(float*)(gc + GC_GAMMA) = expf(gl);
    }
    __syncthreads();
    {
        const int typ = w >> 2, mi = (w >> 1) & 1, nj = w & 1;
        f32x16 acc;
#pragma unroll
        for (int r = 0; r < 16; ++r) acc[r] = 0.f;
        if (!(mi == 0 && nj == 1)) {
            const LAS unsigned char* Ab = lds + (typ ? GP_QR : GP_KBR) + (32 * mi + l31) * 272 + 16 * hh;
            const LAS unsigned char* Bb = lds + GP_KR + (32 * nj + l31) * 272 + 16 * hh;
#pragma unroll
            for (int ks = 0; ks < 8; ++ks) acc = MFMA32(*(const LAS bf16x8*)(Ab + 32 * ks), *(const LAS bf16x8*)(Bb + 32 * ks), acc);
        }
        const int j = 32 * nj + l31; const float gcj = *(LAS float*)(lds + GP_GC + 4 * j);
#pragma unroll
        for (int r = 0; r < 16; ++r) { const int i = 32 * mi + (r & 3) + 8 * (r >> 2) + 4 * hh;
            const float gci = *(LAS float*)(lds + GP_GC + 4 * i);
            const float d = (i >= j) ? expf(gci - gcj) : 0.f;
            if (typ == 0) *(LAS float*)(lds + GP_LM + i * 272 + 4 * j) = (i > j) ? acc[r] * d : 0.f;
            else *(LAS bf16_t*)(lds + GP_AS + i * 144 + 2 * j) = (bf16_t)f2bf((i >= j) ? acc[r] * d : 0.f); }
    }
    __syncthreads();
    if (w == 0) {
        float x[64];
#pragma unroll
        for (int i = 0; i < 64; ++i) {
            float s0 = (i == lane) ? 1.f : 0.f, s1 = 0.f;
#pragma unroll
            for (int j4 = 0; j4 < (i + 3) / 4; ++j4) { const f32x4 l4 = *(const LAS f32x4*)(lds + GP_LM + i * 272 + 16 * j4);
#pragma unroll
                for (int e = 0; e < 4; ++e) { const int j = 4 * j4 + e; if (j < i) { if (e & 1) s1 -= l4[e] * x[j]; else s0 -= l4[e] * x[j]; } } }
            x[i] = s0 + s1;
        }
#pragma unroll
        for (int i = 0; i < 64; ++i) *(LAS bf16_t*)(lds + GP_TM + i * 144 + 2 * lane) = (bf16_t)f2bf(x[i]);
    } else {
        for (int task = tid - 64; task < 1536; task += 448) {
            const int ll = task & 63, hq = ll >> 5;
            if (task < 1024) { const int f = task >> 6, db = f >> 2, tb = (f >> 1) & 1, s = f & 1, dk = 32 * db + (ll & 31), t0 = 32 * tb + 16 * s + 4 * hq;
                const u32x2 lo = *(const LAS u32x2*)(lds + GP_KT2 + dk * 144 + 2 * t0), hi = *(const LAS u32x2*)(lds + GP_KT2 + dk * 144 + 2 * (t0 + 8));
                *(u32x4*)(gc + GC_KG + (f * 64 + ll) * 16) = (u32x4){lo.x, lo.y, hi.x, hi.y}; }
            else { const int f = (task - 1024) >> 6, mb = f >> 2, tb = (f >> 1) & 1, s = f & 1, i = 32 * mb + (ll & 31), j0 = 32 * tb + 16 * s + 4 * hq;
                const u32x2 lo = *(const LAS u32x2*)(lds + GP_AS + i * 144 + 2 * j0), hi = *(const LAS u32x2*)(lds + GP_AS + i * 144 + 2 * (j0 + 8));
                *(u32x4*)(gc + GC_AT + (f * 64 + ll) * 16) = (u32x4){lo.x, lo.y, hi.x, hi.y}; }
        }
    }
    __syncthreads();
    {
        const LAS unsigned char* Bb = lds + (w < 4 ? GP_VT : GP_KGT) + (32 * (w & 3) + l31) * 144 + 16 * hh;
#pragma unroll
        for (int mb = 0; mb < 2; ++mb) {
            f32x16 acc;
#pragma unroll
            for (int r = 0; r < 16; ++r) acc[r] = 0.f;
            const LAS unsigned char* Ab = lds + GP_TM + (32 * mb + l31) * 144 + 16 * hh;
#pragma unroll
            for (int ks = 0; ks < 4; ++ks) acc = MFMA32(*(const LAS bf16x8*)(Ab + 32 * ks), *(const LAS bf16x8*)(Bb + 32 * ks), acc);
            if (w < 4) { unsigned* up = (unsigned*)(gc + GC_U) + ((w * 2 + mb) * 8) * 64 + lane;
#pragma unroll
                for (int q = 0; q < 8; ++q) up[q * 64] = pk2(acc[2 * q], acc[2 * q + 1]); }
            else {
#pragma unroll
                for (int r = 0; r < 16; ++r) { const int tt = 32 * mb + (r & 3) + 8 * (r >> 2) + 4 * hh;
                    *(LAS bf16_t*)(lds + GP_WST + tt * 272 + 2 * (32 * (w - 4) + l31)) = (bf16_t)f2bf(-acc[r]); } }
        }
    }
    __syncthreads();
#pragma unroll
    for (int q = 0; q < 2; ++q) { const int task = tid + 512 * q, f = task >> 6, ll = task & 63, hq = ll >> 5, mb = f >> 3, kb = (f >> 1) & 3, s = f & 1;
        const int tt = 32 * mb + (ll & 31), d0 = 32 * kb + 16 * s + 4 * hq;
        const u32x2 lo = *(const LAS u32x2*)(lds + GP_WST + tt * 272 + 2 * d0), hi = *(const LAS u32x2*)(lds + GP_WST + tt * 272 + 2 * (d0 + 8));
        *(u32x4*)(gc + GC_WN + (f * 64 + ll) * 16) = (u32x4){lo.x, lo.y, hi.x, hi.y}; }
}

__device__ __forceinline__ bf16x8 cvt_frag(const f32x16& v, int s) {
    u32x4 w; w.x = pk2(v[8 * s], v[8 * s + 1]); w.y = pk2(v[8 * s + 2], v[8 * s + 3]); w.z = pk2(v[8 * s + 4], v[8 * s + 5]); w.w = pk2(v[8 * s + 6], v[8 * s + 7]);
    return __builtin_bit_cast(bf16x8, w);
}
constexpr int CH_OB = 2 * GC_OPS;
#define CH_LOAD(dst, cidx) do { const unsigned char* _s = gcb + (size_t)(cidx) * GC_STRIDE + lt * 16; _Pragma("unroll") for (int _i = 0; _i < 14; ++_i) dst[_i] = *(const u32x4*)(_s + _i * 4096); } while (0)
#define CH_WRITE(src, bufi) do { LAS unsigned char* _d = lds + (bufi) * GC_OPS + lt * 16; _Pragma("unroll") for (int _i = 0; _i < 14; ++_i) *(LAS u32x4*)(_d + _i * 4096) = src[_i]; } while (0)
#define CH_GATE(dst, cidx) do { const bf16_t* _g = P + (size_t)(b * 2048 + (cidx) * 64 + (lt >> 2)) * NP + C_GATEC + h * 128 + (lt & 3) * 32; _Pragma("unroll") for (int _q = 0; _q < 4; ++_q) dst[_q] = *(const u32x4*)(_g + 8 * _q); } while (0)
#define CH_ULOAD(dst, cidx) do { const unsigned* _u = (const unsigned*)(gcb + (size_t)(cidx) * GC_STRIDE + GC_U) + (w * 2 * 8) * 64 + lane; \
    _Pragma("unroll") for (int _m = 0; _m < 2; ++_m) _Pragma("unroll") for (int _q = 0; _q < 8; ++_q) dst[_m][_q] = _u[(_m * 8 + _q) * 64]; } while (0)
__device__ __forceinline__ void gdn_chain(int layer, int bh, const int tid) {
    CArgs& a = kargs(); LAS unsigned char* lds = lds_base();
    const int lane = tid & 63, w = __builtin_amdgcn_readfirstlane(tid >> 6), hh = lane >> 5, l31 = lane & 31;
    const int b = bh >> 3, h = bh & 7;
    const unsigned char* gcb = a.ws + WS_GC + (size_t)bh * 32 * GC_STRIDE;
    __syncthreads();
    if (w >= 4) {
        const int lt = tid - 256;
        const bf16_t* P = (const bf16_t*)(a.ws + WS_P); bf16_t* YC = (bf16_t*)(a.ws + WS_YC);
        const float* ng = a.in[27] + layer * 128 + (lt & 3) * 32;
        u32x4 ra[14], rb[14], gt[4];
        CH_LOAD(ra, 0); CH_LOAD(rb, 1);
        CH_WRITE(ra, 0);
        CH_LOAD(ra, 2);
        CH_GATE(gt, 0);
        __syncthreads();
#define CH_FINISH(cc) do { const int tt = lt >> 2, qd = lt & 3; const size_t row = (size_t)(b * 2048 + (cc) * 64 + tt); \
            const LAS unsigned char* ob = lds + CH_OB + ((cc) & 1) * 16384 + tt * 256 + qd * 64; float ss = 0.f; \
            _Pragma("unroll") for (int q = 0; q < 4; ++q) { float t8[8]; unpack8(*(const LAS u32x4*)(ob + 16 * q), t8); \
                _Pragma("unroll") for (int e = 0; e < 8; ++e) ss += t8[e] * t8[e]; } \
            ss += __shfl_xor(ss, 1); ss += __shfl_xor(ss, 2); const float r = 1.f / sqrtf(ss * (1.f / 128.f) + 1e-6f); \
            bf16_t* yp = YC + row * 1024 + h * 128 + qd * 32; asm volatile("" ::: "memory"); \
            _Pragma("unroll") for (int q = 0; q < 4; ++q) { float g8[8], o8[8], t8[8]; unpack8(gt[q], g8); unpack8(*(const LAS u32x4*)(ob + 16 * q), t8); \
                const f32x4 n0 = *(const f32x4*)(ng + 8 * q), n1 = *(const f32x4*)(ng + 8 * q + 4); \
                _Pragma("unroll") for (int e = 0; e < 8; ++e) o8[e] = t8[e] * r * (e < 4 ? n0[e & 3] : n1[e & 3]) * silu(g8[e]); \
                *(u32x4*)(yp + 8 * q) = pack8(o8); } } while (0)
        for (int c = 0; c < 32; c += 2) {
            if (c >= 1) { CH_FINISH(c - 1); CH_GATE(gt, c); }
            CH_WRITE(rb, 1);
            if (c + 3 < 32) CH_LOAD(rb, c + 3);
            __syncthreads();
            CH_FINISH(c); CH_GATE(gt, c + 1);
            if (c + 2 < 32) { CH_WRITE(ra, 0); }
            if (c + 4 < 32) CH_LOAD(ra, c + 4);
            __syncthreads();
        }
        CH_FINISH(31);
    } else {
        f32x16 S[4];
#pragma unroll
        for (int kb = 0; kb < 4; ++kb)
#pragma unroll
            for (int r = 0; r < 16; ++r) S[kb][r] = 0.f;
        const float gam_all = (lane < 32) ? *(const float*)(gcb + (size_t)lane * GC_STRIDE + GC_GAMMA) : 0.f;
        unsigned ua[2][8], ub[2][8];
        CH_ULOAD(ua, 0); CH_ULOAD(ub, 1);
        __syncthreads();
#define CH_STEP(c, ucur) do { \
            const LAS unsigned char* ops = lds + ((c) & 1) * GC_OPS + lane * 16; \
            const float gamma = __shfl(gam_all, (c)); \
            f32x16 va[2], oa[2]; \
            _Pragma("unroll") for (int mb = 0; mb < 2; ++mb) _Pragma("unroll") for (int q = 0; q < 8; ++q) { va[mb][2 * q] = bflo(ucur[mb][q]); va[mb][2 * q + 1] = bfhi(ucur[mb][q]); } \
            _Pragma("unroll") for (int r = 0; r < 16; ++r) { oa[0][r] = 0.f; oa[1][r] = 0.f; } \
            if ((c) + 2 < 32) CH_ULOAD(ucur, (c) + 2); \
            _Pragma("unroll") for (int kb = 0; kb < 4; ++kb) _Pragma("unroll") for (int s = 0; s < 2; ++s) { const bf16x8 Bs = cvt_frag(S[kb], s); \
                _Pragma("unroll") for (int mb = 0; mb < 2; ++mb) { const int f = (mb * 4 + kb) * 2 + s; \
                    va[mb] = MFMA32(*(const LAS bf16x8*)(ops + GC_WN + f * 1024), Bs, va[mb]); \
                    oa[mb] = MFMA32(*(const LAS bf16x8*)(ops + GC_QG + f * 1024), Bs, oa[mb]); } } \
            _Pragma("unroll") for (int kb = 0; kb < 4; ++kb) _Pragma("unroll") for (int r = 0; r < 16; ++r) S[kb][r] *= gamma; \
            _Pragma("unroll") for (int tb = 0; tb < 2; ++tb) _Pragma("unroll") for (int s = 0; s < 2; ++s) { const bf16x8 Bv = cvt_frag(va[tb], s); \
                _Pragma("unroll") for (int kb = 0; kb < 4; ++kb) S[kb] = MFMA32(*(const LAS bf16x8*)(ops + GC_KG + ((kb * 2 + tb) * 2 + s) * 1024), Bv, S[kb]); \
                _Pragma("unroll") for (int mb = 0; mb < 2; ++mb) if (mb >= tb) oa[mb] = MFMA32(*(const LAS bf16x8*)(ops + GC_AT + ((mb * 2 + tb) * 2 + s) * 1024), Bv, oa[mb]); } \
            LAS unsigned char* ob = lds + CH_OB + ((c) & 1) * 16384; \
            _Pragma("unroll") for (int mb = 0; mb < 2; ++mb) _Pragma("unroll") for (int r = 0; r < 16; ++r) { const int tt = 32 * mb + (r & 3) + 8 * (r >> 2) + 4 * hh; \
                *(LAS bf16_t*)(ob + tt * 256 + 2 * (32 * w + l31)) = (bf16_t)f2bf(oa[mb][r]); } \
            __syncthreads(); } while (0)
        for (int c = 0; c < 32; c += 2) { CH_STEP(c, ua); CH_STEP(c + 1, ub); }
        float* so = a.out + O_DP + (size_t)((layer * 4 + b) * 8 + h) * 128 * 128 + 32 * w + l31;
#pragma unroll
        for (int kb = 0; kb < 4; ++kb)
#pragma unroll
            for (int r = 0; r < 16; ++r) so[(size_t)(32 * kb + (r & 3) + 8 * (r >> 2) + 4 * hh) * 128] = S[kb][r];
    }
}

__device__ __forceinline__ void gdn_sample_item(int layer, int item, const int tid) {
    CArgs& a = kargs(); LAS unsigned char* lds = lds_base();
    const int lane = tid & 63, w = __builtin_amdgcn_readfirstlane(tid >> 6);
    const int b = item >> 3, h = item & 7, rbase = TP + b * 4;
    const bf16_t* P = (const bf16_t*)(a.ws + WS_P); const float* AB = (const float*)(a.ws + WS_AB); bf16_t* YC = (bf16_t*)(a.ws + WS_YC);
    LAS float* qs = (LAS float*)lds; LAS float* ks = qs + 512; LAS float* vs = ks + 512;
    LAS float* red = vs + 512;
    LAS float* dots = red + 4096; LAS float* gcv = dots + 32; LAS float* btv = gcv + 4; LAS float* ob = btv + 4;
    const int dv = (w & 1) * 64 + lane, sl = w >> 1, dk0 = sl * 32;
    float S[32];
    { const float* s0 = a.in[4] + ((size_t)((layer * 128 + b) * 8 + h) * 128 + dk0) * 128 + dv;
#pragma unroll
      for (int i = 0; i < 32; ++i) S[i] = s0[(size_t)i * 128]; }
    __syncthreads();
    {
        const float* convw = a.in[24] + (size_t)layer * 4 * 3072; const float* sconv = a.in[5] + (size_t)(layer * 128 + b) * 3 * 3072;
        float* co = a.out + O_CS + (size_t)(layer * 128 + b) * 3 * 3072;
        for (int idx = tid; idx < 4 * 384; idx += 512) {
            const int t = idx / 384, ch = idx - t * 384, sec = ch >> 7, cc = ch & 127, col = sec * 1024 + h * 128 + cc;
            float accv = 0.f;
#pragma unroll
            for (int j = 0; j < 4; ++j) { const int tt = t - 3 + j;
                const float x = (tt >= 0) ? bf2f(P[(size_t)(rbase + tt) * NP + C_QKV + col]) : sconv[(3 + tt) * 3072 + col];
                if (j == 3 && t >= 1) co[(t - 1) * 3072 + col] = x;
                accv += convw[j * 3072 + col] * x; }
            LAS float* dst = sec == 0 ? qs : (sec == 1 ? ks : vs); dst[t * 128 + cc] = silu(accv);
        }
        if (tid < 4) { const size_t row = (size_t)(rbase + tid); const float ac = AB[row * 16 + h], bc = AB[row * 16 + 8 + h];
            gcv[tid] = -expf(a.in[25][layer * 8 + h]) * softplus(ac + a.in[26][layer * 8 + h]); btv[tid] = sigm(bc); }
    }
    __syncthreads();
    if (w < 4) { const int t = w;
        { const float q0 = qs[t * 128 + lane], q1 = qs[t * 128 + 64 + lane]; const float ss = wave_sum(q0 * q0 + q1 * q1);
          const float r = (1.f / sqrtf(ss + 1e-6f)) * 0.08838834764831845f; qs[t * 128 + lane] = q0 * r; qs[t * 128 + 64 + lane] = q1 * r; }
        { const float k0 = ks[t * 128 + lane], k1 = ks[t * 128 + 64 + lane]; const float ss = wave_sum(k0 * k0 + k1 * k1);
          const float r = 1.f / sqrtf(ss + 1e-6f); ks[t * 128 + lane] = k0 * r; ks[t * 128 + 64 + lane] = k1 * r; } }
    __syncthreads();
    {
#pragma unroll
        for (int q = 0; q < 4; ++q) { const int id = w * 4 + q, typ = id >> 4, i = (id >> 2) & 3, j = id & 3;
            const LAS float* xa = (typ ? qs : ks) + i * 128; const LAS float* xb = ks + j * 128;
            const float d = wave_sum(xa[lane] * xb[lane] + xa[64 + lane] * xb[64 + lane]);
            if (lane == 0) dots[id] = d; }
        float pk[4], pq[4];
#pragma unroll
        for (int j = 0; j < 4; ++j) { pk[j] = 0.f; pq[j] = 0.f; }
#pragma unroll
        for (int i = 0; i < 32; i += 4)
#pragma unroll
            for (int j = 0; j < 4; ++j) { const f32x4 kk = *(const LAS f32x4*)(ks + j * 128 + dk0 + i), qq = *(const LAS f32x4*)(qs + j * 128 + dk0 + i);
                pk[j] += kk[0] * S[i] + kk[1] * S[i + 1] + kk[2] * S[i + 2] + kk[3] * S[i + 3];
                pq[j] += qq[0] * S[i] + qq[1] * S[i + 1] + qq[2] * S[i + 2] + qq[3] * S[i + 3]; }
#pragma unroll
        for (int j = 0; j < 4; ++j) { red[(j * 4 + sl) * 128 + dv] = pk[j]; red[((4 + j) * 4 + sl) * 128 + dv] = pq[j]; }
    }
    __syncthreads();
    {
        float gc[4], bt[4];
        gc[0] = gcv[0]; gc[1] = gc[0] + gcv[1]; gc[2] = gc[1] + gcv[2]; gc[3] = gc[2] + gcv[3];
#pragma unroll
        for (int j = 0; j < 4; ++j) bt[j] = btv[j];
        float L[4][4], Tm[4][4];
#pragma unroll
        for (int i = 0; i < 4; ++i)
#pragma unroll
            for (int j = 0; j < 4; ++j) L[i][j] = (i > j) ? bt[i] * dots[i * 4 + j] * expf(gc[i] - gc[j]) : 0.f;
#pragma unroll
        for (int i = 0; i < 4; ++i)
#pragma unroll
            for (int c = 0; c < 4; ++c) { float s = (i == c) ? 1.f : 0.f;
#pragma unroll
                for (int j = 0; j < 4; ++j) if (j < i) s -= L[i][j] * Tm[j][c];
                Tm[i][c] = s; }
        float kS[4], qS[4], rhs[4], vn[4];
#pragma unroll
        for (int j = 0; j < 4; ++j) { kS[j] = (red[(j * 4 + 0) * 128 + dv] + red[(j * 4 + 1) * 128 + dv]) + (red[(j * 4 + 2) * 128 + dv] + red[(j * 4 + 3) * 128 + dv]);
            qS[j] = (red[((4 + j) * 4 + 0) * 128 + dv] + red[((4 + j) * 4 + 1) * 128 + dv]) + (red[((4 + j) * 4 + 2) * 128 + dv] + red[((4 + j) * 4 + 3) * 128 + dv]);
            rhs[j] = bt[j] * (vs[j * 128 + dv] - expf(gc[j]) * kS[j]); }
#pragma unroll
        for (int i = 0; i < 4; ++i) { float s = 0.f;
#pragma unroll
            for (int j = 0; j < 4; ++j) if (j <= i) s += Tm[i][j] * rhs[j];
            vn[i] = s; }
        if (sl == 0) {
#pragma unroll
            for (int i = 0; i < 4; ++i) { float o = expf(gc[i]) * qS[i];
#pragma unroll
                for (int j = 0; j < 4; ++j) if (j <= i) o += dots[16 + i * 4 + j] * expf(gc[i] - gc[j]) * vn[j];
                ob[i * 128 + dv] = o; } }
        const float gl = gc[3], egl = expf(gl);
        float cf[4];
#pragma unroll
        for (int j = 0; j < 4; ++j) cf[j] = expf(gl - gc[j]) * vn[j];
        float* so = a.out + O_DS + ((size_t)((layer * 128 + b) * 8 + h) * 128 + dk0) * 128 + dv;
#pragma unroll
        for (int i = 0; i < 32; ++i) { float s = egl * S[i];
#pragma unroll
            for (int j = 0; j < 4; ++j) s += ks[j * 128 + dk0 + i] * cf[j];
            so[(size_t)i * 128] = s; }
    }
    __syncthreads();
    if (w < 4) { const int t = w; const float* ng = a.in[27] + layer * 128;
        const float o0 = ob[t * 128 + lane], o1 = ob[t * 128 + 64 + lane]; const float ss = wave_sum(o0 * o0 + o1 * o1);
        const float r = 1.f / sqrtf(ss * (1.f / 128.f) + 1e-6f); const size_t row = (size_t)(rbase + t);
        const float g0 = bf2f(P[row * NP + C_GATEC + h * 128 + lane]), g1 = bf2f(P[row * NP + C_GATEC + h * 128 + 64 + lane]);
        YC[row * 1024 + h * 128 + lane] = (bf16_t)f2bf(o0 * r * ng[lane] * silu(g0));
        YC[row * 1024 + h * 128 + 64 + lane] = (bf16_t)f2bf(o1 * r * ng[64 + lane] * silu(g1)); }
}

__device__ __forceinline__ void phase_mixers(int layer, int G, int bid, int tid0) {
#ifndef PROBE_MIX
#define PROBE_MIX -1
#endif
#define PM(x) (PROBE_MIX == -1 || PROBE_MIX == (x))
    if (bid < 80) {
        const int tid = launder_v(tid0), lane = tid & 63, w = __builtin_amdgcn_readfirstlane(tid >> 6);
        if (w < 4) { const int it = launder_s(launder_s(bid) * 4 + w);
            if (it < 256) { if (PM(1)) s5_item<false>(layer, it, w * S5_WLDS, lane); }
            else if (it < 320) { if (PM(2)) s5_item<true>(layer, it - 256, w * S5_WLDS, lane); } }
        return;
    }
    const int nw = G - 80;
    for (int it = bid - 80; it < 1024 + 64 + 16 + 1024; it += nw) {
        const int tid = launder_v(tid0), lane = tid & 63, w = tid >> 6;
        if (it < 1024) { if (PM(0)) gdn_prep_item(layer, launder_s(it), tid); }
        else if (it < 1088) { if (PM(3)) gmlp_prompt_item(layer, launder_s(it) - 1024, tid); }
        else if (it < 1104) { if (PM(4)) gmlp_sample_item(layer, (launder_s(it) - 1088) * 8 + w, lane); }
        else { if (PM(5)) gdn_sample_item(layer, launder_s(it) - 1104, tid); }
    }
}

__global__ void __launch_bounds__(512, 2) mega(Args karg) {
    const int ph_lo = karg.ph_lo, ph_hi = karg.ph_hi;
#ifndef REP_SUB
#define REP_SUB -1
#endif
#ifndef REP_N
#define REP_N 2
#endif
    int rep = 0;
    for (int ph = ph_lo; ph < ph_hi; (REP_SUB >= 0 && ph >= 1 && (ph - 1) % 6 == REP_SUB && rep + 1 < REP_N) ? (void)++rep : (void)(rep = 0, ++ph)) {
        if (ph > ph_lo && rep == 0) { cg::this_grid().sync(); }
        const int G = launder_s((int)gridDim.x), bid = launder_s((int)blockIdx.x), tid = launder_v((int)threadIdx.x);
        CArgs& a = kargs(); LAS unsigned char* lds = lds_base();
        unsigned char* ws = a.ws;
#ifndef PROBE_SUB
#define PROBE_SUB -1
#endif
#define PS(x) (PROBE_SUB == -1 || PROBE_SUB == (x))
        if (ph == 0) { if (PS(6)) phase_convert(a, lds, G, bid, tid); continue; }
        const int layer = (ph - 1) / 6, sub = (ph - 1) % 6;
        unsigned char* wb = ws + WS_W0 + (size_t)layer * WS_WL;
        if (PS(0) && sub == 0) {
            pg8::Gemm g{(const bf16_t*)(ws + WS_XB), nullptr, nullptr, (const bf16_t*)(wb + WO_IN), nullptr, nullptr, DM};
            pg8::Sched S; S.init(MT / 256, NP / 256, 1, G, bid);
            pg8::Epi1 E{(bf16_t*)(ws + WS_P), (float*)(ws + WS_AB)};
            pg8::gemm_phase(lds, g, S, E, tid);
        } else if (PS(1) && sub == 1) {
            phase_mixers(layer, G, bid, tid);
        } else if (PS(2) && sub == 2) {
            if (bid < 32) { gdn_chain(layer, bid, tid); }
            else {
            pg8::Gemm g{(const bf16_t*)(ws + WS_ZB), nullptr, nullptr, (const bf16_t*)(wb + WO_GLU), nullptr, nullptr, 1024};
            pg8::Sched S; S.init(MT / 256, 4, 1, G - 32, bid - 32);
            pg8::Epi2 E{(const bf16_t*)(ws + WS_ZB), (const bf16_t*)(ws + WS_P), a.in[17] + layer * 1024, (bf16_t*)(ws + WS_YA)};
            pg8::gemm_phase(lds, g, S, E, tid);
            }
        } else if (PS(3) && sub == 3) {
            pg8::Gemm g{(const bf16_t*)(ws + WS_YA), (const bf16_t*)(ws + WS_YB), (const bf16_t*)(ws + WS_YC),
                        (const bf16_t*)(wb + WO_PA), (const bf16_t*)(wb + WO_PB), (const bf16_t*)(wb + WO_PC), 1024};
            pg8::Sched S; S.init(MT / 256, 8, 3, G, bid);
            pg8::Epi3 E{(const bf16_t*)(ws + WS_P), a.in[7] + layer * 3 * DM, (float*)(ws + WS_M32), (bf16_t*)(ws + WS_MB)};
            pg8::gemm_phase(lds, g, S, E, tid);
        } else if (PS(4) && sub == 4) {
            pg8::Gemm g{(const bf16_t*)(ws + WS_MB), nullptr, nullptr, (const bf16_t*)(wb + WO_OUT), nullptr, nullptr, DM};
            pg8::Sched S; S.init(MT / 256, 8, 1, G, bid);
            const float* xp = layer == 0 ? a.in[0] : (const float*)(ws + WS_X32);
            const float* xs = layer == 0 ? a.in[1] : (const float*)(ws + WS_X32) + (size_t)TP * DM;
            pg8::Epi4 E{xp, xs, (float*)(ws + WS_H32)};
            pg8::gemm_phase(lds, g, S, E, tid);
        } else if (PS(5) && sub == 5) {
            phase_ln(a, layer, G, bid, tid);
        }
    }
}

extern "C" void kernel_launch(void* const* d_in, const int* in_sizes, int n_in, void* d_out, int out_size, void* d_ws, size_t ws_size, hipStream_t stream) {
    static int grid = 0;
    if (grid == 0) {
        if (n_in != 32 || (size_t)out_size != O_END || ws_size < WS_END) {
            fprintf(stderr, "kernel_launch: unexpected problem: n_in %d out %d ws %zu (need %zu)\n", n_in, out_size, ws_size, (size_t)WS_END); grid = -1; return; }
        int dev = 0, cus = 0, per_cu = 0;
        if (hipGetDevice(&dev) != hipSuccess || hipDeviceGetAttribute(&cus, hipDeviceAttributeMultiprocessorCount, dev) != hipSuccess) { grid = -1; return; }
        if (hipFuncSetAttribute((const void*)mega, hipFuncAttributeMaxDynamicSharedMemorySize, LDS_BYTES) != hipSuccess) { fprintf(stderr, "kernel_launch: hipFuncSetAttribute failed\n"); grid = -1; return; }
        if (hipOccupancyMaxActiveBlocksPerMultiprocessor(&per_cu, (const void*)mega, 512, LDS_BYTES) != hipSuccess || per_cu < 1) {
            fprintf(stderr, "kernel_launch: occupancy query says %d blocks per CU\n", per_cu); (void)hipGetLastError(); grid = -1; return; }
        grid = cus;
    }
    if (grid < 0) return;
    Args a{};
    for (int i = 0; i < 32; ++i) a.in[i] = (const float*)d_in[i];
    a.out = (float*)d_out; a.ws = (unsigned char*)d_ws;
#if MK_SINGLE
    a.ph_lo = 0; a.ph_hi = NPHASE;
    void* params[] = {&a};
    hipError_t e = hipLaunchCooperativeKernel((const void*)mega, dim3(grid), dim3(512), params, LDS_BYTES, stream);
    if (e != hipSuccess) fprintf(stderr, "kernel_launch: cooperative launch failed: %s (grid %d)\n", hipGetErrorString(e), grid);
#else
    for (int ph = 0; ph < NPHASE; ++ph) {
        a.ph_lo = ph; a.ph_hi = ph + 1;
        hipLaunchKernelGGL(mega, dim3(grid), dim3(512), LDS_BYTES, stream, a);
    }
#endif
}
```

```cpp
#include <hip/hip_runtime.h>
#include <hip/hip_cooperative_groups.h>
#include <cstdio>
#include <cstdint>
namespace cg = cooperative_groups;

#ifndef MK_SINGLE
#define MK_SINGLE 1
#endif

#define LAS __attribute__((address_space(3)))
typedef unsigned short bf16_t;
typedef short bf16x8 __attribute__((ext_vector_type(8)));
typedef float f32x4 __attribute__((ext_vector_type(4)));
typedef float f32x2 __attribute__((ext_vector_type(2)));
typedef float f32x16 __attribute__((ext_vector_type(16)));
typedef unsigned u32x4 __attribute__((ext_vector_type(4)));
typedef unsigned u32x2 __attribute__((ext_vector_type(2)));

constexpr int DM = 2048, TP = 8192, TS = 512, MT = TP + TS;
constexpr int NIN = 15376, NP = 15616;
constexpr int C_XA = 0, C_GA = 1024, C_UB = 2048, C_VB = 3072, C_GB = 4096, C_QKV = 5120, C_GATEC = 8192, C_ZG = 9216, C_AB = 15360;
constexpr int NPHASE = 13;
constexpr float ALPHA = 1.41421356237f;

constexpr size_t MiB = 1u << 20;
constexpr size_t WS_CTL = 0;
constexpr size_t WS_W0 = 1 * MiB, WS_WL = 83 * MiB;
constexpr size_t WO_IN = 0, WO_GLU = 61 * MiB, WO_PA = 63 * MiB, WO_PB = 67 * MiB, WO_PC = 71 * MiB, WO_OUT = 75 * MiB;
constexpr size_t WS_XB = 167 * MiB, WS_P = 201 * MiB, WS_AB = 461 * MiB, WS_ZB = 462 * MiB, WS_YA = 479 * MiB, WS_YB = 496 * MiB, WS_YC = 513 * MiB;
constexpr size_t WS_M32 = 530 * MiB, WS_MB = 598 * MiB, WS_H32 = 632 * MiB, WS_X32 = 700 * MiB, WS_END = 768 * MiB;

constexpr size_t O_YP = 0, O_YS = 16777216, O_SRP = 17825792, O_SIP = 17858560, O_DP = 17891328, O_CP = 18939904,
                 O_SRS = 19013632, O_SIS = 20062208, O_DS = 21110784, O_CS = 54665216, O_GV = 57024512, O_END = 58073088;

constexpr int LDS_BYTES = 147456;

struct Args { const float* in[32]; float* out; unsigned char* ws; int ph_lo, ph_hi; };
typedef const __attribute__((address_space(4))) Args CArgs;

__device__ __forceinline__ unsigned f2bf(float f) { unsigned u = __builtin_bit_cast(unsigned, f); return (u + 0x7fffu + ((u >> 16) & 1u)) >> 16; }
__device__ __forceinline__ unsigned pk2(float lo, float hi) { return f2bf(lo) | (f2bf(hi) << 16); }
__device__ __forceinline__ float bf2f(unsigned short h) { return __builtin_bit_cast(float, (unsigned)h << 16); }
__device__ __forceinline__ float bflo(unsigned w) { return __builtin_bit_cast(float, w << 16); }
__device__ __forceinline__ float bfhi(unsigned w) { return __builtin_bit_cast(float, w & 0xffff0000u); }
__device__ __forceinline__ float sigm(float x) { return 1.f / (1.f + __expf(-x)); }
__device__ __forceinline__ float silu(float x) { return x / (1.f + __expf(-x)); }
__device__ __forceinline__ float gelu_tanh(float x) { return x * sigm(1.5957691216f * (x + 0.044715f * x * x * x)); }
__device__ __forceinline__ float softplus(float x) { return x > 20.f ? x : log1pf(expf(x)); }
__device__ __forceinline__ float wave_sum(float v) {
#pragma unroll
    for (int o = 1; o < 64; o <<= 1) v += __shfl_xor(v, o);
    return v;
}
__device__ __forceinline__ void unpack8(const u32x4 w, float (&f)[8]) {
    f[0] = bflo(w.x); f[1] = bfhi(w.x); f[2] = bflo(w.y); f[3] = bfhi(w.y); f[4] = bflo(w.z); f[5] = bfhi(w.z); f[6] = bflo(w.w); f[7] = bfhi(w.w);
}
__device__ __forceinline__ u32x4 pack8(const float (&f)[8]) { u32x4 w; w.x = pk2(f[0], f[1]); w.y = pk2(f[2], f[3]); w.z = pk2(f[4], f[5]); w.w = pk2(f[6], f[7]); return w; }
#define LDS_WAIT() asm volatile("s_waitcnt lgkmcnt(0)" ::: "memory")
__device__ __forceinline__ int launder_v(int x) { asm volatile("" : "+v"(x)); return x; }
__device__ __forceinline__ int launder_s(int x) { asm volatile("" : "+s"(x)); return x; }
__device__ __forceinline__ CArgs& kargs() { int z; asm volatile("s_mov_b32 %0, 0" : "=s"(z));
    return *(CArgs*)((const __attribute__((address_space(4))) char*)__builtin_amdgcn_kernarg_segment_ptr() + z); }
__device__ __forceinline__ LAS unsigned char* lds_base() { extern __shared__ __attribute__((aligned(16))) unsigned char lds_raw[]; int z; asm volatile("s_mov_b32 %0, 0" : "=s"(z));
    return (LAS unsigned char*)lds_raw + z; }

namespace pg8 {
constexpr int BM = 256, BK = 64, HALF = 128, HTB = HALF * BK * 2, STAGE_BYTES = 8 * HTB, NXCD = 8, WGM = 8;
__device__ __forceinline__ int lds_byte(int r, int c) { const int st = (r >> 4) * 2 + (c >> 5), rr = r & 15, cc = c & 31, ob = rr * 64 + cc * 2; return st * 1024 + (ob ^ (((ob >> 9) & 1) << 5)); }
__device__ __forceinline__ void stage_rc(int b, int& R, int& C) { const int st = b / 1024, sb = b % 1024, swz = sb ^ (((sb >> 9) & 1) << 5); R = (st >> 1) * 16 + swz / 64; C = (st & 1) * 32 + (swz % 64) / 2; }
__device__ __forceinline__ int perm32(int rho) { const int n = rho >> 4, i = rho & 15; return 8 * (i >> 2) + 4 * n + (i & 3); }

struct Unit { int pm, pn, br; };
struct Gemm { const bf16_t* A0; const bf16_t* A1; const bf16_t* A2; const bf16_t* B0; const bf16_t* B1; const bf16_t* B2; int K; };

struct Sched {
    int nM, nN, nbr, nwg, G, c;
    __device__ __forceinline__ void init(int nM_, int nN_, int nbr_, int G_, int c_) { nM = nM_; nN = nN_; nbr = nbr_; nwg = nM * nN; G = G_; c = c_; }
    __device__ __forceinline__ bool next(int i, Unit& u) const {
        const int ti = i / nbr; u.br = i - ti * nbr;
        const long L = (long)ti * G + c; if (L >= nwg) return false;
        int wgid = (int)L; { const int q = nwg / NXCD, r = nwg % NXCD, xcd = wgid % NXCD, off = wgid / NXCD; wgid = (xcd < r ? xcd * (q + 1) : r * (q + 1) + (xcd - r) * q) + off; }
        const int nig = WGM * nN, gid = wgid / nig, fm = gid * WGM, gsz = (nM - fm) < WGM ? (nM - fm) : WGM;
        u.pm = fm + ((wgid % nig) % gsz); u.pn = (wgid % nig) / gsz; return true;
    }
};

template <class Epi>
__device__ __forceinline__ void gemm_phase(LAS unsigned char* lds, const Gemm g, const Sched& S, const Epi& E, const int tid) {
    const int wid = __builtin_amdgcn_readfirstlane(tid >> 6), lane = tid & 63, wr = wid >> 2, wc = wid & 3, fr = lane & 15, fq = lane >> 4;
    const int K = g.K, nt = K / BK;
    unsigned voffA[2], voffB[2];
#pragma unroll
    for (int i = 0; i < 2; ++i) { int R, C; stage_rc(tid * 16 + i * 8192, R, C); const int Rb = (R & ~31) + perm32(R & 31);
        voffA[i] = (unsigned)(R * K + C) * 2u; voffB[i] = (unsigned)(Rb * K + C) * 2u; }
    const size_t kstep = (size_t)(BK * 2);
    const size_t hstep = (size_t)HALF * K * 2;
    const size_t tstep = 2 * hstep;
    const unsigned ldsw = (unsigned)wid * 1024u;
    const int aoff = lds_byte(wr * 64 + fr, fq * 8), boff = lds_byte(wc * 32 + fr, fq * 8);
#define PG8_SA(b, h) (((b) * 2 + (h)) * HTB)
#define PG8_SB(b, h) ((4 + (b) * 2 + (h)) * HTB)
#define PG8_STAGE(bufoff, gbase, voff) do { _Pragma("unroll") for (int _i = 0; _i < 2; ++_i) \
        __builtin_amdgcn_global_load_lds((const unsigned*)((const char*)(gbase) + (voff)[_i]), (LAS unsigned*)(lds + (bufoff) + ldsw + _i * 8192), 16, 0, 0); } while (0)
#define PG8_LDA(dst, b, h) do { _Pragma("unroll") for (int m = 0; m < 4; ++m) _Pragma("unroll") for (int k = 0; k < 2; ++k) dst[m][k] = *(const LAS bf16x8*)(lds + PG8_SA(b, h) + aoff + m * 2048 + k * 1024); } while (0)
#define PG8_LDB(dst, b, h) do { _Pragma("unroll") for (int n = 0; n < 2; ++n) _Pragma("unroll") for (int k = 0; k < 2; ++k) dst[n][k] = *(const LAS bf16x8*)(lds + PG8_SB(b, h) + boff + n * 2048 + k * 1024); } while (0)
#define PG8_MMA(ai, bj, At, Bt) do { __builtin_amdgcn_s_setprio(1); _Pragma("unroll") for (int m = 0; m < 4; ++m) _Pragma("unroll") for (int n = 0; n < 2; ++n) _Pragma("unroll") for (int k = 0; k < 2; ++k) \
        acc[ai][bj][m][n] = __builtin_amdgcn_mfma_f32_16x16x32_bf16(Bt[n][k], At[m][k], acc[ai][bj][m][n], 0, 0, 0); __builtin_amdgcn_s_setprio(0); } while (0)
#define PG8_WAIT_V(n) asm volatile("s_waitcnt vmcnt(" #n ")" ::: "memory")
#define PG8_WAIT_L(n) asm volatile("s_waitcnt lgkmcnt(" #n ")" ::: "memory")
#define PG8_BAR __builtin_amdgcn_s_barrier()
#define PG8_SCHED __builtin_amdgcn_sched_barrier(0)
#define PG8_APTR(u) ((const char*)((u).br == 0 ? g.A0 : ((u).br == 1 ? g.A1 : g.A2)) + (size_t)(u).pm * tstep)
#define PG8_BPTR(u) ((const char*)((u).br == 0 ? g.B0 : ((u).br == 1 ? g.B1 : g.B2)) + (size_t)(u).pn * tstep)
    Unit cur, nxt; int ui = 0;
    if (!S.next(0, cur)) return;
    f32x4 acc[2][2][4][2];
#pragma unroll
    for (int a = 0; a < 2; ++a)
#pragma unroll
        for (int b = 0; b < 2; ++b)
#pragma unroll
            for (int m = 0; m < 4; ++m)
#pragma unroll
                for (int n = 0; n < 2; ++n) acc[a][b][m][n] = (f32x4){0.f, 0.f, 0.f, 0.f};
    bf16x8 At[4][2], B0[2][2], B1[2][2];
    const char* cA = PG8_APTR(cur); const char* cB = PG8_BPTR(cur);
    PG8_STAGE(PG8_SB(0, 0), cB, voffB); PG8_STAGE(PG8_SB(0, 1), cB + hstep, voffB); PG8_STAGE(PG8_SA(0, 0), cA, voffA); PG8_STAGE(PG8_SA(0, 1), cA + hstep, voffA);
    if (wr == 1) PG8_BAR;
    PG8_WAIT_V(2); PG8_BAR;
    PG8_STAGE(PG8_SB(1, 0), cB + kstep, voffB); PG8_STAGE(PG8_SA(1, 0), cA + kstep, voffA); PG8_STAGE(PG8_SB(1, 1), cB + hstep + kstep, voffB);
    PG8_WAIT_V(6); PG8_BAR;
    for (;;) {
        const bool has_next = S.next(ui + 1, nxt);
        const char* nA = has_next ? PG8_APTR(nxt) : cA; const char* nB = has_next ? PG8_BPTR(nxt) : cB;
        for (int t = 0; t < nt; t += 2) {
            const bool last = (t == nt - 2);
            const char* a1 = cA + (size_t)(t + 1) * kstep;
            const char* a2 = last ? nA : cA + (size_t)(t + 2) * kstep; const char* b2 = last ? nB : cB + (size_t)(t + 2) * kstep;
            const char* a3 = a2 + kstep; const char* b3 = b2 + kstep;
            PG8_LDB(B0, 0, 0); PG8_LDB(B1, 0, 1); PG8_SCHED; PG8_LDA(At, 0, 0); PG8_STAGE(PG8_SA(1, 1), a1 + hstep, voffA);
            PG8_WAIT_V(8); PG8_WAIT_L(0); PG8_BAR; PG8_MMA(0, 0, At, B0); PG8_MMA(0, 1, At, B1); PG8_BAR; PG8_SCHED;
            PG8_LDA(At, 0, 1); PG8_STAGE(PG8_SB(0, 0), b2, voffB); PG8_STAGE(PG8_SB(0, 1), b2 + hstep, voffB); PG8_STAGE(PG8_SA(0, 0), a2, voffA);
            PG8_WAIT_V(8); PG8_WAIT_L(0); PG8_BAR; PG8_MMA(1, 0, At, B0); PG8_MMA(1, 1, At, B1); PG8_BAR; PG8_SCHED;
            PG8_LDB(B0, 1, 0); PG8_LDB(B1, 1, 1); PG8_SCHED; PG8_LDA(At, 1, 0); PG8_STAGE(PG8_SA(0, 1), a2 + hstep, voffA);
            PG8_WAIT_V(8); PG8_WAIT_L(0); PG8_BAR; PG8_MMA(0, 0, At, B0); PG8_MMA(0, 1, At, B1); PG8_BAR; PG8_SCHED;
            PG8_LDA(At, 1, 1); PG8_STAGE(PG8_SB(1, 0), b3, voffB); PG8_STAGE(PG8_SB(1, 1), b3 + hstep, voffB); PG8_STAGE(PG8_SA(1, 0), a3, voffA);
            PG8_WAIT_V(8); PG8_WAIT_L(0); PG8_BAR; PG8_MMA(1, 0, At, B0); PG8_MMA(1, 1, At, B1); PG8_BAR; PG8_SCHED;
        }
        if (wr == 0) PG8_BAR;
        E(acc, cur, wr, wc, fr, fq);
        if (!has_next) break;
#pragma unroll
        for (int a = 0; a < 2; ++a)
#pragma unroll
            for (int b = 0; b < 2; ++b)
#pragma unroll
                for (int m = 0; m < 4; ++m)
#pragma unroll
                    for (int n = 0; n < 2; ++n) acc[a][b][m][n] = (f32x4){0.f, 0.f, 0.f, 0.f};
        cur = nxt; cA = nA; cB = nB; ++ui;
        if (wr == 1) PG8_BAR;
    }
    PG8_WAIT_V(0);
    PG8_BAR;
#undef PG8_SA
#undef PG8_SB
#undef PG8_STAGE
#undef PG8_LDA
#undef PG8_LDB
#undef PG8_MMA
#undef PG8_WAIT_V
#undef PG8_WAIT_L
#undef PG8_BAR
#undef PG8_SCHED
#undef PG8_APTR
#undef PG8_BPTR
}

struct Epi1 {
    bf16_t* P; float* AB;
    __device__ __forceinline__ void operator()(const f32x4 (&acc)[2][2][4][2], const Unit& u, int wr, int wc, int fr, int fq) const {
        const int row0 = u.pm * BM + wr * 64 + fr, col0 = u.pn * BM + wc * 32 + 8 * fq;
#pragma unroll
        for (int ai = 0; ai < 2; ++ai)
#pragma unroll
            for (int m = 0; m < 4; ++m) { bf16_t* rowp = P + (size_t)(row0 + ai * HALF + m * 16) * NP + col0;
#pragma unroll
                for (int bj = 0; bj < 2; ++bj) { const f32x4 v0 = acc[ai][bj][m][0], v1 = acc[ai][bj][m][1];
                    u32x4 w; w.x = pk2(v0[0], v0[1]); w.y = pk2(v0[2], v0[3]); w.z = pk2(v1[0], v1[1]); w.w = pk2(v1[2], v1[3]);
                    *(u32x4*)(rowp + bj * HALF) = w; } }
        if (u.pn == 60 && wc == 0 && fq < 2) {
#pragma unroll
            for (int ai = 0; ai < 2; ++ai)
#pragma unroll
                for (int m = 0; m < 4; ++m) { float* ab = AB + (size_t)(row0 + ai * HALF + m * 16) * 16 + 8 * fq;
                    *(f32x4*)ab = acc[ai][0][m][0]; *(f32x4*)(ab + 4) = acc[ai][0][m][1]; }
        }
    }
};
struct Epi2 {
    const bf16_t* Zb; const bf16_t* P; const float* bglu; bf16_t* YA;
    __device__ __forceinline__ void operator()(const f32x4 (&acc)[2][2][4][2], const Unit& u, int wr, int wc, int fr, int fq) const {
        const int row0 = u.pm * BM + wr * 64 + fr, col0 = u.pn * BM + wc * 32 + 8 * fq;
#pragma unroll
        for (int bj = 0; bj < 2; ++bj) { const int col = col0 + bj * HALF;
            const f32x4 b0 = *(const f32x4*)(bglu + col), b1 = *(const f32x4*)(bglu + col + 4);
#pragma unroll
            for (int ai = 0; ai < 2; ++ai)
#pragma unroll
                for (int m = 0; m < 4; ++m) { const size_t row = (size_t)(row0 + ai * HALF + m * 16);
                    float z[8], ga[8], o[8];
                    unpack8(*(const u32x4*)(Zb + row * 1024 + col), z); unpack8(*(const u32x4*)(P + row * NP + C_GA + col), ga);
                    const f32x4 v0 = acc[ai][bj][m][0] + b0, v1 = acc[ai][bj][m][1] + b1;
#pragma unroll
                    for (int e = 0; e < 4; ++e) { o[e] = z[e] * sigm(v0[e]) * silu(ga[e]); o[4 + e] = z[4 + e] * sigm(v1[e]) * silu(ga[4 + e]); }
                    *(u32x4*)(YA + row * 1024 + col) = pack8(o); } }
    }
};
struct Epi3 {
    const bf16_t* P; const float* bgate; float* M32; bf16_t* Mb;
    __device__ __forceinline__ void operator()(const f32x4 (&acc)[2][2][4][2], const Unit& u, int wr, int wc, int fr, int fq) const {
        const int row0 = u.pm * BM + wr * 64 + fr, col0 = u.pn * BM + wc * 32 + 8 * fq, br = u.br;
#pragma unroll
        for (int bj = 0; bj < 2; ++bj) { const int col = col0 + bj * HALF;
            const f32x4 g0 = *(const f32x4*)(bgate + br * DM + col), g1 = *(const f32x4*)(bgate + br * DM + col + 4);
#pragma unroll
            for (int ai = 0; ai < 2; ++ai)
#pragma unroll
                for (int m = 0; m < 4; ++m) { const size_t row = (size_t)(row0 + ai * HALF + m * 16);
                    float zg[8], o[8];
                    unpack8(*(const u32x4*)(P + row * NP + C_ZG + br * DM + col), zg);
                    const f32x4 a0 = acc[ai][bj][m][0], a1 = acc[ai][bj][m][1];
#pragma unroll
                    for (int e = 0; e < 4; ++e) { o[e] = sigm(zg[e] + g0[e]) * a0[e]; o[4 + e] = sigm(zg[4 + e] + g1[e]) * a1[e]; }
                    float* mp = M32 + row * DM + col;
                    if (br > 0) { const f32x4 p0 = *(const f32x4*)mp, p1 = *(const f32x4*)(mp + 4);
#pragma unroll
                        for (int e = 0; e < 4; ++e) { o[e] += p0[e]; o[4 + e] += p1[e]; } }
                    if (br < 2) { *(f32x4*)mp = (f32x4){o[0], o[1], o[2], o[3]}; *(f32x4*)(mp + 4) = (f32x4){o[4], o[5], o[6], o[7]}; }
                    else *(u32x4*)(Mb + row * DM + col) = pack8(o); } }
    }
};
struct Epi4 {
    const float* xp; const float* xs; float* H32;
    __device__ __forceinline__ void operator()(const f32x4 (&acc)[2][2][4][2], const Unit& u, int wr, int wc, int fr, int fq) const {
        const int row0 = u.pm * BM + wr * 64 + fr, col0 = u.pn * BM + wc * 32 + 8 * fq;
        const float* xb = (u.pm < 32) ? xp : (xs - (size_t)TP * DM);
#pragma unroll
        for (int ai = 0; ai < 2; ++ai)
#pragma unroll
            for (int m = 0; m < 4; ++m) { const size_t row = (size_t)(row0 + ai * HALF + m * 16);
#pragma unroll
                for (int bj = 0; bj < 2; ++bj) { const int col = col0 + bj * HALF;
                    const f32x4 x0 = *(const f32x4*)(xb + row * DM + col), x1 = *(const f32x4*)(xb + row * DM + col + 4);
                    *(f32x4*)(H32 + row * DM + col) = x0 * ALPHA + acc[ai][bj][m][0];
                    *(f32x4*)(H32 + row * DM + col + 4) = x1 * ALPHA + acc[ai][bj][m][1]; } }
    }
};
}

template <bool REMAP>
__device__ __forceinline__ void transpose_item(const float* W, int K, int Nsrc, int Ndst, bf16_t* WT, LAS float* scr, int item, int lane) {
    const int nblk = Ndst / 32, kb = item / nblk, nb = item % nblk, k0 = 64 * kb, n0 = 32 * nb;
    int d = n0 + (lane & 31), s = d; bool valid = true;
    if (REMAP) { if (d < C_GATEC) s = d; else if (d < C_AB) s = d + 16; else if (d < C_AB + 16) s = 8192 + (d - C_AB); else { s = 0; valid = false; } }
#pragma unroll 8
    for (int i = 0; i < 32; ++i) { const int kk = 2 * i + (lane >> 5); scr[kk * 33 + (lane & 31)] = valid ? W[(size_t)(k0 + kk) * Nsrc + s] : 0.f; }
    LDS_WAIT();
    const int c = lane & 7;
#pragma unroll
    for (int j = 0; j < 4; ++j) { const int n = (lane >> 3) + 8 * j; const LAS float* sp = scr + (8 * c) * 33 + n;
        u32x4 o; o.x = pk2(sp[0 * 33], sp[1 * 33]); o.y = pk2(sp[2 * 33], sp[3 * 33]); o.z = pk2(sp[4 * 33], sp[5 * 33]); o.w = pk2(sp[6 * 33], sp[7 * 33]);
        *(u32x4*)(WT + (size_t)(n0 + n) * K + k0 + 8 * c) = o; }
    LDS_WAIT();
}

__device__ __forceinline__ void phase_convert(CArgs& a, LAS unsigned char* lds, int G, int vb, const int tid) {
    const int lane = tid & 63, wave = tid >> 6;
    LAS float* scr = (LAS float*)(lds + wave * 16384);
    const int gw = vb * 8 + wave, NGW = G * 8;
    constexpr int I_IN = (DM / 64) * (NP / 32), I_GLU = (1024 / 64) * (1024 / 32), I_P = (1024 / 64) * (DM / 32), I_OUT = (DM / 64) * (DM / 32);
    constexpr int I_L = I_IN + I_GLU + 3 * I_P + I_OUT;
    for (int it = gw; it < 2 * I_L; it += NGW) {
        const int l = it / I_L; int r = it - l * I_L;
        unsigned char* wb = a.ws + WS_W0 + (size_t)l * WS_WL;
        if (r < I_IN) { transpose_item<true>(a.in[6] + (size_t)l * DM * NIN, DM, NIN, NP, (bf16_t*)(wb + WO_IN), scr, r, lane); continue; } r -= I_IN;
        if (r < I_GLU) { transpose_item<false>(a.in[16] + (size_t)l * 1024 * 1024, 1024, 1024, 1024, (bf16_t*)(wb + WO_GLU), scr, r, lane); continue; } r -= I_GLU;
        if (r < I_P) { transpose_item<false>(a.in[18] + (size_t)l * 1024 * DM, 1024, DM, DM, (bf16_t*)(wb + WO_PA), scr, r, lane); continue; } r -= I_P;
        if (r < I_P) { transpose_item<false>(a.in[23] + (size_t)l * 1024 * DM, 1024, DM, DM, (bf16_t*)(wb + WO_PB), scr, r, lane); continue; } r -= I_P;
        if (r < I_P) { transpose_item<false>(a.in[28] + (size_t)l * 1024 * DM, 1024, DM, DM, (bf16_t*)(wb + WO_PC), scr, r, lane); continue; } r -= I_P;
        transpose_item<false>(a.in[29] + (size_t)l * DM * DM, DM, DM, DM, (bf16_t*)(wb + WO_OUT), scr, r, lane);
    }
    bf16_t* Xb = (bf16_t*)(a.ws + WS_XB);
    for (int m = gw; m < MT; m += NGW) {
        const float* xr = (m < TP) ? a.in[0] + (size_t)m * DM : a.in[1] + (size_t)(m - TP) * DM;
        const f32x4* xv = (const f32x4*)xr + lane; u32x2* o = (u32x2*)(Xb + (size_t)m * DM) + lane;
#pragma unroll
        for (int j = 0; j < 8; ++j) { const f32x4 v = xv[64 * j]; u32x2 w; w.x = pk2(v.x, v.y); w.y = pk2(v.z, v.w); o[64 * j] = w; }
    }
}

__device__ __forceinline__ void phase_ln(CArgs& a, int layer, int G, int vb, const int tid) {
    const int lane = tid & 63, wave = tid >> 6;
    const int gw = vb * 8 + wave, NGW = G * 8;
    const float* H32 = (const float*)(a.ws + WS_H32);
    const float* lg = a.in[30] + layer * DM; const float* lb = a.in[31] + layer * DM;
    bf16_t* Xb = (bf16_t*)(a.ws + WS_XB);
    for (int m = gw; m < MT; m += NGW) {
        const f32x4* xv = (const f32x4*)(H32 + (size_t)m * DM) + lane;
        f32x4 v[8]; float s = 0.f;
#pragma unroll
        for (int j = 0; j < 8; ++j) { v[j] = xv[64 * j]; s += (v[j].x + v[j].y) + (v[j].z + v[j].w); }
        const float mean = wave_sum(s) * (1.f / DM); float s2 = 0.f;
#pragma unroll
        for (int j = 0; j < 8; ++j) { v[j] = v[j] - mean; s2 += (v[j].x * v[j].x + v[j].y * v[j].y) + (v[j].z * v[j].z + v[j].w * v[j].w); }
        const float rstd = 1.f / sqrtf(wave_sum(s2) * (1.f / DM) + 1e-5f);
        float* dst = (layer == 0) ? (float*)(a.ws + WS_X32) + (size_t)m * DM : (m < TP ? a.out + O_YP + (size_t)m * DM : a.out + O_YS + (size_t)(m - TP) * DM);
#pragma unroll
        for (int j = 0; j < 8; ++j) { const f32x4 gg = *((const f32x4*)lg + lane + 64 * j), bb = *((const f32x4*)lb + lane + 64 * j);
            const f32x4 y = v[j] * rstd * gg + bb; *((f32x4*)dst + lane + 64 * j) = y;
            if (layer == 0) { u32x2 w; w.x = pk2(y.x, y.y); w.y = pk2(y.z, y.w); *((u32x2*)(Xb + (size_t)m * DM) + lane + 64 * j) = w; } }
    }
}

constexpr int S5_BUS = 128;
constexpr int S5_SROW = 272;
constexpr int S5_UB = 32 * S5_BUS * 4 + 32 * S5_SROW;
constexpr int S5_WLDS = S5_UB + 1024;
template <bool SAMPLE>
__device__ __forceinline__ void s5_item(int layer, int item, int wlo, int lane) {
    CArgs& a = kargs(); LAS unsigned char* wl = lds_base() + wlo;
    const int g = SAMPLE ? item : (item & 63), b = SAMPLE ? 0 : (item >> 6);
    const float* lam_re = a.in[8] + layer * 4096 + g * 64; const float* lam_im = a.in[9] + layer * 4096 + g * 64;
    const float dt = expf(a.in[10][layer * 64 + g]);
    const float* b_re = a.in[11] + (size_t)(layer * 64 + g) * 1024; const float* b_im = a.in[12] + (size_t)(layer * 64 + g) * 1024;
    const float* c_re = a.in[13] + (size_t)(layer * 64 + g) * 1024; const float* c_im = a.in[14] + (size_t)(layer * 64 + g) * 1024;
    const f32x4 dch = *(const f32x4*)(a.in[15] + layer * 1024 + g * 16 + 4 * (lane >> 4));
    const bf16_t* P = (const bf16_t*)(a.ws + WS_P); bf16_t* Zb = (bf16_t*)(a.ws + WS_ZB);
    LAS float* BU = (LAS float*)wl; LAS unsigned char* Sb = wl + 32 * S5_BUS * 4; LAS unsigned char* Ub = wl + S5_UB;
    float ar, ai;
    { const float lr = lam_re[lane], li = lam_im[lane]; const float mag = expf(lr * dt); float sn, cs; sincosf(li * dt, &sn, &cs); ar = mag * cs; ai = mag * sn; }
    bf16x8 Bf[4];
    { const int h = lane >> 5;
#pragma unroll
      for (int q = 0; q < 2; ++q) { const int pp = q * 32 + (lane & 31);
        const float lr = lam_re[pp], li = lam_im[pp]; const float mag = expf(lr * dt); float sn, cs; sincosf(li * dt, &sn, &cs);
        const float abr = mag * cs, abi = mag * sn, den = lr * lr + li * li, nr = abr - 1.f, ni = abi;
        const float f_r = (nr * lr + ni * li) / den, f_i = (ni * lr - nr * li) / den;
        float br8[8], bi8[8], or8[8], oi8[8];
        *(f32x4*)&br8[0] = *(const f32x4*)(b_re + pp * 16 + 8 * h); *(f32x4*)&br8[4] = *(const f32x4*)(b_re + pp * 16 + 8 * h + 4);
        *(f32x4*)&bi8[0] = *(const f32x4*)(b_im + pp * 16 + 8 * h); *(f32x4*)&bi8[4] = *(const f32x4*)(b_im + pp * 16 + 8 * h + 4);
#pragma unroll
        for (int e = 0; e < 8; ++e) { or8[e] = f_r * br8[e] - f_i * bi8[e]; oi8[e] = f_r * bi8[e] + f_i * br8[e]; }
        Bf[q] = __builtin_bit_cast(bf16x8, pack8(or8)); Bf[2 + q] = __builtin_bit_cast(bf16x8, pack8(oi8)); } }
    bf16x8 Cf[4];
    { const int c = lane & 15;
#pragma unroll
      for (int ks = 0; ks < 4; ++ks) { const int p0 = 16 * ks + 4 * (lane >> 4);
        const f32x4 cr = *(const f32x4*)(c_re + c * 64 + p0), ci = *(const f32x4*)(c_im + c * 64 + p0);
        float o[8] = {cr[0], -ci[0], cr[1], -ci[1], cr[2], -ci[2], cr[3], -ci[3]};
        Cf[ks] = __builtin_bit_cast(bf16x8, pack8(o)); } }
    float sr = 0.f, si = 0.f;
    const int nsc = SAMPLE ? 16 : 64;
    const float* h_re = a.in[2] + (size_t)layer * 128 * 4096 + g * 64 + lane; const float* h_im = a.in[3] + (size_t)layer * 128 * 4096 + g * 64 + lane;
    float* o_re = a.out + O_SRS + (size_t)layer * 128 * 4096 + g * 64 + lane; float* o_im = a.out + O_SIS + (size_t)layer * 128 * 4096 + g * 64 + lane;
    const bf16_t* up = P + (size_t)((SAMPLE ? TP : b * 2048) + (lane & 31)) * NP + C_XA + g * 16 + 8 * (lane >> 5);
    bf16x8 Af = *(const bf16x8*)up;
    float hr[8], hi[8];
    if (SAMPLE) {
#pragma unroll
        for (int q = 0; q < 8; ++q) { hr[q] = h_re[(size_t)q * 4096]; hi[q] = h_im[(size_t)q * 4096]; } }
    for (int sc = 0; sc < nsc; ++sc) {
        const int row0 = SAMPLE ? TP + sc * 32 : b * 2048 + sc * 32;
        const bf16x8 Ac = Af;
        float hcr[8], hci[8];
        if (SAMPLE) {
#pragma unroll
            for (int q = 0; q < 8; ++q) { hcr[q] = hr[q]; hci[q] = hi[q]; } }
        if (sc + 1 < nsc) { Af = *(const bf16x8*)(up + (size_t)(sc + 1) * 32 * NP);
            if (SAMPLE) {
#pragma unroll
                for (int q = 0; q < 8; ++q) { hr[q] = h_re[(size_t)((sc + 1) * 8 + q) * 4096]; hi[q] = h_im[(size_t)((sc + 1) * 8 + q) * 4096]; } } }
        *(LAS bf16x8*)(Ub + (lane & 31) * 32 + 16 * (lane >> 5)) = Ac;
#pragma unroll
        for (int nb = 0; nb < 4; ++nb) {
            f32x16 acc;
#pragma unroll
            for (int r = 0; r < 16; ++r) acc[r] = 0.f;
            acc = __builtin_amdgcn_mfma_f32_32x32x16_bf16(Ac, Bf[nb], acc, 0, 0, 0);
#pragma unroll
            for (int r = 0; r < 16; ++r) { const int t = (r & 3) + 8 * (r >> 2) + 4 * (lane >> 5); BU[t * S5_BUS + 32 * nb + (lane & 31)] = acc[r]; }
        }
        LDS_WAIT();
#pragma unroll
        for (int t = 0; t < 32; ++t) {
            if (SAMPLE && (t & 3) == 0) { sr = hcr[t >> 2]; si = hci[t >> 2]; }
            const float bur = BU[t * S5_BUS + lane], bui = BU[t * S5_BUS + 64 + lane];
            const float nsr = ar * sr - ai * si + bur, nsi = ar * si + ai * sr + bui;
            sr = nsr; si = nsi;
            *(LAS unsigned*)(Sb + t * S5_SROW + 4 * lane) = pk2(sr, si);
            if (SAMPLE && (t & 3) == 3) { const int bi = sc * 8 + (t >> 2); o_re[(size_t)bi * 4096] = sr; o_im[(size_t)bi * 4096] = si; }
        }
        LDS_WAIT();
#pragma unroll
        for (int mb = 0; mb < 2; ++mb) {
            f32x4 y = (f32x4){0.f, 0.f, 0.f, 0.f};
#pragma unroll
            for (int ks = 0; ks < 4; ++ks) { const bf16x8 Sf = *(const LAS bf16x8*)(Sb + (16 * mb + (lane & 15)) * S5_SROW + 64 * ks + 16 * (lane >> 4));
                y = __builtin_amdgcn_mfma_f32_16x16x32_bf16(Cf[ks], Sf, y, 0, 0, 0); }
            const int tt = 16 * mb + (lane & 15);
            const u32x2 xw = *(const LAS u32x2*)(Ub + tt * 32 + 8 * (lane >> 4));
            u32x2 o; o.x = pk2(gelu_tanh(y[0] + dch[0] * bflo(xw.x)), gelu_tanh(y[1] + dch[1] * bfhi(xw.x)));
            o.y = pk2(gelu_tanh(y[2] + dch[2] * bflo(xw.y)), gelu_tanh(y[3] + dch[3] * bfhi(xw.y)));
            *(u32x2*)(Zb + (size_t)(row0 + tt) * 1024 + g * 16 + 4 * (lane >> 4)) = o;
        }
        LDS_WAIT();
    }
    if (!SAMPLE) { a.out[O_SRP + (size_t)((layer * 4 + b) * 64 + g) * 64 + lane] = sr; a.out[O_SIP + (size_t)((layer * 4 + b) * 64 + g) * 64 + lane] = si; }
}

constexpr int GM_TROW = 80;
__device__ __forceinline__ void gmlp_prompt_item(int layer, int item, const int tid) {
    CArgs& a = kargs(); LAS unsigned char* lds = lds_base();
    const int lane = tid & 63, w = __builtin_amdgcn_readfirstlane(tid >> 6);
    const bf16_t* P = (const bf16_t*)(a.ws + WS_P); bf16_t* YB = (bf16_t*)(a.ws + WS_YB);
    const float* lng = a.in[19] + layer * 1024; const float* lnb = a.in[20] + layer * 1024;
    const int r0 = item * 128, g = w;
    LAS f32x2* stats = (LAS f32x2*)lds;
    LAS unsigned char* vt = lds + 1024 + w * (16 * GM_TROW);
    __syncthreads();
    {
#pragma unroll 1
        for (int hb = 0; hb < 2; ++hb) {
        u32x4 raw[8][2];
#pragma unroll
        for (int i = 0; i < 8; ++i) { const bf16_t* rp = P + (size_t)(r0 + 16 * w + 8 * hb + i) * NP + C_VB + lane * 16; raw[i][0] = *(const u32x4*)rp; raw[i][1] = *(const u32x4*)(rp + 8); }
#pragma unroll
        for (int i = 0; i < 8; ++i) { float x[16]; { float t8[8]; unpack8(raw[i][0], t8);
#pragma unroll
                for (int e = 0; e < 8; ++e) x[e] = t8[e];
                unpack8(raw[i][1], t8);
#pragma unroll
                for (int e = 0; e < 8; ++e) x[8 + e] = t8[e]; }
            float s = 0.f;
#pragma unroll
            for (int e = 0; e < 16; ++e) s += x[e];
            const float mean = wave_sum(s) * (1.f / 1024.f); float s2 = 0.f;
#pragma unroll
            for (int e = 0; e < 16; ++e) { const float d = x[e] - mean; s2 += d * d; }
            const float rstd = 1.f / sqrtf(wave_sum(s2) * (1.f / 1024.f) + 1e-5f);
            if (lane == 0) stats[16 * w + 8 * hb + i] = (f32x2){mean, rstd}; }
        }
    }
    __syncthreads();
    bf16x8 Wf[20];
    { const float* Ws = a.in[21] + (size_t)(layer * 8 + g) * 128 * 128;
#pragma unroll
      for (int kb = 0; kb < 4; ++kb)
#pragma unroll
        for (int ib = 2 * kb; ib < 8; ++ib) { const int fi = (kb == 0 ? 0 : kb == 1 ? 8 : kb == 2 ? 14 : 18) + ib - 2 * kb;
            const int i = 16 * ib + (lane & 15), j0 = 32 * kb + 8 * (lane >> 4);
            const f32x4 w0 = *(const f32x4*)(Ws + i * 128 + j0), w1 = *(const f32x4*)(Ws + i * 128 + j0 + 4);
            float wv[8];
#pragma unroll
            for (int e = 0; e < 8; ++e) { const float x = e < 4 ? w0[e & 3] : w1[e & 3]; wv[e] = (j0 + e <= i) ? x : 0.f; }
            Wf[fi] = __builtin_bit_cast(bf16x8, pack8(wv));
            if ((fi & 3) == 3) __builtin_amdgcn_sched_barrier(0); } }
    const float* bsp = a.in[22] + (size_t)(layer * 8 + g) * 128;
#pragma unroll 1
    for (int rnd = 0; rnd < 8; ++rnd) {
        const int cbase = g * 128 + rnd * 16;
        f32x4 acc[8];
#pragma unroll
        for (int ib = 0; ib < 8; ++ib) acc[ib] = (f32x4){0.f, 0.f, 0.f, 0.f};
        const int cg = lane & 1, j = lane >> 1;
        u32x4 raw[4];
#pragma unroll
        for (int kb = 0; kb < 4; ++kb) raw[kb] = *(const u32x4*)(P + (size_t)(r0 + 32 * kb + j) * NP + C_VB + cbase + cg * 8);
        const f32x4 g0 = *(const f32x4*)(lng + cbase + cg * 8), g1 = *(const f32x4*)(lng + cbase + cg * 8 + 4);
        const f32x4 b0 = *(const f32x4*)(lnb + cbase + cg * 8), b1 = *(const f32x4*)(lnb + cbase + cg * 8 + 4);
#pragma unroll
        for (int kb = 0; kb < 4; ++kb) {
            { float x[8]; unpack8(raw[kb], x);
              const f32x2 st = stats[32 * kb + j];
#pragma unroll
              for (int e = 0; e < 8; ++e) { const float gg = e < 4 ? g0[e & 3] : g1[e & 3], bb = e < 4 ? b0[e & 3] : b1[e & 3];
                  const float v = (x[e] - st.x) * st.y * gg + bb;
                  *(LAS bf16_t*)(vt + (cg * 8 + e) * GM_TROW + 2 * j) = (bf16_t)f2bf(v); } }
            LDS_WAIT();
            const bf16x8 Af = *(const LAS bf16x8*)(vt + (lane & 15) * GM_TROW + 16 * (lane >> 4));
#pragma unroll
            for (int ib = 2 * kb; ib < 8; ++ib) { const int fi = (kb == 0 ? 0 : kb == 1 ? 8 : kb == 2 ? 14 : 18) + ib - 2 * kb;
                acc[ib] = __builtin_amdgcn_mfma_f32_16x16x32_bf16(Af, Wf[fi], acc[ib], 0, 0, 0); }
            LDS_WAIT();
        }
#pragma unroll
        for (int ib = 0; ib < 8; ++ib) { const int i = 16 * ib + (lane & 15); const float bs = bsp[i]; const size_t row = (size_t)(r0 + i);
            const int ch = cbase + 4 * (lane >> 4);
            const u32x2 uw = *(const u32x2*)(P + row * NP + C_UB + ch), gw = *(const u32x2*)(P + row * NP + C_GB + ch);
            const f32x4 s = acc[ib] + bs;
            u32x2 o; o.x = pk2(bflo(uw.x) * s[0] * silu(bflo(gw.x)), bfhi(uw.x) * s[1] * silu(bfhi(gw.x)));
            o.y = pk2(bflo(uw.y) * s[2] * silu(bflo(gw.y)), bfhi(uw.y) * s[3] * silu(bfhi(gw.y)));
            *(u32x2*)(YB + row * 1024 + ch) = o; }
    }
}
__device__ __forceinline__ void gmlp_sample_item(int layer, int b, int lane) {
    CArgs& a = kargs();
    const bf16_t* P = (const bf16_t*)(a.ws + WS_P); bf16_t* YB = (bf16_t*)(a.ws + WS_YB);
    const float* lng = a.in[19] + layer * 1024 + lane * 16; const float* lnb = a.in[20] + layer * 1024 + lane * 16;
    const int g = lane >> 3;
    const float* Ws = a.in[21] + (size_t)(layer * 8 + g) * 128 * 128; const float* bsp = a.in[22] + (size_t)(layer * 8 + g) * 128;
    float vn[4][16];
#pragma unroll
    for (int t = 0; t < 4; ++t) { const size_t row = (size_t)(TP + b * 4 + t); const bf16_t* rp = P + row * NP + C_VB + lane * 16;
        float x[16]; { float t8[8]; unpack8(*(const u32x4*)rp, t8);
#pragma unroll
            for (int e = 0; e < 8; ++e) x[e] = t8[e];
            unpack8(*(const u32x4*)(rp + 8), t8);
#pragma unroll
            for (int e = 0; e < 8; ++e) x[8 + e] = t8[e]; }
        float s = 0.f;
#pragma unroll
        for (int e = 0; e < 16; ++e) s += x[e];
        const float mean = wave_sum(s) * (1.f / 1024.f); float s2 = 0.f;
#pragma unroll
        for (int e = 0; e < 16; ++e) { const float d = x[e] - mean; s2 += d * d; }
        const float rstd = 1.f / sqrtf(wave_sum(s2) * (1.f / 1024.f) + 1e-5f);
        float* ov = a.out + O_GV + ((size_t)(layer * 128 + b) * 4 + t) * 1024 + lane * 16;
#pragma unroll
        for (int e = 0; e < 16; ++e) vn[t][e] = (x[e] - mean) * rstd * lng[e] + lnb[e];
#pragma unroll
        for (int e = 0; e < 16; e += 4) *(f32x4*)(ov + e) = (f32x4){vn[t][e], vn[t][e + 1], vn[t][e + 2], vn[t][e + 3]}; }
#pragma unroll
    for (int i = 0; i < 4; ++i) { const size_t row = (size_t)(TP + b * 4 + i);
        float s[16]; const float bs = bsp[i];
#pragma unroll
        for (int e = 0; e < 16; ++e) s[e] = bs;
#pragma unroll
        for (int j = 0; j < 4; ++j) if (j <= i) { const float wv = Ws[i * 128 + j];
#pragma unroll
            for (int e = 0; e < 16; ++e) s[e] += wv * vn[j][e]; }
        float ub[16], gb[16];
        { float t8[8]; unpack8(*(const u32x4*)(P + row * NP + C_UB + lane * 16), t8);
#pragma unroll
          for (int e = 0; e < 8; ++e) ub[e] = t8[e];
          unpack8(*(const u32x4*)(P + row * NP + C_UB + lane * 16 + 8), t8);
#pragma unroll
          for (int e = 0; e < 8; ++e) ub[8 + e] = t8[e];
          unpack8(*(const u32x4*)(P + row * NP + C_GB + lane * 16), t8);
#pragma unroll
          for (int e = 0; e < 8; ++e) gb[e] = t8[e];
          unpack8(*(const u32x4*)(P + row * NP + C_GB + lane * 16 + 8), t8);
#pragma unroll
          for (int e = 0; e < 8; ++e) gb[8 + e] = t8[e]; }
        float o0[8], o1[8];
#pragma unroll
        for (int e = 0; e < 8; ++e) { o0[e] = ub[e] * s[e] * silu(gb[e]); o1[e] = ub[8 + e] * s[8 + e] * silu(gb[8 + e]); }
        *(u32x4*)(YB + row * 1024 + lane * 16) = pack8(o0); *(u32x4*)(YB + row * 1024 + lane * 16 + 8) = pack8(o1); }
}

template <bool SAMPLE>
__device__ __forceinline__ void gdn_item_v1(int layer, int item, const int tid) {
    CArgs& a = kargs(); LAS unsigned char* lds = lds_base();
    const int lane = tid & 63, w = tid >> 6;
    const int b = item >> 3, h = item & 7;
    const int T = SAMPLE ? 4 : 2048, rbase = SAMPLE ? TP + b * 4 : b * 2048, NB = SAMPLE ? 128 : 4;
    const bf16_t* P = (const bf16_t*)(a.ws + WS_P); const float* AB = (const float*)(a.ws + WS_AB); bf16_t* YC = (bf16_t*)(a.ws + WS_YC);
    const float* convw = a.in[24] + (size_t)layer * 4 * 3072;
    const float* sconv = a.in[5] + (size_t)(layer * 128 + b) * 3 * 3072;
    LAS float* qs = (LAS float*)lds; LAS float* ks = qs + 64 * 128; LAS float* vs = ks + 64 * 128;
    LAS float* red = vs + 64 * 128; LAS float* red2 = red + 512; LAS float* av = red2 + 512; LAS float* bv = av + 64;
    const int dv = (w & 1) * 64 + lane, sl = w >> 1, dk0 = sl * 32;
    float S[32];
    if (SAMPLE) { const float* s0 = a.in[4] + ((size_t)((layer * 128 + b) * 8 + h) * 128 + dk0) * 128 + dv;
#pragma unroll
        for (int i = 0; i < 32; ++i) S[i] = s0[(size_t)i * 128]; }
    else {
#pragma unroll
        for (int i = 0; i < 32; ++i) S[i] = 0.f; }
    const float Aexp = expf(a.in[25][layer * 8 + h]), dtb = a.in[26][layer * 8 + h];
    for (int c0 = 0; c0 < T; c0 += 64) {
        const int n = (T - c0) < 64 ? (T - c0) : 64;
        __syncthreads();
        for (int idx = tid; idx < n * 384; idx += 512) {
            const int t = idx / 384, ch = idx - t * 384, sec = ch >> 7, cc = ch & 127, col = sec * 1024 + h * 128 + cc, tg = c0 + t;
            float accv = 0.f;
#pragma unroll
            for (int j = 0; j < 4; ++j) { const int tt = tg - 3 + j; float x;
                if (tt >= 0) x = bf2f(P[(size_t)(rbase + tt) * NP + C_QKV + col]);
                else x = SAMPLE ? sconv[(3 + tt) * 3072 + col] : 0.f;
                accv += convw[j * 3072 + col] * x; }
            const float y = silu(accv);
            LAS float* dst = sec == 0 ? qs : (sec == 1 ? ks : vs); dst[t * 128 + cc] = y;
        }
        if (tid < n) { const size_t row = (size_t)(rbase + c0 + tid); const float ac = AB[row * 16 + h], bc = AB[row * 16 + 8 + h];
            const float gg = -Aexp * softplus(ac + dtb); av[tid] = expf(gg); bv[tid] = sigm(bc); }
        __syncthreads();
        for (int t = w; t < n; t += 8) {
            { const float q0 = qs[t * 128 + lane], q1 = qs[t * 128 + 64 + lane]; const float ss = wave_sum(q0 * q0 + q1 * q1);
              const float r = (1.f / sqrtf(ss + 1e-6f)) * 0.08838834764831845f; qs[t * 128 + lane] = q0 * r; qs[t * 128 + 64 + lane] = q1 * r; }
            { const float k0 = ks[t * 128 + lane], k1 = ks[t * 128 + 64 + lane]; const float ss = wave_sum(k0 * k0 + k1 * k1);
              const float r = 1.f / sqrtf(ss + 1e-6f); ks[t * 128 + lane] = k0 * r; ks[t * 128 + 64 + lane] = k1 * r; }
        }
        __syncthreads();
        for (int t = 0; t < n; ++t) {
            const float at = av[t], bt = bv[t];
            float p = 0.f;
#pragma unroll
            for (int i = 0; i < 32; i += 4) { const f32x4 kk = *(const LAS f32x4*)(ks + t * 128 + dk0 + i);
                p += kk[0] * S[i] + kk[1] * S[i + 1] + kk[2] * S[i + 2] + kk[3] * S[i + 3]; }
            red[sl * 128 + dv] = p;
            __syncthreads();
            const float kS = (red[dv] + red[128 + dv]) + (red[256 + dv] + red[384 + dv]);
            const float vnew = bt * (vs[t * 128 + dv] - at * kS);
            float po = 0.f;
#pragma unroll
            for (int i = 0; i < 32; i += 4) { const f32x4 kk = *(const LAS f32x4*)(ks + t * 128 + dk0 + i), qq = *(const LAS f32x4*)(qs + t * 128 + dk0 + i);
#pragma unroll
                for (int e = 0; e < 4; ++e) { S[i + e] = at * S[i + e] + kk[e] * vnew; po += qq[e] * S[i + e]; } }
            red2[sl * 128 + dv] = po;
            __syncthreads();
            if (sl == 0) vs[t * 128 + dv] = (red2[dv] + red2[128 + dv]) + (red2[256 + dv] + red2[384 + dv]);
        }
        __syncthreads();
        const float* ng = a.in[27] + layer * 128;
        for (int t = w; t < n; t += 8) {
            const float o0 = vs[t * 128 + lane], o1 = vs[t * 128 + 64 + lane]; const float ss = wave_sum(o0 * o0 + o1 * o1);
            const float r = 1.f / sqrtf(ss * (1.f / 128.f) + 1e-6f); const size_t row = (size_t)(rbase + c0 + t);
            const float g0 = bf2f(P[row * NP + C_GATEC + h * 128 + lane]), g1 = bf2f(P[row * NP + C_GATEC + h * 128 + 64 + lane]);
            YC[row * 1024 + h * 128 + lane] = (bf16_t)f2bf(o0 * r * ng[lane] * silu(g0));
            YC[row * 1024 + h * 128 + 64 + lane] = (bf16_t)f2bf(o1 * r * ng[64 + lane] * silu(g1));
        }
    }
    { float* so = a.out + (SAMPLE ? O_DS : O_DP) + ((size_t)((layer * NB + b) * 8 + h) * 128 + dk0) * 128 + dv;
#pragma unroll
      for (int i = 0; i < 32; ++i) so[(size_t)i * 128] = S[i]; }
    { float* co = a.out + (SAMPLE ? O_CS : O_CP) + (size_t)(layer * NB + b) * 3 * 3072;
      for (int idx = tid; idx < 3 * 384; idx += 512) { const int r = idx / 384, ch = idx - r * 384, col = (ch >> 7) * 1024 + h * 128 + (ch & 127);
          co[r * 3072 + col] = bf2f(P[(size_t)(rbase + T - 3 + r) * NP + C_QKV + col]); } }
}


constexpr size_t WS_GC = WS_M32;
constexpr int GC_STRIDE = 98304, GC_WN = 0, GC_QG = 16384, GC_KG = 32768, GC_AT = 49152, GC_U = 57344, GC_GAMMA = 90112, GC_OPS = 57344;
static_assert(WS_GC + (size_t)1024 * GC_STRIDE <= WS_H32, "chunk buffers fit in the M32|MB overlay");
constexpr int GP_QR = 0, GP_KR = 17408, GP_KBR = 34816, GP_VT = 52224, GP_KGT = 70656, GP_KT2 = 89088, GP_LM = 107520, GP_TM = 124928, GP_AS = 134144,
              GP_GC = 143360, GP_BETA = 143616, GP_GRAW = 143872, GP_WST = 0;
#define MFMA32(a, b, c) __builtin_amdgcn_mfma_f32_32x32x16_bf16((a), (b), (c), 0, 0, 0)

__device__ __forceinline__ void gdn_prep_item(int layer, int item, const int tid) {
    CArgs& a = kargs(); LAS unsigned char* lds = lds_base();
    const int lane = tid & 63, w = __builtin_amdgcn_readfirstlane(tid >> 6), hh = lane >> 5, l31 = lane & 31;
    const int b = item >> 8, h = (item >> 5) & 7, n = item & 31;
    const bf16_t* P = (const bf16_t*)(a.ws + WS_P); const float* AB = (const float*)(a.ws + WS_AB);
    unsigned char* gc = a.ws + WS_GC + (size_t)item * GC_STRIDE;
    const int t = tid >> 3, cg = tid & 7;
    const int r0 = b * 2048 + n * 64;
    __syncthreads();
    float qv[16], kv[16], vv[16];
    {
        const float* convw = a.in[24] + (size_t)layer * 4 * 3072;
#pragma unroll
        for (int sec = 0; sec < 3; ++sec) {
            const int ch = sec * 1024 + h * 128 + 16 * cg;
            float acc[16];
#pragma unroll
            for (int e = 0; e < 16; ++e) acc[e] = 0.f;
#pragma unroll
            for (int j = 0; j < 4; ++j) {
                const int tt = n * 64 + t - 3 + j; const float msk = tt < 0 ? 0.f : 1.f;
                float x[16];
                { const bf16_t* rp = P + (size_t)(b * 2048 + (tt < 0 ? 0 : tt)) * NP + C_QKV + ch; float t8[8];
                    unpack8(*(const u32x4*)rp, t8);
#pragma unroll
                    for (int e = 0; e < 8; ++e) x[e] = t8[e];
                    unpack8(*(const u32x4*)(rp + 8), t8);
#pragma unroll
                    for (int e = 0; e < 8; ++e) x[8 + e] = t8[e]; }
                const float* wp = convw + j * 3072 + ch;
#pragma unroll
                for (int e = 0; e < 16; e += 4) { const f32x4 wv = *(const f32x4*)(wp + e) * msk;
                    acc[e] += wv[0] * x[e]; acc[e + 1] += wv[1] * x[e + 1]; acc[e + 2] += wv[2] * x[e + 2]; acc[e + 3] += wv[3] * x[e + 3]; }
                if (j == 3 && n == 31 && t >= 61) { float* co = a.out + O_CP + ((size_t)(layer * 4 + b) * 3 + (t - 61)) * 3072 + ch;
#pragma unroll
                    for (int e = 0; e < 16; e += 4) *(f32x4*)(co + e) = (f32x4){x[e], x[e + 1], x[e + 2], x[e + 3]}; }
            }
            float ss = 0.f;
#pragma unroll
            for (int e = 0; e < 16; ++e) { acc[e] = silu(acc[e]); ss += acc[e] * acc[e]; }
            if (sec < 2) { ss += __shfl_xor(ss, 1); ss += __shfl_xor(ss, 2); ss += __shfl_xor(ss, 4);
                const float r = (1.f / sqrtf(ss + 1e-6f)) * (sec == 0 ? 0.08838834764831845f : 1.f);
#pragma unroll
                for (int e = 0; e < 16; ++e) { if (sec == 0) qv[e] = acc[e] * r; else kv[e] = acc[e] * r; } }
            else {
#pragma unroll
                for (int e = 0; e < 16; ++e) vv[e] = acc[e]; }
        }
        if (cg == 0) { const size_t row = (size_t)(r0 + t); const float ac = AB[row * 16 + h], bc = AB[row * 16 + 8 + h];
            const float Aexp = expf(a.in[25][layer * 8 + h]), dtb = a.in[26][layer * 8 + h];
            *(LAS float*)(lds + GP_GRAW + 4 * t) = -Aexp * softplus(ac + dtb); *(LAS float*)(lds + GP_BETA + 4 * t) = sigm(bc); }
    }
    __syncthreads();
    if (w == 0) { float g = *(LAS float*)(lds + GP_GRAW + 4 * lane);
#pragma unroll
        for (int o = 1; o < 64; o <<= 1) { const float y = __shfl_up(g, o); if (lane >= o) g += y; }
        *(LAS float*)(lds + GP_GC + 4 * lane) = g; }
    __syncthreads();
    {
        const float gct = *(LAS float*)(lds + GP_GC + 4 * t), bt = *(LAS float*)(lds + GP_BETA + 4 * t), gl = *(LAS float*)(lds + GP_GC + 4 * 63);
        const float eg = expf(gct), egl = expf(gl - gct);
        float tq[8], tk[8], tb[8];
#pragma unroll
        for (int half = 0; half < 2; ++half) {
#pragma unroll
            for (int e = 0; e < 8; ++e) { tq[e] = qv[8 * half + e]; tk[e] = kv[8 * half + e]; tb[e] = kv[8 * half + e] * bt; }
            *(LAS u32x4*)(lds + GP_QR + t * 272 + (16 * cg + 8 * half) * 2) = pack8(tq);
            *(LAS u32x4*)(lds + GP_KR + t * 272 + (16 * cg + 8 * half) * 2) = pack8(tk);
            *(LAS u32x4*)(lds + GP_KBR + t * 272 + (16 * cg + 8 * half) * 2) = pack8(tb);
        }
#pragma unroll
        for (int d = 0; d < 16; ++d) { const int rowd = 16 * cg + d;
            *(LAS bf16_t*)(lds + GP_VT + rowd * 144 + 2 * t) = (bf16_t)f2bf(vv[d] * bt);
            *(LAS bf16_t*)(lds + GP_KGT + rowd * 144 + 2 * t) = (bf16_t)f2bf(kv[d] * bt * eg);
            *(LAS bf16_t*)(lds + GP_KT2 + rowd * 144 + 2 * t) = (bf16_t)f2bf(kv[d] * egl); }
#pragma unroll
        for (int hq = 0; hq < 2; ++hq) { float o8[8];
#pragma unroll
            for (int j = 0; j < 8; ++j) o8[j] = qv[8 * (j >> 2) + 4 * hq + (j & 3)] * eg;
            *(u32x4*)(gc + GC_QG + ((((t >> 5) * 4 + (cg >> 1)) * 2 + (cg & 1)) * 64 + (t & 31) + 32 * hq) * 16) = pack8(o8); }
        if (tid == 0) *(float*)(gc + GC_GAMMA) = expf(gl);
    }
    __syncthreads();
    {
        const int typ = w >> 2, mi = (w >> 1) & 1, nj = w & 1;
        f32x16 acc;
#pragma unroll
        for (int r = 0; r < 16; ++r) acc[r] = 0.f;
        if (!(mi == 0 && nj == 1)) {
            const LAS unsigned char* Ab = lds + (typ ? GP_QR : GP_KBR) + (32 * mi + l31) * 272 + 16 * hh;
            const LAS unsigned char* Bb = lds + GP_KR + (32 * nj + l31) * 272 + 16 * hh;
#pragma unroll
            for (int ks = 0; ks < 8; ++ks) acc = MFMA32(*(const LAS bf16x8*)(Ab + 32 * ks), *(const LAS bf16x8*)(Bb + 32 * ks), acc);
        }
        const int j = 32 * nj + l31; const float gcj = *(LAS float*)(lds + GP_GC + 4 * j);
#pragma unroll
        for (int r = 0; r < 16; ++r) { const int i = 32 * mi + (r & 3) + 8 * (r >> 2) + 4 * hh;
            const float gci = *(LAS float*)(lds + GP_GC + 4 * i);
            const float d = (i >= j) ? expf(gci - gcj) : 0.f;
            if (typ == 0) *(LAS float*)(lds + GP_LM + i * 272 + 4 * j) = (i > j) ? acc[r] * d : 0.f;
            else *(LAS bf16_t*)(lds + GP_AS + i * 144 + 2 * j) = (bf16_t)f2bf((i >= j) ? acc[r] * d : 0.f); }
    }
    __syncthreads();
    if (w == 0) {
        float x[64];
#pragma unroll
        for (int i = 0; i < 64; ++i) {
            float s0 = (i == lane) ? 1.f : 0.f, s1 = 0.f;
#pragma unroll
            for (int j4 = 0; j4 < (i + 3) / 4; ++j4) { const f32x4 l4 = *(const LAS f32x4*)(lds + GP_LM + i * 272 + 16 * j4);
#pragma unroll
                for (int e = 0; e < 4; ++e) { const int j = 4 * j4 + e; if (j < i) { if (e & 1) s1 -= l4[e] * x[j]; else s0 -= l4[e] * x[j]; } } }
            x[i] = s0 + s1;
        }
#pragma unroll
        for (int i = 0; i < 64; ++i) *(LAS bf16_t*)(lds + GP_TM + i * 144 + 2 * lane) = (bf16_t)f2bf(x[i]);
    } else {
        for (int task = tid - 64; task < 1536; task += 448) {
            const int ll = task & 63, hq = ll >> 5;
            if (task < 1024) { const int f = task >> 6, db = f >> 2, tb = (f >> 1) & 1, s = f & 1, dk = 32 * db + (ll & 31), t0 = 32 * tb + 16 * s + 4 * hq;
                const u32x2 lo = *(const LAS u32x2*)(lds + GP_KT2 + dk * 144 + 2 * t0), hi = *(const LAS u32x2*)(lds + GP_KT2 + dk * 144 + 2 * (t0 + 8));
                *(u32x4*)(gc + GC_KG + (f * 64 + ll) * 16) = (u32x4){lo.x, lo.y, hi.x, hi.y}; }
            else { const int f = (task - 1024) >> 6, mb = f >> 2, tb = (f >> 1) & 1, s = f & 1, i = 32 * mb + (ll & 31), j0 = 32 * tb + 16 * s + 4 * hq;
                const u32x2 lo = *(const LAS u32x2*)(lds + GP_AS + i * 144 + 2 * j0), hi = *(const LAS u32x2*)(lds + GP_AS + i * 144 + 2 * (j0 + 8));
                *(u32x4*)(gc + GC_AT + (f * 64 + ll) * 16) = (u32x4){lo.x, lo.y, hi.x, hi.y}; }
        }
    }
    __syncthreads();
    {
        const LAS unsigned char* Bb = lds + (w < 4 ? GP_VT : GP_KGT) + (32 * (w & 3) + l31) * 144 + 16 * hh;
#pragma unroll
        for (int mb = 0; mb < 2; ++mb) {
            f32x16 acc;
#pragma unroll
            for (int r = 0; r < 16; ++r) acc[r] = 0.f;
            const LAS unsigned char* Ab = lds + GP_TM + (32 * mb + l31) * 144 + 16 * hh;
#pragma unroll
            for (int ks = 0; ks < 4; ++ks) acc = MFMA32(*(const LAS bf16x8*)(Ab + 32 * ks), *(const LAS bf16x8*)(Bb + 32 * ks), acc);
            if (w < 4) { unsigned* up = (unsigned*)(gc + GC_U) + ((w * 2 + mb) * 8) * 64 + lane;
#pragma unroll
                for (int q = 0; q < 8; ++q) up[q * 64] = pk2(acc[2 * q], acc[2 * q + 1]); }
            else {
#pragma unroll
                for (int r = 0; r < 16; ++r) { const int tt = 32 * mb + (r & 3) + 8 * (r >> 2) + 4 * hh;
                    *(LAS bf16_t*)(lds + GP_WST + tt * 272 + 2 * (32 * (w - 4) + l31)) = (bf16_t)f2bf(-acc[r]); } }
        }
    }
    __syncthreads();
#pragma unroll
    for (int q = 0; q < 2; ++q) { const int task = tid + 512 * q, f = task >> 6, ll = task & 63, hq = ll >> 5, mb = f >> 3, kb = (f >> 1) & 3, s = f & 1;
        const int tt = 32 * mb + (ll & 31), d0 = 32 * kb + 16 * s + 4 * hq;
        const u32x2 lo = *(const LAS u32x2*)(lds + GP_WST + tt * 272 + 2 * d0), hi = *(const LAS u32x2*)(lds + GP_WST + tt * 272 + 2 * (d0 + 8));
        *(u32x4*)(gc + GC_WN + (f * 64 + ll) * 16) = (u32x4){lo.x, lo.y, hi.x, hi.y}; }
}

__device__ __forceinline__ bf16x8 cvt_frag(const f32x16& v, int s) {
    u32x4 w; w.x = pk2(v[8 * s], v[8 * s + 1]); w.y = pk2(v[8 * s + 2], v[8 * s + 3]); w.z = pk2(v[8 * s + 4], v[8 * s + 5]); w.w = pk2(v[8 * s + 6], v[8 * s + 7]);
    return __builtin_bit_cast(bf16x8, w);
}
constexpr int CH_OB = 2 * GC_OPS;
#define CH_LOAD(dst, cidx) do { const unsigned char* _s = gcb + (size_t)(cidx) * GC_STRIDE + lt * 16; _Pragma("unroll") for (int _i = 0; _i < 14; ++_i) dst[_i] = *(const u32x4*)(_s + _i * 4096); } while (0)
#define CH_WRITE(src, bufi) do { LAS unsigned char* _d = lds + (bufi) * GC_OPS + lt * 16; _Pragma("unroll") for (int _i = 0; _i < 14; ++_i) *(LAS u32x4*)(_d + _i * 4096) = src[_i]; } while (0)
#define CH_GATE(dst, cidx) do { const bf16_t* _g = P + (size_t)(b * 2048 + (cidx) * 64 + (lt >> 4) * 4) * NP + C_GATEC + h * 128 + (lt & 15) * 8; _Pragma("unroll") for (int _q = 0; _q < 4; ++_q) dst[_q] = *(const u32x4*)(_g + (size_t)_q * NP); } while (0)
#define CH_ULOAD(dst, cidx) do { const unsigned* _u = (const unsigned*)(gcb + (size_t)(cidx) * GC_STRIDE + GC_U) + (w * 2 * 8) * 64 + lane; \
    _Pragma("unroll") for (int _m = 0; _m < 2; ++_m) _Pragma("unroll") for (int _q = 0; _q < 8; ++_q) dst[_m][_q] = _u[(_m * 8 + _q) * 64]; } while (0)
__device__ __forceinline__ void gdn_chain(int layer, int bh, const int tid) {
    CArgs& a = kargs(); LAS unsigned char* lds = lds_base();
    const int lane = tid & 63, w = __builtin_amdgcn_readfirstlane(tid >> 6), hh = lane >> 5, l31 = lane & 31;
    const int b = bh >> 3, h = bh & 7;
    const unsigned char* gcb = a.ws + WS_GC + (size_t)bh * 32 * GC_STRIDE;
    __syncthreads();
    if (w >= 4) {
        const int lt = tid - 256;
        const bf16_t* P = (const bf16_t*)(a.ws + WS_P); bf16_t* YC = (bf16_t*)(a.ws + WS_YC);
        float ngv[8]; { const float* ng = a.in[27] + layer * 128 + (lt & 15) * 8; const f32x4 n0 = *(const f32x4*)ng, n1 = *(const f32x4*)(ng + 4);
#pragma unroll
            for (int e = 0; e < 4; ++e) { ngv[e] = n0[e]; ngv[4 + e] = n1[e]; } }
        u32x4 ra[14], rb[14], gt[4];
        CH_LOAD(ra, 0); CH_LOAD(rb, 1);
        CH_WRITE(ra, 0);
        CH_LOAD(ra, 2);
        CH_GATE(gt, 0);
        __syncthreads();
#define CH_FINISH(cc) do { const int t0 = (lt >> 4) * 4, dg = lt & 15; \
            _Pragma("unroll") for (int q = 0; q < 4; ++q) { float t8[8], g8[8], o8[8]; \
                unpack8(*(const LAS u32x4*)(lds + CH_OB + ((cc) & 1) * 16384 + (t0 + q) * 256 + dg * 16), t8); unpack8(gt[q], g8); float ss = 0.f; \
                _Pragma("unroll") for (int e = 0; e < 8; ++e) ss += t8[e] * t8[e]; \
                ss += __shfl_xor(ss, 1); ss += __shfl_xor(ss, 2); ss += __shfl_xor(ss, 4); ss += __shfl_xor(ss, 8); \
                const float r = 1.f / sqrtf(ss * (1.f / 128.f) + 1e-6f); \
                _Pragma("unroll") for (int e = 0; e < 8; ++e) o8[e] = t8[e] * r * ngv[e] * silu(g8[e]); \
                *(u32x4*)(YC + (size_t)(b * 2048 + (cc) * 64 + t0 + q) * 1024 + h * 128 + dg * 8) = pack8(o8); } } while (0)
        for (int c = 0; c < 32; c += 2) {
            if (c >= 1) { CH_FINISH(c - 1); CH_GATE(gt, c); }
            CH_WRITE(rb, 1);
            if (c + 3 < 32) CH_LOAD(rb, c + 3);
            __syncthreads();
            CH_FINISH(c); CH_GATE(gt, c + 1);
            if (c + 2 < 32) { CH_WRITE(ra, 0); }
            if (c + 4 < 32) CH_LOAD(ra, c + 4);
            __syncthreads();
        }
        CH_FINISH(31);
    } else {
        f32x16 S[4];
#pragma unroll
        for (int kb = 0; kb < 4; ++kb)
#pragma unroll
            for (int r = 0; r < 16; ++r) S[kb][r] = 0.f;
        const float gam_all = (lane < 32) ? *(const float*)(gcb + (size_t)lane * GC_STRIDE + GC_GAMMA) : 0.f;
        unsigned ua[2][8], ub[2][8];
        CH_ULOAD(ua, 0); CH_ULOAD(ub, 1);
        __syncthreads();
#define CH_STEP(c, ucur) do { \
            const LAS unsigned char* ops = lds + ((c) & 1) * GC_OPS + lane * 16; \
            const float gamma = __shfl(gam_all, (c)); \
            f32x16 va[2], oa[2]; \
            _Pragma("unroll") for (int mb = 0; mb < 2; ++mb) _Pragma("unroll") for (int q = 0; q < 8; ++q) { va[mb][2 * q] = bflo(ucur[mb][q]); va[mb][2 * q + 1] = bfhi(ucur[mb][q]); } \
            _Pragma("unroll") for (int r = 0; r < 16; ++r) { oa[0][r] = 0.f; oa[1][r] = 0.f; } \
            if ((c) + 2 < 32) CH_ULOAD(ucur, (c) + 2); \
            _Pragma("unroll") for (int kb = 0; kb < 4; ++kb) _Pragma("unroll") for (int s = 0; s < 2; ++s) { const bf16x8 Bs = cvt_frag(S[kb], s); \
                _Pragma("unroll") for (int mb = 0; mb < 2; ++mb) { const int f = (mb * 4 + kb) * 2 + s; \
                    va[mb] = MFMA32(*(const LAS bf16x8*)(ops + GC_WN + f * 1024), Bs, va[mb]); \
                    oa[mb] = MFMA32(*(const LAS bf16x8*)(ops + GC_QG + f * 1024), Bs, oa[mb]); } } \
            _Pragma("unroll") for (int kb = 0; kb < 4; ++kb) _Pragma("unroll") for (int r = 0; r < 16; ++r) S[kb][r] *= gamma; \
            _Pragma("unroll") for (int tb = 0; tb < 2; ++tb) _Pragma("unroll") for (int s = 0; s < 2; ++s) { const bf16x8 Bv = cvt_frag(va[tb], s); \
                _Pragma("unroll") for (int kb = 0; kb < 4; ++kb) S[kb] = MFMA32(*(const LAS bf16x8*)(ops + GC_KG + ((kb * 2 + tb) * 2 + s) * 1024), Bv, S[kb]); \
                _Pragma("unroll") for (int mb = 0; mb < 2; ++mb) if (mb >= tb) oa[mb] = MFMA32(*(const LAS bf16x8*)(ops + GC_AT + ((mb * 2 + tb) * 2 + s) * 1024), Bv, oa[mb]); } \
            LAS unsigned char* ob = lds + CH_OB + ((c) & 1) * 16384; \
            _Pragma("unroll") for (int mb = 0; mb < 2; ++mb) _Pragma("unroll") for (int r = 0; r < 16; ++r) { const int tt = 32 * mb + (r & 3) + 8 * (r >> 2) + 4 * hh; \
                *(LAS bf16_t*)(ob + tt * 256 + 2 * (32 * w + l31)) = (bf16_t)f2bf(oa[mb][r]); } \
            __syncthreads(); } while (0)
        for (int c = 0; c < 32; c += 2) { CH_STEP(c, ua); CH_STEP(c + 1, ub); }
        float* so = a.out + O_DP + (size_t)((layer * 4 + b) * 8 + h) * 128 * 128 + 32 * w + l31;
#pragma unroll
        for (int kb = 0; kb < 4; ++kb)
#pragma unroll
            for (int r = 0; r < 16; ++r) so[(size_t)(32 * kb + (r & 3) + 8 * (r >> 2) + 4 * hh) * 128] = S[kb][r];
    }
}

__device__ __forceinline__ void gdn_sample_item(int layer, int item, const int tid) {
    CArgs& a = kargs(); LAS unsigned char* lds = lds_base();
    const int lane = tid & 63, w = __builtin_amdgcn_readfirstlane(tid >> 6);
    const int b = item >> 3, h = item & 7, rbase = TP + b * 4;
    const bf16_t* P = (const bf16_t*)(a.ws + WS_P); const float* AB = (const float*)(a.ws + WS_AB); bf16_t* YC = (bf16_t*)(a.ws + WS_YC);
    LAS float* qs = (LAS float*)lds; LAS float* ks = qs + 512; LAS float* vs = ks + 512;
    LAS float* red = vs + 512;
    LAS float* dots = red + 4096; LAS float* gcv = dots + 32; LAS float* btv = gcv + 4; LAS float* ob = btv + 4;
    const int dv = (w & 1) * 64 + lane, sl = w >> 1, dk0 = sl * 32;
    float S[32];
    { const float* s0 = a.in[4] + ((size_t)((layer * 128 + b) * 8 + h) * 128 + dk0) * 128 + dv;
#pragma unroll
      for (int i = 0; i < 32; ++i) S[i] = s0[(size_t)i * 128]; }
    __syncthreads();
    {
        const float* convw = a.in[24] + (size_t)layer * 4 * 3072; const float* sconv = a.in[5] + (size_t)(layer * 128 + b) * 3 * 3072;
        float* co = a.out + O_CS + (size_t)(layer * 128 + b) * 3 * 3072;
#pragma unroll
        for (int it3 = 0; it3 < 3; ++it3) { const int idx = tid + 512 * it3;
            const int t = idx / 384, ch = idx - t * 384, sec = ch >> 7, cc = ch & 127, col = sec * 1024 + h * 128 + cc;
            float accv = 0.f;
#pragma unroll
            for (int j = 0; j < 4; ++j) { const int tt = t - 3 + j;
                const float xp = bf2f(P[(size_t)(rbase + (tt < 0 ? 0 : tt)) * NP + C_QKV + col]), xs = sconv[(tt < 0 ? 3 + tt : 2) * 3072 + col];
                const float x = (tt >= 0) ? xp : xs;
                if (j == 3 && t >= 1) co[(t - 1) * 3072 + col] = x;
                accv += convw[j * 3072 + col] * x; }
            LAS float* dst = sec == 0 ? qs : (sec == 1 ? ks : vs); dst[t * 128 + cc] = silu(accv);
        }
        if (tid < 4) { const size_t row = (size_t)(rbase + tid); const float ac = AB[row * 16 + h], bc = AB[row * 16 + 8 + h];
            gcv[tid] = -expf(a.in[25][layer * 8 + h]) * softplus(ac + a.in[26][layer * 8 + h]); btv[tid] = sigm(bc); }
    }
    __syncthreads();
    if (w < 4) { const int t = w;
        { const float q0 = qs[t * 128 + lane], q1 = qs[t * 128 + 64 + lane]; const float ss = wave_sum(q0 * q0 + q1 * q1);
          const float r = (1.f / sqrtf(ss + 1e-6f)) * 0.08838834764831845f; qs[t * 128 + lane] = q0 * r; qs[t * 128 + 64 + lane] = q1 * r; }
        { const float k0 = ks[t * 128 + lane], k1 = ks[t * 128 + 64 + lane]; const float ss = wave_sum(k0 * k0 + k1 * k1);
          const float r = 1.f / sqrtf(ss + 1e-6f); ks[t * 128 + lane] = k0 * r; ks[t * 128 + 64 + lane] = k1 * r; } }
    __syncthreads();
    {
#pragma unroll
        for (int q = 0; q < 4; ++q) { const int id = w * 4 + q, typ = id >> 4, i = (id >> 2) & 3, j = id & 3;
            const LAS float* xa = (typ ? qs : ks) + i * 128; const LAS float* xb = ks + j * 128;
            const float d = wave_sum(xa[lane] * xb[lane] + xa[64 + lane] * xb[64 + lane]);
            if (lane == 0) dots[id] = d; }
        float pk[4], pq[4];
#pragma unroll
        for (int j = 0; j < 4; ++j) { pk[j] = 0.f; pq[j] = 0.f; }
#pragma unroll
        for (int i = 0; i < 32; i += 4)
#pragma unroll
            for (int j = 0; j < 4; ++j) { const f32x4 kk = *(const LAS f32x4*)(ks + j * 128 + dk0 + i), qq = *(const LAS f32x4*)(qs + j * 128 + dk0 + i);
                pk[j] += kk[0] * S[i] + kk[1] * S[i + 1] + kk[2] * S[i + 2] + kk[3] * S[i + 3];
                pq[j] += qq[0] * S[i] + qq[1] * S[i + 1] + qq[2] * S[i + 2] + qq[3] * S[i + 3]; }
#pragma unroll
        for (int j = 0; j < 4; ++j) { red[(j * 4 + sl) * 128 + dv] = pk[j]; red[((4 + j) * 4 + sl) * 128 + dv] = pq[j]; }
    }
    __syncthreads();
    {
        float gc[4], bt[4];
        gc[0] = gcv[0]; gc[1] = gc[0] + gcv[1]; gc[2] = gc[1] + gcv[2]; gc[3] = gc[2] + gcv[3];
#pragma unroll
        for (int j = 0; j < 4; ++j) bt[j] = btv[j];
        float L[4][4], Tm[4][4];
#pragma unroll
        for (int i = 0; i < 4; ++i)
#pragma unroll
            for (int j = 0; j < 4; ++j) L[i][j] = (i > j) ? bt[i] * dots[i * 4 + j] * expf(gc[i] - gc[j]) : 0.f;
#pragma unroll
        for (int i = 0; i < 4; ++i)
#pragma unroll
            for (int c = 0; c < 4; ++c) { float s = (i == c) ? 1.f : 0.f;
#pragma unroll
                for (int j = 0; j < 4; ++j) if (j < i) s -= L[i][j] * Tm[j][c];
                Tm[i][c] = s; }
        float kS[4], qS[4], rhs[4], vn[4];
#pragma unroll
        for (int j = 0; j < 4; ++j) { kS[j] = (red[(j * 4 + 0) * 128 + dv] + red[(j * 4 + 1) * 128 + dv]) + (red[(j * 4 + 2) * 128 + dv] + red[(j * 4 + 3) * 128 + dv]);
            qS[j] = (red[((4 + j) * 4 + 0) * 128 + dv] + red[((4 + j) * 4 + 1) * 128 + dv]) + (red[((4 + j) * 4 + 2) * 128 + dv] + red[((4 + j) * 4 + 3) * 128 + dv]);
            rhs[j] = bt[j] * (vs[j * 128 + dv] - expf(gc[j]) * kS[j]); }
#pragma unroll
        for (int i = 0; i < 4; ++i) { float s = 0.f;
#pragma unroll
            for (int j = 0; j < 4; ++j) if (j <= i) s += Tm[i][j] * rhs[j];
            vn[i] = s; }
        if (sl == 0) {
#pragma unroll
            for (int i = 0; i < 4; ++i) { float o = expf(gc[i]) * qS[i];
#pragma unroll
                for (int j = 0; j < 4; ++j) if (j <= i) o += dots[16 + i * 4 + j] * expf(gc[i] - gc[j]) * vn[j];
                ob[i * 128 + dv] = o; } }
        const float gl = gc[3], egl = expf(gl);
        float cf[4];
#pragma unroll
        for (int j = 0; j < 4; ++j) cf[j] = expf(gl - gc[j]) * vn[j];
        float* so = a.out + O_DS + ((size_t)((layer * 128 + b) * 8 + h) * 128 + dk0) * 128 + dv;
#pragma unroll
        for (int i = 0; i < 32; ++i) { float s = egl * S[i];
#pragma unroll
            for (int j = 0; j < 4; ++j) s += ks[j * 128 + dk0 + i] * cf[j];
            so[(size_t)i * 128] = s; }
    }
    __syncthreads();
    if (w < 4) { const int t = w; const float* ng = a.in[27] + layer * 128;
        const float o0 = ob[t * 128 + lane], o1 = ob[t * 128 + 64 + lane]; const float ss = wave_sum(o0 * o0 + o1 * o1);
        const float r = 1.f / sqrtf(ss * (1.f / 128.f) + 1e-6f); const size_t row = (size_t)(rbase + t);
        const float g0 = bf2f(P[row * NP + C_GATEC + h * 128 + lane]), g1 = bf2f(P[row * NP + C_GATEC + h * 128 + 64 + lane]);
        YC[row * 1024 + h * 128 + lane] = (bf16_t)f2bf(o0 * r * ng[lane] * silu(g0));
        YC[row * 1024 + h * 128 + 64 + lane] = (bf16_t)f2bf(o1 * r * ng[64 + lane] * silu(g1)); }
}

#ifndef REP_ROLE
#define REP_ROLE -1
#endif
#define RR(x) for (int _rr = 0; _rr < ((REP_ROLE == (x)) ? 2 : 1); ++_rr)
__device__ __forceinline__ void phase_mixers(int layer, int G, int bid, int tid0) {
#ifndef PROBE_MIX
#define PROBE_MIX -1
#endif
#define PM(x) (PROBE_MIX == -1 || PROBE_MIX == (x))
    if (bid < 80) {
        const int tid = launder_v(tid0), lane = tid & 63, w = __builtin_amdgcn_readfirstlane(tid >> 6);
        if (w < 4) { const int it = launder_s(launder_s(bid) * 4 + w);
            if (it < 256) { if (PM(1)) RR(1) s5_item<false>(layer, it, w * S5_WLDS, lane); }
            else if (it < 320) { if (PM(2)) RR(2) s5_item<true>(layer, it - 256, w * S5_WLDS, lane); } }
        return;
    }
    const int nw = G - 80;
    for (int it0 = bid - 80; it0 < 1024 + 64 + 16 + 1024 + (REP_ROLE == 0 ? 1024 : 0); it0 += nw) {
        const int it = it0 >= 2128 ? it0 - 2128 : it0;
        const int tid = launder_v(tid0), lane = tid & 63, w = tid >> 6;
        if (it < 1024) { if (PM(0)) gdn_prep_item(layer, launder_s(it), tid); }
        else if (it < 1088) { if (PM(3)) RR(3) gmlp_prompt_item(layer, launder_s(it) - 1024, tid); }
        else if (it < 1104) { if (PM(4)) RR(4) gmlp_sample_item(layer, (launder_s(it) - 1088) * 8 + w, lane); }
        else { if (PM(5)) RR(5) gdn_sample_item(layer, launder_s(it) - 1104, tid); }
    }
}

__global__ void __launch_bounds__(512, 2) mega(Args karg) {
    const int ph_lo = karg.ph_lo, ph_hi = karg.ph_hi;
#ifndef REP_SUB
#define REP_SUB -1
#endif
#ifndef REP_N
#define REP_N 2
#endif
    int rep = 0;
    for (int ph = ph_lo; ph < ph_hi; (REP_SUB >= 0 && ph >= 1 && (ph - 1) % 6 == REP_SUB && rep + 1 < REP_N) ? (void)++rep : (void)(rep = 0, ++ph)) {
        if (ph > ph_lo && rep == 0) { cg::this_grid().sync(); }
        const int G = launder_s((int)gridDim.x), bid = launder_s((int)blockIdx.x), tid = launder_v((int)threadIdx.x);
        CArgs& a = kargs(); LAS unsigned char* lds = lds_base();
        unsigned char* ws = a.ws;
#ifndef PROBE_SUB
#define PROBE_SUB -1
#endif
#define PS(x) (PROBE_SUB == -1 || PROBE_SUB == (x))
        if (ph == 0) { if (PS(6)) phase_convert(a, lds, G, bid, tid); continue; }
        const int layer = (ph - 1) / 6, sub = (ph - 1) % 6;
        unsigned char* wb = ws + WS_W0 + (size_t)layer * WS_WL;
        if (PS(0) && sub == 0) {
            pg8::Gemm g{(const bf16_t*)(ws + WS_XB), nullptr, nullptr, (const bf16_t*)(wb + WO_IN), nullptr, nullptr, DM};
            pg8::Sched S; S.init(MT / 256, NP / 256, 1, G, bid);
            pg8::Epi1 E{(bf16_t*)(ws + WS_P), (float*)(ws + WS_AB)};
            pg8::gemm_phase(lds, g, S, E, tid);
        } else if (PS(1) && sub == 1) {
            phase_mixers(layer, G, bid, tid);
        } else if (PS(2) && sub == 2) {
            if (bid < 32) { RR(6) gdn_chain(layer, bid, tid); }
            else {
            pg8::Gemm g{(const bf16_t*)(ws + WS_ZB), nullptr, nullptr, (const bf16_t*)(wb + WO_GLU), nullptr, nullptr, 1024};
            pg8::Sched S; S.init(MT / 256, 4, 1, G - 32, bid - 32);
            pg8::Epi2 E{(const bf16_t*)(ws + WS_ZB), (const bf16_t*)(ws + WS_P), a.in[17] + layer * 1024, (bf16_t*)(ws + WS_YA)};
            pg8::gemm_phase(lds, g, S, E, tid);
            }
        } else if (PS(3) && sub == 3) {
            pg8::Gemm g{(const bf16_t*)(ws + WS_YA), (const bf16_t*)(ws + WS_YB), (const bf16_t*)(ws + WS_YC),
                        (const bf16_t*)(wb + WO_PA), (const bf16_t*)(wb + WO_PB), (const bf16_t*)(wb + WO_PC), 1024};
            pg8::Sched S; S.init(MT / 256, 8, 3, G, bid);
            pg8::Epi3 E{(const bf16_t*)(ws + WS_P), a.in[7] + layer * 3 * DM, (float*)(ws + WS_M32), (bf16_t*)(ws + WS_MB)};
            pg8::gemm_phase(lds, g, S, E, tid);
        } else if (PS(4) && sub == 4) {
            pg8::Gemm g{(const bf16_t*)(ws + WS_MB), nullptr, nullptr, (const bf16_t*)(wb + WO_OUT), nullptr, nullptr, DM};
            pg8::Sched S; S.init(MT / 256, 8, 1, G, bid);
            const float* xp = layer == 0 ? a.in[0] : (const float*)(ws + WS_X32);
            const float* xs = layer == 0 ? a.in[1] : (const float*)(ws + WS_X32) + (size_t)TP * DM;
            pg8::Epi4 E{xp, xs, (float*)(ws + WS_H32)};
            pg8::gemm_phase(lds, g, S, E, tid);
        } else if (PS(5) && sub == 5) {
            phase_ln(a, layer, G, bid, tid);
        }
    }
}

extern "C" void kernel_launch(void* const* d_in, const int* in_sizes, int n_in, void* d_out, int out_size, void* d_ws, size_t ws_size, hipStream_t stream) {
    static int grid = 0;
    if (grid == 0) {
        if (n_in != 32 || (size_t)out_size != O_END || ws_size < WS_END) {
            fprintf(stderr, "kernel_launch: unexpected problem: n_in %d out %d ws %zu (need %zu)\n", n_in, out_size, ws_size, (size_t)WS_END); grid = -1; return; }
        int dev = 0, cus = 0, per_cu = 0;
        if (hipGetDevice(&dev) != hipSuccess || hipDeviceGetAttribute(&cus, hipDeviceAttributeMultiprocessorCount, dev) != hipSuccess) { grid = -1; return; }
        if (hipFuncSetAttribute((const void*)mega, hipFuncAttributeMaxDynamicSharedMemorySize, LDS_BYTES) != hipSuccess) { fprintf(stderr, "kernel_launch: hipFuncSetAttribute failed\n"); grid = -1; return; }
        if (hipOccupancyMaxActiveBlocksPerMultiprocessor(&per_cu, (const void*)mega, 512, LDS_BYTES) != hipSuccess || per_cu < 1) {
            fprintf(stderr, "kernel_launch: occupancy query says %d blocks per CU\n", per_cu); (void)hipGetLastError(); grid = -1; return; }
        grid = cus;
    }
    if (grid < 0) return;
    Args a{};
    for (int i = 0; i < 32; ++i) a.in[i] = (const float*)d_in[i];
    a.out = (float*)d_out; a.ws = (unsigned char*)d_ws;
#if MK_SINGLE
    a.ph_lo = 0; a.ph_hi = NPHASE;
    void* params[] = {&a};
    hipError_t e = hipLaunchCooperativeKernel((const void*)mega, dim3(grid), dim3(512), params, LDS_BYTES, stream);
    if (e != hipSuccess) fprintf(stderr, "kernel_launch: cooperative launch failed: %s (grid %d)\n", hipGetErrorString(e), grid);
#else
    for (int ph = 0; ph < NPHASE; ++ph) {
        a.ph_lo = ph; a.ph_hi = ph + 1;
        hipLaunchKernelGGL(mega, dim3(grid), dim3(512), LDS_BYTES, stream, a);
    }
#endif
}
```

```cpp
#include <hip/hip_runtime.h>
#include <hip/hip_cooperative_groups.h>
#include <cstdio>
#include <cstdint>
namespace cg = cooperative_groups;

#ifndef MK_SINGLE
#define MK_SINGLE 1
#endif

#define LAS __attribute__((address_space(3)))
typedef unsigned short bf16_t;
typedef short bf16x8 __attribute__((ext_vector_type(8)));
typedef float f32x4 __attribute__((ext_vector_type(4)));
typedef float f32x2 __attribute__((ext_vector_type(2)));
typedef float f32x16 __attribute__((ext_vector_type(16)));
typedef unsigned u32x4 __attribute__((ext_vector_type(4)));
typedef unsigned u32x2 __attribute__((ext_vector_type(2)));

constexpr int DM = 2048, TP = 8192, TS = 512, MT = TP + TS;
constexpr int NIN = 15376, NP = 15616;
constexpr int C_XA = 0, C_GA = 1024, C_UB = 2048, C_VB = 3072, C_GB = 4096, C_QKV = 5120, C_GATEC = 8192, C_ZG = 9216, C_AB = 15360;
constexpr int NPHASE = 13;
constexpr float ALPHA = 1.41421356237f;

constexpr size_t MiB = 1u << 20;
constexpr size_t WS_CTL = 0;
constexpr size_t WS_W0 = 1 * MiB, WS_WL = 83 * MiB;
constexpr size_t WO_IN = 0, WO_GLU = 61 * MiB, WO_PA = 63 * MiB, WO_PB = 67 * MiB, WO_PC = 71 * MiB, WO_OUT = 75 * MiB;
constexpr size_t WS_XB = 167 * MiB, WS_P = 201 * MiB, WS_AB = 461 * MiB, WS_ZB = 462 * MiB, WS_YA = 479 * MiB, WS_YB = 496 * MiB, WS_YC = 513 * MiB;
constexpr size_t WS_M32 = 530 * MiB, WS_MB = 598 * MiB, WS_H32 = 632 * MiB, WS_X32 = 700 * MiB, WS_END = 768 * MiB;

constexpr size_t O_YP = 0, O_YS = 16777216, O_SRP = 17825792, O_SIP = 17858560, O_DP = 17891328, O_CP = 18939904,
                 O_SRS = 19013632, O_SIS = 20062208, O_DS = 21110784, O_CS = 54665216, O_GV = 57024512, O_END = 58073088;

constexpr int LDS_BYTES = 147456 + 256, LDS_BARST = 147456;

struct Args { const float* in[32]; float* out; unsigned char* ws; int ph_lo, ph_hi; };
typedef const __attribute__((address_space(4))) Args CArgs;

__device__ __forceinline__ unsigned f2bf(float f) { unsigned u = __builtin_bit_cast(unsigned, f); return (u + 0x7fffu + ((u >> 16) & 1u)) >> 16; }
__device__ __forceinline__ unsigned pk2(float lo, float hi) { return f2bf(lo) | (f2bf(hi) << 16); }
__device__ __forceinline__ float bf2f(unsigned short h) { return __builtin_bit_cast(float, (unsigned)h << 16); }
__device__ __forceinline__ float bflo(unsigned w) { return __builtin_bit_cast(float, w << 16); }
__device__ __forceinline__ float bfhi(unsigned w) { return __builtin_bit_cast(float, w & 0xffff0000u); }
__device__ __forceinline__ float sigm(float x) { return 1.f / (1.f + __expf(-x)); }
__device__ __forceinline__ float silu(float x) { return x / (1.f + __expf(-x)); }
__device__ __forceinline__ float gelu_tanh(float x) { return x * sigm(1.5957691216f * (x + 0.044715f * x * x * x)); }
__device__ __forceinline__ float softplus(float x) { return x > 20.f ? x : log1pf(expf(x)); }
__device__ __forceinline__ float wave_sum(float v) {
#pragma unroll
    for (int o = 1; o < 64; o <<= 1) v += __shfl_xor(v, o);
    return v;
}
__device__ __forceinline__ void unpack8(const u32x4 w, float (&f)[8]) {
    f[0] = bflo(w.x); f[1] = bfhi(w.x); f[2] = bflo(w.y); f[3] = bfhi(w.y); f[4] = bflo(w.z); f[5] = bfhi(w.z); f[6] = bflo(w.w); f[7] = bfhi(w.w);
}
__device__ __forceinline__ u32x4 pack8(const float (&f)[8]) { u32x4 w; w.x = pk2(f[0], f[1]); w.y = pk2(f[2], f[3]); w.z = pk2(f[4], f[5]); w.w = pk2(f[6], f[7]); return w; }
#define LDS_WAIT() asm volatile("s_waitcnt lgkmcnt(0)" ::: "memory")
__device__ __forceinline__ int launder_v(int x) { asm volatile("" : "+v"(x)); return x; }
__device__ __forceinline__ int launder_s(int x) { asm volatile("" : "+s"(x)); return x; }
__device__ __forceinline__ CArgs& kargs() { int z; asm volatile("s_mov_b32 %0, 0" : "=s"(z));
    return *(CArgs*)((const __attribute__((address_space(4))) char*)__builtin_amdgcn_kernarg_segment_ptr() + z); }
__device__ __forceinline__ LAS unsigned char* lds_base() { extern __shared__ __attribute__((aligned(16))) unsigned char lds_raw[]; int z; asm volatile("s_mov_b32 %0, 0" : "=s"(z));
    return (LAS unsigned char*)lds_raw + z; }

namespace pg8 {
constexpr int BM = 256, BK = 64, HALF = 128, HTB = HALF * BK * 2, STAGE_BYTES = 8 * HTB, NXCD = 8, WGM = 8;
__device__ __forceinline__ int lds_byte(int r, int c) { const int st = (r >> 4) * 2 + (c >> 5), rr = r & 15, cc = c & 31, ob = rr * 64 + cc * 2; return st * 1024 + (ob ^ (((ob >> 9) & 1) << 5)); }
__device__ __forceinline__ void stage_rc(int b, int& R, int& C) { const int st = b / 1024, sb = b % 1024, swz = sb ^ (((sb >> 9) & 1) << 5); R = (st >> 1) * 16 + swz / 64; C = (st & 1) * 32 + (swz % 64) / 2; }
__device__ __forceinline__ int perm32(int rho) { const int n = rho >> 4, i = rho & 15; return 8 * (i >> 2) + 4 * n + (i & 3); }

struct Unit { int pm, pn, br; };
struct Gemm { const bf16_t* A0; const bf16_t* A1; const bf16_t* A2; const bf16_t* B0; const bf16_t* B1; const bf16_t* B2; int K; };

struct Sched {
    int nM, nN, nbr, nwg, G, c;
    __device__ __forceinline__ void init(int nM_, int nN_, int nbr_, int G_, int c_) { nM = nM_; nN = nN_; nbr = nbr_; nwg = nM * nN; G = G_; c = c_; }
    __device__ __forceinline__ bool next(int i, Unit& u) const {
        const int ti = i / nbr; u.br = i - ti * nbr;
        const long L = (long)ti * G + c; if (L >= nwg) return false;
        int wgid = (int)L; { const int q = nwg / NXCD, r = nwg % NXCD, xcd = wgid % NXCD, off = wgid / NXCD; wgid = (xcd < r ? xcd * (q + 1) : r * (q + 1) + (xcd - r) * q) + off; }
        const int nig = WGM * nN, gid = wgid / nig, fm = gid * WGM, gsz = (nM - fm) < WGM ? (nM - fm) : WGM;
        u.pm = fm + ((wgid % nig) % gsz); u.pn = (wgid % nig) / gsz; return true;
    }
};

template <class Epi>
__device__ __forceinline__ void gemm_phase(LAS unsigned char* lds, const Gemm g, const Sched& S, const Epi& E, const int tid) {
    const int wid = __builtin_amdgcn_readfirstlane(tid >> 6), lane = tid & 63, wr = wid >> 2, wc = wid & 3, fr = lane & 15, fq = lane >> 4;
    const int K = g.K, nt = K / BK;
    unsigned voffA[2], voffB[2];
#pragma unroll
    for (int i = 0; i < 2; ++i) { int R, C; stage_rc(tid * 16 + i * 8192, R, C); const int Rb = (R & ~31) + perm32(R & 31);
        voffA[i] = (unsigned)(R * K + C) * 2u; voffB[i] = (unsigned)(Rb * K + C) * 2u; }
    const size_t kstep = (size_t)(BK * 2);
    const size_t hstep = (size_t)HALF * K * 2;
    const size_t tstep = 2 * hstep;
    const unsigned ldsw = (unsigned)wid * 1024u;
    const int aoff = lds_byte(wr * 64 + fr, fq * 8), boff = lds_byte(wc * 32 + fr, fq * 8);
#define PG8_SA(b, h) (((b) * 2 + (h)) * HTB)
#define PG8_SB(b, h) ((4 + (b) * 2 + (h)) * HTB)
#define PG8_STAGE(bufoff, gbase, voff) do { _Pragma("unroll") for (int _i = 0; _i < 2; ++_i) \
        __builtin_amdgcn_global_load_lds((const unsigned*)((const char*)(gbase) + (voff)[_i]), (LAS unsigned*)(lds + (bufoff) + ldsw + _i * 8192), 16, 0, 0); } while (0)
#define PG8_LDA(dst, b, h) do { _Pragma("unroll") for (int m = 0; m < 4; ++m) _Pragma("unroll") for (int k = 0; k < 2; ++k) dst[m][k] = *(const LAS bf16x8*)(lds + PG8_SA(b, h) + aoff + m * 2048 + k * 1024); } while (0)
#define PG8_LDB(dst, b, h) do { _Pragma("unroll") for (int n = 0; n < 2; ++n) _Pragma("unroll") for (int k = 0; k < 2; ++k) dst[n][k] = *(const LAS bf16x8*)(lds + PG8_SB(b, h) + boff + n * 2048 + k * 1024); } while (0)
#define PG8_MMA(ai, bj, At, Bt) do { __builtin_amdgcn_s_setprio(1); _Pragma("unroll") for (int m = 0; m < 4; ++m) _Pragma("unroll") for (int n = 0; n < 2; ++n) _Pragma("unroll") for (int k = 0; k < 2; ++k) \
        acc[ai][bj][m][n] = __builtin_amdgcn_mfma_f32_16x16x32_bf16(Bt[n][k], At[m][k], acc[ai][bj][m][n], 0, 0, 0); __builtin_amdgcn_s_setprio(0); } while (0)
#define PG8_WAIT_V(n) asm volatile("s_waitcnt vmcnt(" #n ")" ::: "memory")
#define PG8_WAIT_L(n) asm volatile("s_waitcnt lgkmcnt(" #n ")" ::: "memory")
#define PG8_BAR __builtin_amdgcn_s_barrier()
#define PG8_SCHED __builtin_amdgcn_sched_barrier(0)
#define PG8_APTR(u) ((const char*)((u).br == 0 ? g.A0 : ((u).br == 1 ? g.A1 : g.A2)) + (size_t)(u).pm * tstep)
#define PG8_BPTR(u) ((const char*)((u).br == 0 ? g.B0 : ((u).br == 1 ? g.B1 : g.B2)) + (size_t)(u).pn * tstep)
    Unit cur, nxt; int ui = 0;
    if (!S.next(0, cur)) return;
    f32x4 acc[2][2][4][2];
#pragma unroll
    for (int a = 0; a < 2; ++a)
#pragma unroll
        for (int b = 0; b < 2; ++b)
#pragma unroll
            for (int m = 0; m < 4; ++m)
#pragma unroll
                for (int n = 0; n < 2; ++n) acc[a][b][m][n] = (f32x4){0.f, 0.f, 0.f, 0.f};
    bf16x8 At[4][2], B0[2][2], B1[2][2];
    const char* cA = PG8_APTR(cur); const char* cB = PG8_BPTR(cur);
    PG8_STAGE(PG8_SB(0, 0), cB, voffB); PG8_STAGE(PG8_SB(0, 1), cB + hstep, voffB); PG8_STAGE(PG8_SA(0, 0), cA, voffA); PG8_STAGE(PG8_SA(0, 1), cA + hstep, voffA);
    if (wr == 1) PG8_BAR;
    PG8_WAIT_V(2); PG8_BAR;
    PG8_STAGE(PG8_SB(1, 0), cB + kstep, voffB); PG8_STAGE(PG8_SA(1, 0), cA + kstep, voffA); PG8_STAGE(PG8_SB(1, 1), cB + hstep + kstep, voffB);
    PG8_WAIT_V(6); PG8_BAR;
    for (;;) {
        const bool has_next = S.next(ui + 1, nxt);
        const char* nA = has_next ? PG8_APTR(nxt) : cA; const char* nB = has_next ? PG8_BPTR(nxt) : cB;
        for (int t = 0; t < nt; t += 2) {
            const bool last = (t == nt - 2);
            const char* a1 = cA + (size_t)(t + 1) * kstep;
            const char* a2 = last ? nA : cA + (size_t)(t + 2) * kstep; const char* b2 = last ? nB : cB + (size_t)(t + 2) * kstep;
            const char* a3 = a2 + kstep; const char* b3 = b2 + kstep;
            PG8_LDB(B0, 0, 0); PG8_LDB(B1, 0, 1); PG8_SCHED; PG8_LDA(At, 0, 0); PG8_STAGE(PG8_SA(1, 1), a1 + hstep, voffA);
            PG8_WAIT_V(8); PG8_WAIT_L(0); PG8_BAR; PG8_MMA(0, 0, At, B0); PG8_MMA(0, 1, At, B1); PG8_BAR; PG8_SCHED;
            PG8_LDA(At, 0, 1); PG8_STAGE(PG8_SB(0, 0), b2, voffB); PG8_STAGE(PG8_SB(0, 1), b2 + hstep, voffB); PG8_STAGE(PG8_SA(0, 0), a2, voffA);
            PG8_WAIT_V(8); PG8_WAIT_L(0); PG8_BAR; PG8_MMA(1, 0, At, B0); PG8_MMA(1, 1, At, B1); PG8_BAR; PG8_SCHED;
            PG8_LDB(B0, 1, 0); PG8_LDB(B1, 1, 1); PG8_SCHED; PG8_LDA(At, 1, 0); PG8_STAGE(PG8_SA(0, 1), a2 + hstep, voffA);
            PG8_WAIT_V(8); PG8_WAIT_L(0); PG8_BAR; PG8_MMA(0, 0, At, B0); PG8_MMA(0, 1, At, B1); PG8_BAR; PG8_SCHED;
            PG8_LDA(At, 1, 1); PG8_STAGE(PG8_SB(1, 0), b3, voffB); PG8_STAGE(PG8_SB(1, 1), b3 + hstep, voffB); PG8_STAGE(PG8_SA(1, 0), a3, voffA);
            PG8_WAIT_V(8); PG8_WAIT_L(0); PG8_BAR; PG8_MMA(1, 0, At, B0); PG8_MMA(1, 1, At, B1); PG8_BAR; PG8_SCHED;
        }
        if (wr == 0) PG8_BAR;
        E(acc, cur, wr, wc, fr, fq);
        if (!has_next) break;
#pragma unroll
        for (int a = 0; a < 2; ++a)
#pragma unroll
            for (int b = 0; b < 2; ++b)
#pragma unroll
                for (int m = 0; m < 4; ++m)
#pragma unroll
                    for (int n = 0; n < 2; ++n) acc[a][b][m][n] = (f32x4){0.f, 0.f, 0.f, 0.f};
        cur = nxt; cA = nA; cB = nB; ++ui;
        if (wr == 1) PG8_BAR;
    }
    PG8_WAIT_V(0);
    PG8_BAR;
#undef PG8_SA
#undef PG8_SB
#undef PG8_STAGE
#undef PG8_LDA
#undef PG8_LDB
#undef PG8_MMA
#undef PG8_WAIT_V
#undef PG8_WAIT_L
#undef PG8_BAR
#undef PG8_SCHED
#undef PG8_APTR
#undef PG8_BPTR
}

struct Epi1 {
    bf16_t* P; float* AB;
    __device__ __forceinline__ void operator()(const f32x4 (&acc)[2][2][4][2], const Unit& u, int wr, int wc, int fr, int fq) const {
        const int row0 = u.pm * BM + wr * 64 + fr, col0 = u.pn * BM + wc * 32 + 8 * fq;
#pragma unroll
        for (int ai = 0; ai < 2; ++ai)
#pragma unroll
            for (int m = 0; m < 4; ++m) { bf16_t* rowp = P + (size_t)(row0 + ai * HALF + m * 16) * NP + col0;
#pragma unroll
                for (int bj = 0; bj < 2; ++bj) { const f32x4 v0 = acc[ai][bj][m][0], v1 = acc[ai][bj][m][1];
                    u32x4 w; w.x = pk2(v0[0], v0[1]); w.y = pk2(v0[2], v0[3]); w.z = pk2(v1[0], v1[1]); w.w = pk2(v1[2], v1[3]);
                    *(u32x4*)(rowp + bj * HALF) = w; } }
        if (u.pn == 60 && wc == 0 && fq < 2) {
#pragma unroll
            for (int ai = 0; ai < 2; ++ai)
#pragma unroll
                for (int m = 0; m < 4; ++m) { float* ab = AB + (size_t)(row0 + ai * HALF + m * 16) * 16 + 8 * fq;
                    *(f32x4*)ab = acc[ai][0][m][0]; *(f32x4*)(ab + 4) = acc[ai][0][m][1]; }
        }
    }
};
struct Epi2 {
    const bf16_t* Zb; const bf16_t* P; const float* bglu; bf16_t* YA;
    __device__ __forceinline__ void operator()(const f32x4 (&acc)[2][2][4][2], const Unit& u, int wr, int wc, int fr, int fq) const {
        const int row0 = u.pm * BM + wr * 64 + fr, col0 = u.pn * BM + wc * 32 + 8 * fq;
#pragma unroll
        for (int bj = 0; bj < 2; ++bj) { const int col = col0 + bj * HALF;
            const f32x4 b0 = *(const f32x4*)(bglu + col), b1 = *(const f32x4*)(bglu + col + 4);
#pragma unroll
            for (int ai = 0; ai < 2; ++ai)
#pragma unroll
                for (int m = 0; m < 4; ++m) { const size_t row = (size_t)(row0 + ai * HALF + m * 16);
                    float z[8], ga[8], o[8];
                    unpack8(*(const u32x4*)(Zb + row * 1024 + col), z); unpack8(*(const u32x4*)(P + row * NP + C_GA + col), ga);
                    const f32x4 v0 = acc[ai][bj][m][0] + b0, v1 = acc[ai][bj][m][1] + b1;
#pragma unroll
                    for (int e = 0; e < 4; ++e) { o[e] = z[e] * sigm(v0[e]) * silu(ga[e]); o[4 + e] = z[4 + e] * sigm(v1[e]) * silu(ga[4 + e]); }
                    *(u32x4*)(YA + row * 1024 + col) = pack8(o); } }
    }
};
struct Epi3 {
    const bf16_t* P; const float* bgate; float* M32; bf16_t* Mb;
    __device__ __forceinline__ void operator()(const f32x4 (&acc)[2][2][4][2], const Unit& u, int wr, int wc, int fr, int fq) const {
        const int row0 = u.pm * BM + wr * 64 + fr, col0 = u.pn * BM + wc * 32 + 8 * fq, br = u.br;
#pragma unroll
        for (int bj = 0; bj < 2; ++bj) { const int col = col0 + bj * HALF;
            const f32x4 g0 = *(const f32x4*)(bgate + br * DM + col), g1 = *(const f32x4*)(bgate + br * DM + col + 4);
#pragma unroll
            for (int ai = 0; ai < 2; ++ai)
#pragma unroll
                for (int m = 0; m < 4; ++m) { const size_t row = (size_t)(row0 + ai * HALF + m * 16);
                    float zg[8], o[8];
                    unpack8(*(const u32x4*)(P + row * NP + C_ZG + br * DM + col), zg);
                    const f32x4 a0 = acc[ai][bj][m][0], a1 = acc[ai][bj][m][1];
#pragma unroll
                    for (int e = 0; e < 4; ++e) { o[e] = sigm(zg[e] + g0[e]) * a0[e]; o[4 + e] = sigm(zg[4 + e] + g1[e]) * a1[e]; }
                    float* mp = M32 + row * DM + col;
                    if (br > 0) { const f32x4 p0 = *(const f32x4*)mp, p1 = *(const f32x4*)(mp + 4);
#pragma unroll
                        for (int e = 0; e < 4; ++e) { o[e] += p0[e]; o[4 + e] += p1[e]; } }
                    if (br < 2) { *(f32x4*)mp = (f32x4){o[0], o[1], o[2], o[3]}; *(f32x4*)(mp + 4) = (f32x4){o[4], o[5], o[6], o[7]}; }
                    else *(u32x4*)(Mb + row * DM + col) = pack8(o); } }
    }
};
struct Epi4 {
    const float* xp; const float* xs; float* H32;
    __device__ __forceinline__ void operator()(const f32x4 (&acc)[2][2][4][2], const Unit& u, int wr, int wc, int fr, int fq) const {
        const int row0 = u.pm * BM + wr * 64 + fr, col0 = u.pn * BM + wc * 32 + 8 * fq;
        const float* xb = (u.pm < 32) ? xp : (xs - (size_t)TP * DM);
#pragma unroll
        for (int ai = 0; ai < 2; ++ai)
#pragma unroll
            for (int m = 0; m < 4; ++m) { const size_t row = (size_t)(row0 + ai * HALF + m * 16);
#pragma unroll
                for (int bj = 0; bj < 2; ++bj) { const int col = col0 + bj * HALF;
                    const f32x4 x0 = *(const f32x4*)(xb + row * DM + col), x1 = *(const f32x4*)(xb + row * DM + col + 4);
                    *(f32x4*)(H32 + row * DM + col) = x0 * ALPHA + acc[ai][bj][m][0];
                    *(f32x4*)(H32 + row * DM + col + 4) = x1 * ALPHA + acc[ai][bj][m][1]; } }
    }
};
}

template <bool REMAP>
__device__ __forceinline__ void transpose_item(const float* W, int K, int Nsrc, int Ndst, bf16_t* WT, LAS float* scr, int item, int lane) {
    const int nblk = Ndst / 32, kb = item / nblk, nb = item % nblk, k0 = 64 * kb, n0 = 32 * nb;
    int d = n0 + (lane & 31), s = d; bool valid = true;
    if (REMAP) { if (d < C_GATEC) s = d; else if (d < C_AB) s = d + 16; else if (d < C_AB + 16) s = 8192 + (d - C_AB); else { s = 0; valid = false; } }
#pragma unroll 8
    for (int i = 0; i < 32; ++i) { const int kk = 2 * i + (lane >> 5); scr[kk * 33 + (lane & 31)] = valid ? W[(size_t)(k0 + kk) * Nsrc + s] : 0.f; }
    LDS_WAIT();
    const int c = lane & 7;
#pragma unroll
    for (int j = 0; j < 4; ++j) { const int n = (lane >> 3) + 8 * j; const LAS float* sp = scr + (8 * c) * 33 + n;
        u32x4 o; o.x = pk2(sp[0 * 33], sp[1 * 33]); o.y = pk2(sp[2 * 33], sp[3 * 33]); o.z = pk2(sp[4 * 33], sp[5 * 33]); o.w = pk2(sp[6 * 33], sp[7 * 33]);
        *(u32x4*)(WT + (size_t)(n0 + n) * K + k0 + 8 * c) = o; }
    LDS_WAIT();
}

__device__ __forceinline__ void phase_convert(CArgs& a, LAS unsigned char* lds, int G, int vb, const int tid) {
    const int lane = tid & 63, wave = tid >> 6;
    LAS float* scr = (LAS float*)(lds + wave * 16384);
    const int gw = vb * 8 + wave, NGW = G * 8;
    constexpr int I_IN = (DM / 64) * (NP / 32), I_GLU = (1024 / 64) * (1024 / 32), I_P = (1024 / 64) * (DM / 32), I_OUT = (DM / 64) * (DM / 32);
    constexpr int I_L = I_IN + I_GLU + 3 * I_P + I_OUT;
    for (int it = gw; it < 2 * I_L; it += NGW) {
        const int l = it / I_L; int r = it - l * I_L;
        unsigned char* wb = a.ws + WS_W0 + (size_t)l * WS_WL;
        if (r < I_IN) { transpose_item<true>(a.in[6] + (size_t)l * DM * NIN, DM, NIN, NP, (bf16_t*)(wb + WO_IN), scr, r, lane); continue; } r -= I_IN;
        if (r < I_GLU) { transpose_item<false>(a.in[16] + (size_t)l * 1024 * 1024, 1024, 1024, 1024, (bf16_t*)(wb + WO_GLU), scr, r, lane); continue; } r -= I_GLU;
        if (r < I_P) { transpose_item<false>(a.in[18] + (size_t)l * 1024 * DM, 1024, DM, DM, (bf16_t*)(wb + WO_PA), scr, r, lane); continue; } r -= I_P;
        if (r < I_P) { transpose_item<false>(a.in[23] + (size_t)l * 1024 * DM, 1024, DM, DM, (bf16_t*)(wb + WO_PB), scr, r, lane); continue; } r -= I_P;
        if (r < I_P) { transpose_item<false>(a.in[28] + (size_t)l * 1024 * DM, 1024, DM, DM, (bf16_t*)(wb + WO_PC), scr, r, lane); continue; } r -= I_P;
        transpose_item<false>(a.in[29] + (size_t)l * DM * DM, DM, DM, DM, (bf16_t*)(wb + WO_OUT), scr, r, lane);
    }
    bf16_t* Xb = (bf16_t*)(a.ws + WS_XB);
    for (int m = gw; m < MT; m += NGW) {
        const float* xr = (m < TP) ? a.in[0] + (size_t)m * DM : a.in[1] + (size_t)(m - TP) * DM;
        const f32x4* xv = (const f32x4*)xr + lane; u32x2* o = (u32x2*)(Xb + (size_t)m * DM) + lane;
#pragma unroll
        for (int j = 0; j < 8; ++j) { const f32x4 v = xv[64 * j]; u32x2 w; w.x = pk2(v.x, v.y); w.y = pk2(v.z, v.w); o[64 * j] = w; }
    }
}

__device__ __forceinline__ void phase_ln(CArgs& a, int layer, int G, int vb, const int tid) {
    const int lane = tid & 63, wave = tid >> 6;
    const int gw = vb * 8 + wave, NGW = G * 8;
    const float* H32 = (const float*)(a.ws + WS_H32);
    const float* lg = a.in[30] + layer * DM; const float* lb = a.in[31] + layer * DM;
    bf16_t* Xb = (bf16_t*)(a.ws + WS_XB);
    for (int m = gw; m < MT; m += NGW) {
        const f32x4* xv = (const f32x4*)(H32 + (size_t)m * DM) + lane;
        f32x4 v[8]; float s = 0.f;
#pragma unroll
        for (int j = 0; j < 8; ++j) { v[j] = xv[64 * j]; s += (v[j].x + v[j].y) + (v[j].z + v[j].w); }
        const float mean = wave_sum(s) * (1.f / DM); float s2 = 0.f;
#pragma unroll
        for (int j = 0; j < 8; ++j) { v[j] = v[j] - mean; s2 += (v[j].x * v[j].x + v[j].y * v[j].y) + (v[j].z * v[j].z + v[j].w * v[j].w); }
        const float rstd = 1.f / sqrtf(wave_sum(s2) * (1.f / DM) + 1e-5f);
        float* dst = (layer == 0) ? (float*)(a.ws + WS_X32) + (size_t)m * DM : (m < TP ? a.out + O_YP + (size_t)m * DM : a.out + O_YS + (size_t)(m - TP) * DM);
#pragma unroll
        for (int j = 0; j < 8; ++j) { const f32x4 gg = *((const f32x4*)lg + lane + 64 * j), bb = *((const f32x4*)lb + lane + 64 * j);
            const f32x4 y = v[j] * rstd * gg + bb; *((f32x4*)dst + lane + 64 * j) = y;
            if (layer == 0) { u32x2 w; w.x = pk2(y.x, y.y); w.y = pk2(y.z, y.w); *((u32x2*)(Xb + (size_t)m * DM) + lane + 64 * j) = w; } }
    }
}

constexpr int S5_BUS = 128;
constexpr int S5_SROW = 272;
constexpr int S5_UB = 32 * S5_BUS * 4 + 32 * S5_SROW;
constexpr int S5_WLDS = S5_UB + 1024;
template <bool SAMPLE>
__device__ __forceinline__ void s5_item(int layer, int item, int wlo, int lane) {
    CArgs& a = kargs(); LAS unsigned char* wl = lds_base() + wlo;
    const int g = SAMPLE ? item : (item & 63), b = SAMPLE ? 0 : (item >> 6);
    const float* lam_re = a.in[8] + layer * 4096 + g * 64; const float* lam_im = a.in[9] + layer * 4096 + g * 64;
    const float dt = expf(a.in[10][layer * 64 + g]);
    const float* b_re = a.in[11] + (size_t)(layer * 64 + g) * 1024; const float* b_im = a.in[12] + (size_t)(layer * 64 + g) * 1024;
    const float* c_re = a.in[13] + (size_t)(layer * 64 + g) * 1024; const float* c_im = a.in[14] + (size_t)(layer * 64 + g) * 1024;
    const f32x4 dch = *(const f32x4*)(a.in[15] + layer * 1024 + g * 16 + 4 * (lane >> 4));
    const bf16_t* P = (const bf16_t*)(a.ws + WS_P); bf16_t* Zb = (bf16_t*)(a.ws + WS_ZB);
    LAS float* BU = (LAS float*)wl; LAS unsigned char* Sb = wl + 32 * S5_BUS * 4; LAS unsigned char* Ub = wl + S5_UB;
    float ar, ai;
    { const float lr = lam_re[lane], li = lam_im[lane]; const float mag = expf(lr * dt); float sn, cs; sincosf(li * dt, &sn, &cs); ar = mag * cs; ai = mag * sn; }
    bf16x8 Bf[4];
    { const int h = lane >> 5;
#pragma unroll
      for (int q = 0; q < 2; ++q) { const int pp = q * 32 + (lane & 31);
        const float lr = lam_re[pp], li = lam_im[pp]; const float mag = expf(lr * dt); float sn, cs; sincosf(li * dt, &sn, &cs);
        const float abr = mag * cs, abi = mag * sn, den = lr * lr + li * li, nr = abr - 1.f, ni = abi;
        const float f_r = (nr * lr + ni * li) / den, f_i = (ni * lr - nr * li) / den;
        float br8[8], bi8[8], or8[8], oi8[8];
        *(f32x4*)&br8[0] = *(const f32x4*)(b_re + pp * 16 + 8 * h); *(f32x4*)&br8[4] = *(const f32x4*)(b_re + pp * 16 + 8 * h + 4);
        *(f32x4*)&bi8[0] = *(const f32x4*)(b_im + pp * 16 + 8 * h); *(f32x4*)&bi8[4] = *(const f32x4*)(b_im + pp * 16 + 8 * h + 4);
#pragma unroll
        for (int e = 0; e < 8; ++e) { or8[e] = f_r * br8[e] - f_i * bi8[e]; oi8[e] = f_r * bi8[e] + f_i * br8[e]; }
        Bf[q] = __builtin_bit_cast(bf16x8, pack8(or8)); Bf[2 + q] = __builtin_bit_cast(bf16x8, pack8(oi8)); } }
    bf16x8 Cf[4];
    { const int c = lane & 15;
#pragma unroll
      for (int ks = 0; ks < 4; ++ks) { const int p0 = 16 * ks + 4 * (lane >> 4);
        const f32x4 cr = *(const f32x4*)(c_re + c * 64 + p0), ci = *(const f32x4*)(c_im + c * 64 + p0);
        float o[8] = {cr[0], -ci[0], cr[1], -ci[1], cr[2], -ci[2], cr[3], -ci[3]};
        Cf[ks] = __builtin_bit_cast(bf16x8, pack8(o)); } }
    float sr = 0.f, si = 0.f;
    const int nsc = SAMPLE ? 16 : 64;
    const float* h_re = a.in[2] + (size_t)layer * 128 * 4096 + g * 64 + lane; const float* h_im = a.in[3] + (size_t)layer * 128 * 4096 + g * 64 + lane;
    float* o_re = a.out + O_SRS + (size_t)layer * 128 * 4096 + g * 64 + lane; float* o_im = a.out + O_SIS + (size_t)layer * 128 * 4096 + g * 64 + lane;
    const bf16_t* up = P + (size_t)((SAMPLE ? TP : b * 2048) + (lane & 31)) * NP + C_XA + g * 16 + 8 * (lane >> 5);
    bf16x8 Af = *(const bf16x8*)up;
    float hr[8], hi[8];
    if (SAMPLE) {
#pragma unroll
        for (int q = 0; q < 8; ++q) { hr[q] = h_re[(size_t)q * 4096]; hi[q] = h_im[(size_t)q * 4096]; } }
    for (int sc = 0; sc < nsc; ++sc) {
        const int row0 = SAMPLE ? TP + sc * 32 : b * 2048 + sc * 32;
        const bf16x8 Ac = Af;
        float hcr[8], hci[8];
        if (SAMPLE) {
#pragma unroll
            for (int q = 0; q < 8; ++q) { hcr[q] = hr[q]; hci[q] = hi[q]; } }
        if (sc + 1 < nsc) { Af = *(const bf16x8*)(up + (size_t)(sc + 1) * 32 * NP);
            if (SAMPLE) {
#pragma unroll
                for (int q = 0; q < 8; ++q) { hr[q] = h_re[(size_t)((sc + 1) * 8 + q) * 4096]; hi[q] = h_im[(size_t)((sc + 1) * 8 + q) * 4096]; } } }
        *(LAS bf16x8*)(Ub + (lane & 31) * 32 + 16 * (lane >> 5)) = Ac;
#pragma unroll
        for (int nb = 0; nb < 4; ++nb) {
            f32x16 acc;
#pragma unroll
            for (int r = 0; r < 16; ++r) acc[r] = 0.f;
            acc = __builtin_amdgcn_mfma_f32_32x32x16_bf16(Ac, Bf[nb], acc, 0, 0, 0);
#pragma unroll
            for (int r = 0; r < 16; ++r) { const int t = (r & 3) + 8 * (r >> 2) + 4 * (lane >> 5); BU[t * S5_BUS + 32 * nb + (lane & 31)] = acc[r]; }
        }
        LDS_WAIT();
#pragma unroll
        for (int t = 0; t < 32; ++t) {
            if (SAMPLE && (t & 3) == 0) { sr = hcr[t >> 2]; si = hci[t >> 2]; }
            const float bur = BU[t * S5_BUS + lane], bui = BU[t * S5_BUS + 64 + lane];
            const float nsr = ar * sr - ai * si + bur, nsi = ar * si + ai * sr + bui;
            sr = nsr; si = nsi;
            *(LAS unsigned*)(Sb + t * S5_SROW + 4 * lane) = pk2(sr, si);
            if (SAMPLE && (t & 3) == 3) { const int bi = sc * 8 + (t >> 2); o_re[(size_t)bi * 4096] = sr; o_im[(size_t)bi * 4096] = si; }
        }
        LDS_WAIT();
#pragma unroll
        for (int mb = 0; mb < 2; ++mb) {
            f32x4 y = (f32x4){0.f, 0.f, 0.f, 0.f};
#pragma unroll
            for (int ks = 0; ks < 4; ++ks) { const bf16x8 Sf = *(const LAS bf16x8*)(Sb + (16 * mb + (lane & 15)) * S5_SROW + 64 * ks + 16 * (lane >> 4));
                y = __builtin_amdgcn_mfma_f32_16x16x32_bf16(Cf[ks], Sf, y, 0, 0, 0); }
            const int tt = 16 * mb + (lane & 15);
            const u32x2 xw = *(const LAS u32x2*)(Ub + tt * 32 + 8 * (lane >> 4));
            u32x2 o; o.x = pk2(gelu_tanh(y[0] + dch[0] * bflo(xw.x)), gelu_tanh(y[1] + dch[1] * bfhi(xw.x)));
            o.y = pk2(gelu_tanh(y[2] + dch[2] * bflo(xw.y)), gelu_tanh(y[3] + dch[3] * bfhi(xw.y)));
            *(u32x2*)(Zb + (size_t)(row0 + tt) * 1024 + g * 16 + 4 * (lane >> 4)) = o;
        }
        LDS_WAIT();
    }
    if (!SAMPLE) { a.out[O_SRP + (size_t)((layer * 4 + b) * 64 + g) * 64 + lane] = sr; a.out[O_SIP + (size_t)((layer * 4 + b) * 64 + g) * 64 + lane] = si; }
}

constexpr int GM_TROW = 80;
__device__ __forceinline__ void gmlp_prompt_item(int layer, int item, const int tid) {
    CArgs& a = kargs(); LAS unsigned char* lds = lds_base();
    const int lane = tid & 63, w = __builtin_amdgcn_readfirstlane(tid >> 6);
    const bf16_t* P = (const bf16_t*)(a.ws + WS_P); bf16_t* YB = (bf16_t*)(a.ws + WS_YB);
    const float* lng = a.in[19] + layer * 1024; const float* lnb = a.in[20] + layer * 1024;
    const int r0 = item * 128, g = w;
    LAS f32x2* stats = (LAS f32x2*)lds;
    LAS unsigned char* vt = lds + 1024 + w * (16 * GM_TROW);
    __syncthreads();
    {
#pragma unroll 1
        for (int hb = 0; hb < 2; ++hb) {
        u32x4 raw[8][2];
#pragma unroll
        for (int i = 0; i < 8; ++i) { const bf16_t* rp = P + (size_t)(r0 + 16 * w + 8 * hb + i) * NP + C_VB + lane * 16; raw[i][0] = *(const u32x4*)rp; raw[i][1] = *(const u32x4*)(rp + 8); }
#pragma unroll
        for (int i = 0; i < 8; ++i) { float x[16]; { float t8[8]; unpack8(raw[i][0], t8);
#pragma unroll
                for (int e = 0; e < 8; ++e) x[e] = t8[e];
                unpack8(raw[i][1], t8);
#pragma unroll
                for (int e = 0; e < 8; ++e) x[8 + e] = t8[e]; }
            float s = 0.f;
#pragma unroll
            for (int e = 0; e < 16; ++e) s += x[e];
            const float mean = wave_sum(s) * (1.f / 1024.f); float s2 = 0.f;
#pragma unroll
            for (int e = 0; e < 16; ++e) { const float d = x[e] - mean; s2 += d * d; }
            const float rstd = 1.f / sqrtf(wave_sum(s2) * (1.f / 1024.f) + 1e-5f);
            if (lane == 0) stats[16 * w + 8 * hb + i] = (f32x2){mean, rstd}; }
        }
    }
    __syncthreads();
    bf16x8 Wf[20];
    { const float* Ws = a.in[21] + (size_t)(layer * 8 + g) * 128 * 128;
#pragma unroll
      for (int kb = 0; kb < 4; ++kb)
#pragma unroll
        for (int ib = 2 * kb; ib < 8; ++ib) { const int fi = (kb == 0 ? 0 : kb == 1 ? 8 : kb == 2 ? 14 : 18) + ib - 2 * kb;
            const int i = 16 * ib + (lane & 15), j0 = 32 * kb + 8 * (lane >> 4);
            const f32x4 w0 = *(const f32x4*)(Ws + i * 128 + j0), w1 = *(const f32x4*)(Ws + i * 128 + j0 + 4);
            float wv[8];
#pragma unroll
            for (int e = 0; e < 8; ++e) { const float x = e < 4 ? w0[e & 3] : w1[e & 3]; wv[e] = (j0 + e <= i) ? x : 0.f; }
            Wf[fi] = __builtin_bit_cast(bf16x8, pack8(wv));
            if ((fi & 3) == 3) __builtin_amdgcn_sched_barrier(0); } }
    const float* bsp = a.in[22] + (size_t)(layer * 8 + g) * 128;
#pragma unroll 1
    for (int rnd = 0; rnd < 8; ++rnd) {
        const int cbase = g * 128 + rnd * 16;
        f32x4 acc[8];
#pragma unroll
        for (int ib = 0; ib < 8; ++ib) acc[ib] = (f32x4){0.f, 0.f, 0.f, 0.f};
        const int cg = lane & 1, j = lane >> 1;
        u32x4 raw[4];
#pragma unroll
        for (int kb = 0; kb < 4; ++kb) raw[kb] = *(const u32x4*)(P + (size_t)(r0 + 32 * kb + j) * NP + C_VB + cbase + cg * 8);
        const f32x4 g0 = *(const f32x4*)(lng + cbase + cg * 8), g1 = *(const f32x4*)(lng + cbase + cg * 8 + 4);
        const f32x4 b0 = *(const f32x4*)(lnb + cbase + cg * 8), b1 = *(const f32x4*)(lnb + cbase + cg * 8 + 4);
#pragma unroll
        for (int kb = 0; kb < 4; ++kb) {
            { float x[8]; unpack8(raw[kb], x);
              const f32x2 st = stats[32 * kb + j];
#pragma unroll
              for (int e = 0; e < 8; ++e) { const float gg = e < 4 ? g0[e & 3] : g1[e & 3], bb = e < 4 ? b0[e & 3] : b1[e & 3];
                  const float v = (x[e] - st.x) * st.y * gg + bb;
                  *(LAS bf16_t*)(vt + (cg * 8 + e) * GM_TROW + 2 * j) = (bf16_t)f2bf(v); } }
            LDS_WAIT();
            const bf16x8 Af = *(const LAS bf16x8*)(vt + (lane & 15) * GM_TROW + 16 * (lane >> 4));
#pragma unroll
            for (int ib = 2 * kb; ib < 8; ++ib) { const int fi = (kb == 0 ? 0 : kb == 1 ? 8 : kb == 2 ? 14 : 18) + ib - 2 * kb;
                acc[ib] = __builtin_amdgcn_mfma_f32_16x16x32_bf16(Af, Wf[fi], acc[ib], 0, 0, 0); }
            LDS_WAIT();
        }
#pragma unroll
        for (int ib = 0; ib < 8; ++ib) { const int i = 16 * ib + (lane & 15); const float bs = bsp[i]; const size_t row = (size_t)(r0 + i);
            const int ch = cbase + 4 * (lane >> 4);
            const u32x2 uw = *(const u32x2*)(P + row * NP + C_UB + ch), gw = *(const u32x2*)(P + row * NP + C_GB + ch);
            const f32x4 s = acc[ib] + bs;
            u32x2 o; o.x = pk2(bflo(uw.x) * s[0] * silu(bflo(gw.x)), bfhi(uw.x) * s[1] * silu(bfhi(gw.x)));
            o.y = pk2(bflo(uw.y) * s[2] * silu(bflo(gw.y)), bfhi(uw.y) * s[3] * silu(bfhi(gw.y)));
            *(u32x2*)(YB + row * 1024 + ch) = o; }
    }
}
__device__ __forceinline__ void gmlp_sample_item(int layer, int b, int lane) {
    CArgs& a = kargs();
    const bf16_t* P = (const bf16_t*)(a.ws + WS_P); bf16_t* YB = (bf16_t*)(a.ws + WS_YB);
    const float* lng = a.in[19] + layer * 1024 + lane * 16; const float* lnb = a.in[20] + layer * 1024 + lane * 16;
    const int g = lane >> 3;
    const float* Ws = a.in[21] + (size_t)(layer * 8 + g) * 128 * 128; const float* bsp = a.in[22] + (size_t)(layer * 8 + g) * 128;
    float vn[4][16];
#pragma unroll
    for (int t = 0; t < 4; ++t) { const size_t row = (size_t)(TP + b * 4 + t); const bf16_t* rp = P + row * NP + C_VB + lane * 16;
        float x[16]; { float t8[8]; unpack8(*(const u32x4*)rp, t8);
#pragma unroll
            for (int e = 0; e < 8; ++e) x[e] = t8[e];
            unpack8(*(const u32x4*)(rp + 8), t8);
#pragma unroll
            for (int e = 0; e < 8; ++e) x[8 + e] = t8[e]; }
        float s = 0.f;
#pragma unroll
        for (int e = 0; e < 16; ++e) s += x[e];
        const float mean = wave_sum(s) * (1.f / 1024.f); float s2 = 0.f;
#pragma unroll
        for (int e = 0; e < 16; ++e) { const float d = x[e] - mean; s2 += d * d; }
        const float rstd = 1.f / sqrtf(wave_sum(s2) * (1.f / 1024.f) + 1e-5f);
        float* ov = a.out + O_GV + ((size_t)(layer * 128 + b) * 4 + t) * 1024 + lane * 16;
#pragma unroll
        for (int e = 0; e < 16; ++e) vn[t][e] = (x[e] - mean) * rstd * lng[e] + lnb[e];
#pragma unroll
        for (int e = 0; e < 16; e += 4) *(f32x4*)(ov + e) = (f32x4){vn[t][e], vn[t][e + 1], vn[t][e + 2], vn[t][e + 3]}; }
#pragma unroll
    for (int i = 0; i < 4; ++i) { const size_t row = (size_t)(TP + b * 4 + i);
        float s[16]; const float bs = bsp[i];
#pragma unroll
        for (int e = 0; e < 16; ++e) s[e] = bs;
#pragma unroll
        for (int j = 0; j < 4; ++j) if (j <= i) { const float wv = Ws[i * 128 + j];
#pragma unroll
            for (int e = 0; e < 16; ++e) s[e] += wv * vn[j][e]; }
        float ub[16], gb[16];
        { float t8[8]; unpack8(*(const u32x4*)(P + row * NP + C_UB + lane * 16), t8);
#pragma unroll
          for (int e = 0; e < 8; ++e) ub[e] = t8[e];
          unpack8(*(const u32x4*)(P + row * NP + C_UB + lane * 16 + 8), t8);
#pragma unroll
          for (int e = 0; e < 8; ++e) ub[8 + e] = t8[e];
          unpack8(*(const u32x4*)(P + row * NP + C_GB + lane * 16), t8);
#pragma unroll
          for (int e = 0; e < 8; ++e) gb[e] = t8[e];
          unpack8(*(const u32x4*)(P + row * NP + C_GB + lane * 16 + 8), t8);
#pragma unroll
          for (int e = 0; e < 8; ++e) gb[8 + e] = t8[e]; }
        float o0[8], o1[8];
#pragma unroll
        for (int e = 0; e < 8; ++e) { o0[e] = ub[e] * s[e] * silu(gb[e]); o1[e] = ub[8 + e] * s[8 + e] * silu(gb[8 + e]); }
        *(u32x4*)(YB + row * 1024 + lane * 16) = pack8(o0); *(u32x4*)(YB + row * 1024 + lane * 16 + 8) = pack8(o1); }
}

template <bool SAMPLE>
__device__ __forceinline__ void gdn_item_v1(int layer, int item, const int tid) {
    CArgs& a = kargs(); LAS unsigned char* lds = lds_base();
    const int lane = tid & 63, w = tid >> 6;
    const int b = item >> 3, h = item & 7;
    const int T = SAMPLE ? 4 : 2048, rbase = SAMPLE ? TP + b * 4 : b * 2048, NB = SAMPLE ? 128 : 4;
    const bf16_t* P = (const bf16_t*)(a.ws + WS_P); const float* AB = (const float*)(a.ws + WS_AB); bf16_t* YC = (bf16_t*)(a.ws + WS_YC);
    const float* convw = a.in[24] + (size_t)layer * 4 * 3072;
    const float* sconv = a.in[5] + (size_t)(layer * 128 + b) * 3 * 3072;
    LAS float* qs = (LAS float*)lds; LAS float* ks = qs + 64 * 128; LAS float* vs = ks + 64 * 128;
    LAS float* red = vs + 64 * 128; LAS float* red2 = red + 512; LAS float* av = red2 + 512; LAS float* bv = av + 64;
    const int dv = (w & 1) * 64 + lane, sl = w >> 1, dk0 = sl * 32;
    float S[32];
    if (SAMPLE) { const float* s0 = a.in[4] + ((size_t)((layer * 128 + b) * 8 + h) * 128 + dk0) * 128 + dv;
#pragma unroll
        for (int i = 0; i < 32; ++i) S[i] = s0[(size_t)i * 128]; }
    else {
#pragma unroll
        for (int i = 0; i < 32; ++i) S[i] = 0.f; }
    const float Aexp = expf(a.in[25][layer * 8 + h]), dtb = a.in[26][layer * 8 + h];
    for (int c0 = 0; c0 < T; c0 += 64) {
        const int n = (T - c0) < 64 ? (T - c0) : 64;
        __syncthreads();
        for (int idx = tid; idx < n * 384; idx += 512) {
            const int t = idx / 384, ch = idx - t * 384, sec = ch >> 7, cc = ch & 127, col = sec * 1024 + h * 128 + cc, tg = c0 + t;
            float accv = 0.f;
#pragma unroll
            for (int j = 0; j < 4; ++j) { const int tt = tg - 3 + j; float x;
                if (tt >= 0) x = bf2f(P[(size_t)(rbase + tt) * NP + C_QKV + col]);
                else x = SAMPLE ? sconv[(3 + tt) * 3072 + col] : 0.f;
                accv += convw[j * 3072 + col] * x; }
            const float y = silu(accv);
            LAS float* dst = sec == 0 ? qs : (sec == 1 ? ks : vs); dst[t * 128 + cc] = y;
        }
        if (tid < n) { const size_t row = (size_t)(rbase + c0 + tid); const float ac = AB[row * 16 + h], bc = AB[row * 16 + 8 + h];
            const float gg = -Aexp * softplus(ac + dtb); av[tid] = expf(gg); bv[tid] = sigm(bc); }
        __syncthreads();
        for (int t = w; t < n; t += 8) {
            { const float q0 = qs[t * 128 + lane], q1 = qs[t * 128 + 64 + lane]; const float ss = wave_sum(q0 * q0 + q1 * q1);
              const float r = (1.f / sqrtf(ss + 1e-6f)) * 0.08838834764831845f; qs[t * 128 + lane] = q0 * r; qs[t * 128 + 64 + lane] = q1 * r; }
            { const float k0 = ks[t * 128 + lane], k1 = ks[t * 128 + 64 + lane]; const float ss = wave_sum(k0 * k0 + k1 * k1);
              const float r = 1.f / sqrtf(ss + 1e-6f); ks[t * 128 + lane] = k0 * r; ks[t * 128 + 64 + lane] = k1 * r; }
        }
        __syncthreads();
        for (int t = 0; t < n; ++t) {
            const float at = av[t], bt = bv[t];
            float p = 0.f;
#pragma unroll
            for (int i = 0; i < 32; i += 4) { const f32x4 kk = *(const LAS f32x4*)(ks + t * 128 + dk0 + i);
                p += kk[0] * S[i] + kk[1] * S[i + 1] + kk[2] * S[i + 2] + kk[3] * S[i + 3]; }
            red[sl * 128 + dv] = p;
            __syncthreads();
            const float kS = (red[dv] + red[128 + dv]) + (red[256 + dv] + red[384 + dv]);
            const float vnew = bt * (vs[t * 128 + dv] - at * kS);
            float po = 0.f;
#pragma unroll
            for (int i = 0; i < 32; i += 4) { const f32x4 kk = *(const LAS f32x4*)(ks + t * 128 + dk0 + i), qq = *(const LAS f32x4*)(qs + t * 128 + dk0 + i);
#pragma unroll
                for (int e = 0; e < 4; ++e) { S[i + e] = at * S[i + e] + kk[e] * vnew; po += qq[e] * S[i + e]; } }
            red2[sl * 128 + dv] = po;
            __syncthreads();
            if (sl == 0) vs[t * 128 + dv] = (red2[dv] + red2[128 + dv]) + (red2[256 + dv] + red2[384 + dv]);
        }
        __syncthreads();
        const float* ng = a.in[27] + layer * 128;
        for (int t = w; t < n; t += 8) {
            const float o0 = vs[t * 128 + lane], o1 = vs[t * 128 + 64 + lane]; const float ss = wave_sum(o0 * o0 + o1 * o1);
            const float r = 1.f / sqrtf(ss * (1.f / 128.f) + 1e-6f); const size_t row = (size_t)(rbase + c0 + t);
            const float g0 = bf2f(P[row * NP + C_GATEC + h * 128 + lane]), g1 = bf2f(P[row * NP + C_GATEC + h * 128 + 64 + lane]);
            YC[row * 1024 + h * 128 + lane] = (bf16_t)f2bf(o0 * r * ng[lane] * silu(g0));
            YC[row * 1024 + h * 128 + 64 + lane] = (bf16_t)f2bf(o1 * r * ng[64 + lane] * silu(g1));
        }
    }
    { float* so = a.out + (SAMPLE ? O_DS : O_DP) + ((size_t)((layer * NB + b) * 8 + h) * 128 + dk0) * 128 + dv;
#pragma unroll
      for (int i = 0; i < 32; ++i) so[(size_t)i * 128] = S[i]; }
    { float* co = a.out + (SAMPLE ? O_CS : O_CP) + (size_t)(layer * NB + b) * 3 * 3072;
      for (int idx = tid; idx < 3 * 384; idx += 512) { const int r = idx / 384, ch = idx - r * 384, col = (ch >> 7) * 1024 + h * 128 + (ch & 127);
          co[r * 3072 + col] = bf2f(P[(size_t)(rbase + T - 3 + r) * NP + C_QKV + col]); } }
}


constexpr size_t WS_GC = WS_M32;
constexpr int GC_STRIDE = 98304, GC_WN = 0, GC_QG = 16384, GC_KG = 32768, GC_AT = 49152, GC_U = 57344, GC_GAMMA = 90112, GC_OPS = 57344;
static_assert(WS_GC + (size_t)1024 * GC_STRIDE <= WS_H32, "chunk buffers fit in the M32|MB overlay");
constexpr int GP_QR = 0, GP_KR = 17408, GP_KBR = 34816, GP_VT = 52224, GP_KGT = 70656, GP_KT2 = 89088, GP_LM = 107520, GP_TM = 124928, GP_AS = 134144,
              GP_GC = 143360, GP_BETA = 143616, GP_GRAW = 143872, GP_WST = 0;
#define MFMA32(a, b, c) __builtin_amdgcn_mfma_f32_32x32x16_bf16((a), (b), (c), 0, 0, 0)

__device__ __forceinline__ void gdn_prep_item(int layer, int item, const int tid) {
    CArgs& a = kargs(); LAS unsigned char* lds = lds_base();
    const int lane = tid & 63, w = __builtin_amdgcn_readfirstlane(tid >> 6), hh = lane >> 5, l31 = lane & 31;
    const int b = item >> 8, h = (item >> 5) & 7, n = item & 31;
    const bf16_t* P = (const bf16_t*)(a.ws + WS_P); const float* AB = (const float*)(a.ws + WS_AB);
    unsigned char* gc = a.ws + WS_GC + (size_t)item * GC_STRIDE;
    const int t = tid >> 3, cg = tid & 7;
    const int r0 = b * 2048 + n * 64;
    __syncthreads();
    float qv[16], kv[16], vv[16];
    {
        const float* convw = a.in[24] + (size_t)layer * 4 * 3072;
#pragma unroll
        for (int sec = 0; sec < 3; ++sec) {
            const int ch = sec * 1024 + h * 128 + 16 * cg;
            float acc[16];
#pragma unroll
            for (int e = 0; e < 16; ++e) acc[e] = 0.f;
#pragma unroll
            for (int j = 0; j < 4; ++j) {
                const int tt = n * 64 + t - 3 + j; const float msk = tt < 0 ? 0.f : 1.f;
                float x[16];
                { const bf16_t* rp = P + (size_t)(b * 2048 + (tt < 0 ? 0 : tt)) * NP + C_QKV + ch; float t8[8];
                    unpack8(*(const u32x4*)rp, t8);
#pragma unroll
                    for (int e = 0; e < 8; ++e) x[e] = t8[e];
                    unpack8(*(const u32x4*)(rp + 8), t8);
#pragma unroll
                    for (int e = 0; e < 8; ++e) x[8 + e] = t8[e]; }
                const float* wp = convw + j * 3072 + ch;
#pragma unroll
                for (int e = 0; e < 16; e += 4) { const f32x4 wv = *(const f32x4*)(wp + e) * msk;
                    acc[e] += wv[0] * x[e]; acc[e + 1] += wv[1] * x[e + 1]; acc[e + 2] += wv[2] * x[e + 2]; acc[e + 3] += wv[3] * x[e + 3]; }
                if (j == 3 && n == 31 && t >= 61) { float* co = a.out + O_CP + ((size_t)(layer * 4 + b) * 3 + (t - 61)) * 3072 + ch;
#pragma unroll
                    for (int e = 0; e < 16; e += 4) *(f32x4*)(co + e) = (f32x4){x[e], x[e + 1], x[e + 2], x[e + 3]}; }
            }
            float ss = 0.f;
#pragma unroll
            for (int e = 0; e < 16; ++e) { acc[e] = silu(acc[e]); ss += acc[e] * acc[e]; }
            if (sec < 2) { ss += __shfl_xor(ss, 1); ss += __shfl_xor(ss, 2); ss += __shfl_xor(ss, 4);
                const float r = (1.f / sqrtf(ss + 1e-6f)) * (sec == 0 ? 0.08838834764831845f : 1.f);
#pragma unroll
                for (int e = 0; e < 16; ++e) { if (sec == 0) qv[e] = acc[e] * r; else kv[e] = acc[e] * r; } }
            else {
#pragma unroll
                for (int e = 0; e < 16; ++e) vv[e] = acc[e]; }
        }
        if (cg == 0) { const size_t row = (size_t)(r0 + t); const float ac = AB[row * 16 + h], bc = AB[row * 16 + 8 + h];
            const float Aexp = expf(a.in[25][layer * 8 + h]), dtb = a.in[26][layer * 8 + h];
            *(LAS float*)(lds + GP_GRAW + 4 * t) = -Aexp * softplus(ac + dtb); *(LAS float*)(lds + GP_BETA + 4 * t) = sigm(bc); }
    }
    __syncthreads();
    if (w == 0) { float g = *(LAS float*)(lds + GP_GRAW + 4 * lane);
#pragma unroll
        for (int o = 1; o < 64; o <<= 1) { const float y = __shfl_up(g, o); if (lane >= o) g += y; }
        *(LAS float*)(lds + GP_GC + 4 * lane) = g; }
    __syncthreads();
    {
        const float gct = *(LAS float*)(lds + GP_GC + 4 * t), bt = *(LAS float*)(lds + GP_BETA + 4 * t), gl = *(LAS float*)(lds + GP_GC + 4 * 63);
        const float eg = expf(gct), egl = expf(gl - gct);
        float tq[8], tk[8], tb[8];
#pragma unroll
        for (int half = 0; half < 2; ++half) {
#pragma unroll
            for (int e = 0; e < 8; ++e) { tq[e] = qv[8 * half + e]; tk[e] = kv[8 * half + e]; tb[e] = kv[8 * half + e] * bt; }
            *(LAS u32x4*)(lds + GP_QR + t * 272 + (16 * cg + 8 * half) * 2) = pack8(tq);
            *(LAS u32x4*)(lds + GP_KR + t * 272 + (16 * cg + 8 * half) * 2) = pack8(tk);
            *(LAS u32x4*)(lds + GP_KBR + t * 272 + (16 * cg + 8 * half) * 2) = pack8(tb);
        }
#pragma unroll
        for (int d = 0; d < 16; ++d) { const int rowd = 16 * cg + d;
            *(LAS bf16_t*)(lds + GP_VT + rowd * 144 + 2 * t) = (bf16_t)f2bf(vv[d] * bt);
            *(LAS bf16_t*)(lds + GP_KGT + rowd * 144 + 2 * t) = (bf16_t)f2bf(kv[d] * bt * eg);
            *(LAS bf16_t*)(lds + GP_KT2 + rowd * 144 + 2 * t) = (bf16_t)f2bf(kv[d] * egl); }
#pragma unroll
        for (int hq = 0; hq < 2; ++hq) { float o8[8];
#pragma unroll
            for (int j = 0; j < 8; ++j) o8[j] = qv[8 * (j >> 2) + 4 * hq + (j & 3)] * eg;
            *(u32x4*)(gc + GC_QG + ((((t >> 5) * 4 + (cg >> 1)) * 2 + (cg & 1)) * 64 + (t & 31) + 32 * hq) * 16) = pack8(o8); }
        if (tid == 0) *(float*)(gc + GC_GAMMA) = expf(gl);
    }
    __syncthreads();
    {
        const int typ = w >> 2, mi = (w >> 1) & 1, nj = w & 1;
        f32x16 acc;
#pragma unroll
        for (int r = 0; r < 16; ++r) acc[r] = 0.f;
        if (!(mi == 0 && nj == 1)) {
            const LAS unsigned char* Ab = lds + (typ ? GP_QR : GP_KBR) + (32 * mi + l31) * 272 + 16 * hh;
            const LAS unsigned char* Bb = lds + GP_KR + (32 * nj + l31) * 272 + 16 * hh;
#pragma unroll
            for (int ks = 0; ks < 8; ++ks) acc = MFMA32(*(const LAS bf16x8*)(Ab + 32 * ks), *(const LAS bf16x8*)(Bb + 32 * ks), acc);
        }
        const int j = 32 * nj + l31; const float gcj = *(LAS float*)(lds + GP_GC + 4 * j);
#pragma unroll
        for (int r = 0; r < 16; ++r) { const int i = 32 * mi + (r & 3) + 8 * (r >> 2) + 4 * hh;
            const float gci = *(LAS float*)(lds + GP_GC + 4 * i);
            const float d = (i >= j) ? expf(gci - gcj) : 0.f;
            if (typ == 0) *(LAS float*)(lds + GP_LM + i * 272 + 4 * j) = (i > j) ? acc[r] * d : 0.f;
            else *(LAS bf16_t*)(lds + GP_AS + i * 144 + 2 * j) = (bf16_t)f2bf((i >= j) ? acc[r] * d : 0.f); }
    }
    __syncthreads();
    if (w == 0) {
        float x[64];
#pragma unroll
        for (int i = 0; i < 64; ++i) {
            float s0 = (i == lane) ? 1.f : 0.f, s1 = 0.f;
#pragma unroll
            for (int j4 = 0; j4 < (i + 3) / 4; ++j4) { const f32x4 l4 = *(const LAS f32x4*)(lds + GP_LM + i * 272 + 16 * j4);
#pragma unroll
                for (int e = 0; e < 4; ++e) { const int j = 4 * j4 + e; if (j < i) { if (e & 1) s1 -= l4[e] * x[j]; else s0 -= l4[e] * x[j]; } } }
            x[i] = s0 + s1;
        }
#pragma unroll
        for (int i = 0; i < 64; ++i) *(LAS bf16_t*)(lds + GP_TM + i * 144 + 2 * lane) = (bf16_t)f2bf(x[i]);
    } else {
        for (int task = tid - 64; task < 1536; task += 448) {
            const int ll = task & 63, hq = ll >> 5;
            if (task < 1024) { const int f = task >> 6, db = f >> 2, tb = (f >> 1) & 1, s = f & 1, dk = 32 * db + (ll & 31), t0 = 32 * tb + 16 * s + 4 * hq;
                const u32x2 lo = *(const LAS u32x2*)(lds + GP_KT2 + dk * 144 + 2 * t0), hi = *(const LAS u32x2*)(lds + GP_KT2 + dk * 144 + 2 * (t0 + 8));
                *(u32x4*)(gc + GC_KG + (f * 64 + ll) * 16) = (u32x4){lo.x, lo.y, hi.x, hi.y}; }
            else { const int f = (task - 1024) >> 6, mb = f >> 2, tb = (f >> 1) & 1, s = f & 1, i = 32 * mb + (ll & 31), j0 = 32 * tb + 16 * s + 4 * hq;
                const u32x2 lo = *(const LAS u32x2*)(lds + GP_AS + i * 144 + 2 * j0), hi = *(const LAS u32x2*)(lds + GP_AS + i * 144 + 2 * (j0 + 8));
                *(u32x4*)(gc + GC_AT + (f * 64 + ll) * 16) = (u32x4){lo.x, lo.y, hi.x, hi.y}; }
        }
    }
    __syncthreads();
    {
        const LAS unsigned char* Bb = lds + (w < 4 ? GP_VT : GP_KGT) + (32 * (w & 3) + l31) * 144 + 16 * hh;
#pragma unroll
        for (int mb = 0; mb < 2; ++mb) {
            f32x16 acc;
#pragma unroll
            for (int r = 0; r < 16; ++r) acc[r] = 0.f;
            const LAS unsigned char* Ab = lds + GP_TM + (32 * mb + l31) * 144 + 16 * hh;
#pragma unroll
            for (int ks = 0; ks < 4; ++ks) acc = MFMA32(*(const LAS bf16x8*)(Ab + 32 * ks), *(const LAS bf16x8*)(Bb + 32 * ks), acc);
            if (w < 4) { unsigned* up = (unsigned*)(gc + GC_U) + ((w * 2 + mb) * 8) * 64 + lane;
#pragma unroll
                for (int q = 0; q < 8; ++q) up[q * 64] = pk2(acc[2 * q], acc[2 * q + 1]); }
            else {
#pragma unroll
                for (int r = 0; r < 16; ++r) { const int tt = 32 * mb + (r & 3) + 8 * (r >> 2) + 4 * hh;
                    *(LAS bf16_t*)(lds + GP_WST + tt * 272 + 2 * (32 * (w - 4) + l31)) = (bf16_t)f2bf(-acc[r]); } }
        }
    }
    __syncthreads();
#pragma unroll
    for (int q = 0; q < 2; ++q) { const int task = tid + 512 * q, f = task >> 6, ll = task & 63, hq = ll >> 5, mb = f >> 3, kb = (f >> 1) & 3, s = f & 1;
        const int tt = 32 * mb + (ll & 31), d0 = 32 * kb + 16 * s + 4 * hq;
        const u32x2 lo = *(const LAS u32x2*)(lds + GP_WST + tt * 272 + 2 * d0), hi = *(const LAS u32x2*)(lds + GP_WST + tt * 272 + 2 * (d0 + 8));
        *(u32x4*)(gc + GC_WN + (f * 64 + ll) * 16) = (u32x4){lo.x, lo.y, hi.x, hi.y}; }
}

__device__ __forceinline__ bf16x8 cvt_frag(const f32x16& v, int s) {
    u32x4 w; w.x = pk2(v[8 * s], v[8 * s + 1]); w.y = pk2(v[8 * s + 2], v[8 * s + 3]); w.z = pk2(v[8 * s + 4], v[8 * s + 5]); w.w = pk2(v[8 * s + 6], v[8 * s + 7]);
    return __builtin_bit_cast(bf16x8, w);
}
constexpr int CH_OB = 2 * GC_OPS;
#define CH_LOAD(dst, cidx) do { const unsigned char* _s = gcb + (size_t)(cidx) * GC_STRIDE + lt * 16; _Pragma("unroll") for (int _i = 0; _i < 14; ++_i) dst[_i] = *(const u32x4*)(_s + _i * 4096); } while (0)
#define CH_WRITE(src, bufi) do { LAS unsigned char* _d = lds + (bufi) * GC_OPS + lt * 16; _Pragma("unroll") for (int _i = 0; _i < 14; ++_i) *(LAS u32x4*)(_d + _i * 4096) = src[_i]; } while (0)
#define CH_GATE(dst, cidx) do { const bf16_t* _g = P + (size_t)(b * 2048 + (cidx) * 64 + (lt >> 4) * 4) * NP + C_GATEC + h * 128 + (lt & 15) * 8; _Pragma("unroll") for (int _q = 0; _q < 4; ++_q) dst[_q] = *(const u32x4*)(_g + (size_t)_q * NP); } while (0)
#define CH_ULOAD(dst, cidx) do { const unsigned* _u = (const unsigned*)(gcb + (size_t)(cidx) * GC_STRIDE + GC_U) + (w * 2 * 8) * 64 + lane; \
    _Pragma("unroll") for (int _m = 0; _m < 2; ++_m) _Pragma("unroll") for (int _q = 0; _q < 8; ++_q) dst[_m][_q] = _u[(_m * 8 + _q) * 64]; } while (0)
__device__ __forceinline__ void gdn_chain(int layer, int bh, const int tid) {
    CArgs& a = kargs(); LAS unsigned char* lds = lds_base();
    const int lane = tid & 63, w = __builtin_amdgcn_readfirstlane(tid >> 6), hh = lane >> 5, l31 = lane & 31;
    const int b = bh >> 3, h = bh & 7;
    const unsigned char* gcb = a.ws + WS_GC + (size_t)bh * 32 * GC_STRIDE;
    __syncthreads();
    if (w >= 4) {
        const int lt = tid - 256;
        const bf16_t* P = (const bf16_t*)(a.ws + WS_P); bf16_t* YC = (bf16_t*)(a.ws + WS_YC);
        float ngv[8]; { const float* ng = a.in[27] + layer * 128 + (lt & 15) * 8; const f32x4 n0 = *(const f32x4*)ng, n1 = *(const f32x4*)(ng + 4);
#pragma unroll
            for (int e = 0; e < 4; ++e) { ngv[e] = n0[e]; ngv[4 + e] = n1[e]; } }
        u32x4 ra[14], rb[14], gt[4];
        CH_LOAD(ra, 0); CH_LOAD(rb, 1);
        CH_WRITE(ra, 0);
        CH_LOAD(ra, 2);
        CH_GATE(gt, 0);
        __syncthreads();
#define CH_FINISH(cc) do { const int t0 = (lt >> 4) * 4, dg = lt & 15; \
            _Pragma("unroll") for (int q = 0; q < 4; ++q) { float t8[8], g8[8], o8[8]; \
                unpack8(*(const LAS u32x4*)(lds + CH_OB + ((cc) & 1) * 16384 + (t0 + q) * 256 + dg * 16), t8); unpack8(gt[q], g8); float ss = 0.f; \
                _Pragma("unroll") for (int e = 0; e < 8; ++e) ss += t8[e] * t8[e]; \
                ss += __shfl_xor(ss, 1); ss += __shfl_xor(ss, 2); ss += __shfl_xor(ss, 4); ss += __shfl_xor(ss, 8); \
                const float r = 1.f / sqrtf(ss * (1.f / 128.f) + 1e-6f); \
                _Pragma("unroll") for (int e = 0; e < 8; ++e) o8[e] = t8[e] * r * ngv[e] * silu(g8[e]); \
                *(u32x4*)(YC + (size_t)(b * 2048 + (cc) * 64 + t0 + q) * 1024 + h * 128 + dg * 8) = pack8(o8); } } while (0)
        for (int c = 0; c < 32; c += 2) {
            if (c >= 1) { CH_FINISH(c - 1); CH_GATE(gt, c); }
            CH_WRITE(rb, 1);
            if (c + 3 < 32) CH_LOAD(rb, c + 3);
            __syncthreads();
            CH_FINISH(c); CH_GATE(gt, c + 1);
            if (c + 2 < 32) { CH_WRITE(ra, 0); }
            if (c + 4 < 32) CH_LOAD(ra, c + 4);
            __syncthreads();
        }
        CH_FINISH(31);
    } else {
        f32x16 S[4];
#pragma unroll
        for (int kb = 0; kb < 4; ++kb)
#pragma unroll
            for (int r = 0; r < 16; ++r) S[kb][r] = 0.f;
        const float gam_all = (lane < 32) ? *(const float*)(gcb + (size_t)lane * GC_STRIDE + GC_GAMMA) : 0.f;
        unsigned ua[2][8], ub[2][8];
        CH_ULOAD(ua, 0); CH_ULOAD(ub, 1);
        __syncthreads();
#define CH_STEP(c, ucur) do { \
            const LAS unsigned char* ops = lds + ((c) & 1) * GC_OPS + lane * 16; \
            const float gamma = __shfl(gam_all, (c)); \
            f32x16 va[2], oa[2]; \
            _Pragma("unroll") for (int mb = 0; mb < 2; ++mb) _Pragma("unroll") for (int q = 0; q < 8; ++q) { va[mb][2 * q] = bflo(ucur[mb][q]); va[mb][2 * q + 1] = bfhi(ucur[mb][q]); } \
            _Pragma("unroll") for (int r = 0; r < 16; ++r) { oa[0][r] = 0.f; oa[1][r] = 0.f; } \
            if ((c) + 2 < 32) CH_ULOAD(ucur, (c) + 2); \
            _Pragma("unroll") for (int kb = 0; kb < 4; ++kb) _Pragma("unroll") for (int s = 0; s < 2; ++s) { const bf16x8 Bs = cvt_frag(S[kb], s); \
                _Pragma("unroll") for (int mb = 0; mb < 2; ++mb) { const int f = (mb * 4 + kb) * 2 + s; \
                    va[mb] = MFMA32(*(const LAS bf16x8*)(ops + GC_WN + f * 1024), Bs, va[mb]); \
                    oa[mb] = MFMA32(*(const LAS bf16x8*)(ops + GC_QG + f * 1024), Bs, oa[mb]); } } \
            _Pragma("unroll") for (int kb = 0; kb < 4; ++kb) _Pragma("unroll") for (int r = 0; r < 16; ++r) S[kb][r] *= gamma; \
            _Pragma("unroll") for (int tb = 0; tb < 2; ++tb) _Pragma("unroll") for (int s = 0; s < 2; ++s) { const bf16x8 Bv = cvt_frag(va[tb], s); \
                _Pragma("unroll") for (int kb = 0; kb < 4; ++kb) S[kb] = MFMA32(*(const LAS bf16x8*)(ops + GC_KG + ((kb * 2 + tb) * 2 + s) * 1024), Bv, S[kb]); \
                _Pragma("unroll") for (int mb = 0; mb < 2; ++mb) if (mb >= tb) oa[mb] = MFMA32(*(const LAS bf16x8*)(ops + GC_AT + ((mb * 2 + tb) * 2 + s) * 1024), Bv, oa[mb]); } \
            LAS unsigned char* ob = lds + CH_OB + ((c) & 1) * 16384; \
            _Pragma("unroll") for (int mb = 0; mb < 2; ++mb) _Pragma("unroll") for (int r = 0; r < 16; ++r) { const int tt = 32 * mb + (r & 3) + 8 * (r >> 2) + 4 * hh; \
                *(LAS bf16_t*)(ob + tt * 256 + 2 * (32 * w + l31)) = (bf16_t)f2bf(oa[mb][r]); } \
            __syncthreads(); } while (0)
        for (int c = 0; c < 32; c += 2) { CH_STEP(c, ua); CH_STEP(c + 1, ub); }
        float* so = a.out + O_DP + (size_t)((layer * 4 + b) * 8 + h) * 128 * 128 + 32 * w + l31;
#pragma unroll
        for (int kb = 0; kb < 4; ++kb)
#pragma unroll
            for (int r = 0; r < 16; ++r) so[(size_t)(32 * kb + (r & 3) + 8 * (r >> 2) + 4 * hh) * 128] = S[kb][r];
    }
}

__device__ __forceinline__ void gdn_sample_item(int layer, int item, const int tid) {
    CArgs& a = kargs(); LAS unsigned char* lds = lds_base();
    const int lane = tid & 63, w = __builtin_amdgcn_readfirstlane(tid >> 6);
    const int b = item >> 3, h = item & 7, rbase = TP + b * 4;
    const bf16_t* P = (const bf16_t*)(a.ws + WS_P); const float* AB = (const float*)(a.ws + WS_AB); bf16_t* YC = (bf16_t*)(a.ws + WS_YC);
    LAS float* qs = (LAS float*)lds; LAS float* ks = qs + 512; LAS float* vs = ks + 512;
    LAS float* red = vs + 512;
    LAS float* dots = red + 4096; LAS float* gcv = dots + 32; LAS float* btv = gcv + 4; LAS float* ob = btv + 4;
    const int dv = (w & 1) * 64 + lane, sl = w >> 1, dk0 = sl * 32;
    float S[32];
    { const float* s0 = a.in[4] + ((size_t)((layer * 128 + b) * 8 + h) * 128 + dk0) * 128 + dv;
#pragma unroll
      for (int i = 0; i < 32; ++i) S[i] = s0[(size_t)i * 128]; }
    __syncthreads();
    {
        const float* convw = a.in[24] + (size_t)layer * 4 * 3072; const float* sconv = a.in[5] + (size_t)(layer * 128 + b) * 3 * 3072;
        float* co = a.out + O_CS + (size_t)(layer * 128 + b) * 3 * 3072;
#pragma unroll
        for (int it3 = 0; it3 < 3; ++it3) { const int idx = tid + 512 * it3;
            const int t = idx / 384, ch = idx - t * 384, sec = ch >> 7, cc = ch & 127, col = sec * 1024 + h * 128 + cc;
            float accv = 0.f;
#pragma unroll
            for (int j = 0; j < 4; ++j) { const int tt = t - 3 + j;
                const float xp = bf2f(P[(size_t)(rbase + (tt < 0 ? 0 : tt)) * NP + C_QKV + col]), xs = sconv[(tt < 0 ? 3 + tt : 2) * 3072 + col];
                const float x = (tt >= 0) ? xp : xs;
                if (j == 3 && t >= 1) co[(t - 1) * 3072 + col] = x;
                accv += convw[j * 3072 + col] * x; }
            LAS float* dst = sec == 0 ? qs : (sec == 1 ? ks : vs); dst[t * 128 + cc] = silu(accv);
        }
        if (tid < 4) { const size_t row = (size_t)(rbase + tid); const float ac = AB[row * 16 + h], bc = AB[row * 16 + 8 + h];
            gcv[tid] = -expf(a.in[25][layer * 8 + h]) * softplus(ac + a.in[26][layer * 8 + h]); btv[tid] = sigm(bc); }
    }
    __syncthreads();
    if (w < 4) { const int t = w;
        { const float q0 = qs[t * 128 + lane], q1 = qs[t * 128 + 64 + lane]; const float ss = wave_sum(q0 * q0 + q1 * q1);
          const float r = (1.f / sqrtf(ss + 1e-6f)) * 0.08838834764831845f; qs[t * 128 + lane] = q0 * r; qs[t * 128 + 64 + lane] = q1 * r; }
        { const float k0 = ks[t * 128 + lane], k1 = ks[t * 128 + 64 + lane]; const float ss = wave_sum(k0 * k0 + k1 * k1);
          const float r = 1.f / sqrtf(ss + 1e-6f); ks[t * 128 + lane] = k0 * r; ks[t * 128 + 64 + lane] = k1 * r; } }
    __syncthreads();
    {
#pragma unroll
        for (int q = 0; q < 4; ++q) { const int id = w * 4 + q, typ = id >> 4, i = (id >> 2) & 3, j = id & 3;
            const LAS float* xa = (typ ? qs : ks) + i * 128; const LAS float* xb = ks + j * 128;
            const float d = wave_sum(xa[lane] * xb[lane] + xa[64 + lane] * xb[64 + lane]);
            if (lane == 0) dots[id] = d; }
        float pk[4], pq[4];
#pragma unroll
        for (int j = 0; j < 4; ++j) { pk[j] = 0.f; pq[j] = 0.f; }
#pragma unroll
        for (int i = 0; i < 32; i += 4)
#pragma unroll
            for (int j = 0; j < 4; ++j) { const f32x4 kk = *(const LAS f32x4*)(ks + j * 128 + dk0 + i), qq = *(const LAS f32x4*)(qs + j * 128 + dk0 + i);
                pk[j] += kk[0] * S[i] + kk[1] * S[i + 1] + kk[2] * S[i + 2] + kk[3] * S[i + 3];
                pq[j] += qq[0] * S[i] + qq[1] * S[i + 1] + qq[2] * S[i + 2] + qq[3] * S[i + 3]; }
#pragma unroll
        for (int j = 0; j < 4; ++j) { red[(j * 4 + sl) * 128 + dv] = pk[j]; red[((4 + j) * 4 + sl) * 128 + dv] = pq[j]; }
    }
    __syncthreads();
    {
        float gc[4], bt[4];
        gc[0] = gcv[0]; gc[1] = gc[0] + gcv[1]; gc[2] = gc[1] + gcv[2]; gc[3] = gc[2] + gcv[3];
#pragma unroll
        for (int j = 0; j < 4; ++j) bt[j] = btv[j];
        float L[4][4], Tm[4][4];
#pragma unroll
        for (int i = 0; i < 4; ++i)
#pragma unroll
            for (int j = 0; j < 4; ++j) L[i][j] = (i > j) ? bt[i] * dots[i * 4 + j] * expf(gc[i] - gc[j]) : 0.f;
#pragma unroll
        for (int i = 0; i < 4; ++i)
#pragma unroll
            for (int c = 0; c < 4; ++c) { float s = (i == c) ? 1.f : 0.f;
#pragma unroll
                for (int j = 0; j < 4; ++j) if (j < i) s -= L[i][j] * Tm[j][c];
                Tm[i][c] = s; }
        float kS[4], qS[4], rhs[4], vn[4];
#pragma unroll
        for (int j = 0; j < 4; ++j) { kS[j] = (red[(j * 4 + 0) * 128 + dv] + red[(j * 4 + 1) * 128 + dv]) + (red[(j * 4 + 2) * 128 + dv] + red[(j * 4 + 3) * 128 + dv]);
            qS[j] = (red[((4 + j) * 4 + 0) * 128 + dv] + red[((4 + j) * 4 + 1) * 128 + dv]) + (red[((4 + j) * 4 + 2) * 128 + dv] + red[((4 + j) * 4 + 3) * 128 + dv]);
            rhs[j] = bt[j] * (vs[j * 128 + dv] - expf(gc[j]) * kS[j]); }
#pragma unroll
        for (int i = 0; i < 4; ++i) { float s = 0.f;
#pragma unroll
            for (int j = 0; j < 4; ++j) if (j <= i) s += Tm[i][j] * rhs[j];
            vn[i] = s; }
        if (sl == 0) {
#pragma unroll
            for (int i = 0; i < 4; ++i) { float o = expf(gc[i]) * qS[i];
#pragma unroll
                for (int j = 0; j < 4; ++j) if (j <= i) o += dots[16 + i * 4 + j] * expf(gc[i] - gc[j]) * vn[j];
                ob[i * 128 + dv] = o; } }
        const float gl = gc[3], egl = expf(gl);
        float cf[4];
#pragma unroll
        for (int j = 0; j < 4; ++j) cf[j] = expf(gl - gc[j]) * vn[j];
        float* so = a.out + O_DS + ((size_t)((layer * 128 + b) * 8 + h) * 128 + dk0) * 128 + dv;
#pragma unroll
        for (int i = 0; i < 32; ++i) { float s = egl * S[i];
#pragma unroll
            for (int j = 0; j < 4; ++j) s += ks[j * 128 + dk0 + i] * cf[j];
            so[(size_t)i * 128] = s; }
    }
    __syncthreads();
    if (w < 4) { const int t = w; const float* ng = a.in[27] + layer * 128;
        const float o0 = ob[t * 128 + lane], o1 = ob[t * 128 + 64 + lane]; const float ss = wave_sum(o0 * o0 + o1 * o1);
        const float r = 1.f / sqrtf(ss * (1.f / 128.f) + 1e-6f); const size_t row = (size_t)(rbase + t);
        const float g0 = bf2f(P[row * NP + C_GATEC + h * 128 + lane]), g1 = bf2f(P[row * NP + C_GATEC + h * 128 + 64 + lane]);
        YC[row * 1024 + h * 128 + lane] = (bf16_t)f2bf(o0 * r * ng[lane] * silu(g0));
        YC[row * 1024 + h * 128 + 64 + lane] = (bf16_t)f2bf(o1 * r * ng[64 + lane] * silu(g1)); }
}

#ifndef REP_ROLE
#define REP_ROLE -1
#endif
#define RR(x) for (int _rr = 0; _rr < ((REP_ROLE == (x)) ? 2 : 1); ++_rr)
__device__ __forceinline__ void phase_mixers(int layer, int G, int bid, int tid0) {
#ifndef PROBE_MIX
#define PROBE_MIX -1
#endif
#define PM(x) (PROBE_MIX == -1 || PROBE_MIX == (x))
    if (bid < 80) {
        const int tid = launder_v(tid0), lane = tid & 63, w = __builtin_amdgcn_readfirstlane(tid >> 6);
        if (w < 4) { const int it = launder_s(launder_s(bid) * 4 + w);
            if (it < 256) { if (PM(1)) RR(1) s5_item<false>(layer, it, w * S5_WLDS, lane); }
            else if (it < 320) { if (PM(2)) RR(2) s5_item<true>(layer, it - 256, w * S5_WLDS, lane); } }
        return;
    }
    const int nw = G - 80;
    for (int it0 = bid - 80; it0 < 1024 + 64 + 16 + 1024 + (REP_ROLE == 0 ? 1024 : 0); it0 += nw) {
        const int it = it0 >= 2128 ? it0 - 2128 : it0;
        const int tid = launder_v(tid0), lane = tid & 63, w = tid >> 6;
        if (it < 1024) { if (PM(0)) gdn_prep_item(layer, launder_s(it), tid); }
        else if (it < 1088) { if (PM(3)) RR(3) gmlp_prompt_item(layer, launder_s(it) - 1024, tid); }
        else if (it < 1104) { if (PM(4)) RR(4) gmlp_sample_item(layer, (launder_s(it) - 1088) * 8 + w, lane); }
        else { if (PM(5)) RR(5) gdn_sample_item(layer, launder_s(it) - 1104, tid); }
    }
}


#define XB_TMO      128
#define XB_XCNT(j)  (256  + 64 * (j))
#define XB_XSUB(j)  (1280 + 64 * (j))
#define XB_XGEN(j)  (2304 + 64 * (j))
#define XB_TOP      3328
#define XB_TOPGEN   3392
#define XCD_BAR_WORDS 3456
#define XB_SPIN_CAP (1u << 18)
__device__ __forceinline__ unsigned xb_ld(unsigned* p)              { return __hip_atomic_load(p, __ATOMIC_RELAXED, __HIP_MEMORY_SCOPE_AGENT); }
__device__ __forceinline__ unsigned xb_add(unsigned* p, unsigned v) { return __hip_atomic_fetch_add(p, v, __ATOMIC_RELAXED, __HIP_MEMORY_SCOPE_AGENT); }
__device__ __forceinline__ unsigned xb_xcc_id() { return (unsigned)__builtin_amdgcn_s_getreg((3 << 11) | 20) & 0xFu; }
#define XB_SPIN(cond, bar) do { unsigned _sp = 0; while (cond) { __builtin_amdgcn_s_sleep(1); \
    if ((++_sp & 255u) == 0u) { if (xb_ld(&(bar)[XB_TMO])) break; if (_sp > XB_SPIN_CAP) { atomicAdd(&(bar)[XB_TMO], 1u); break; } } } } while (0)
struct XcdBarrier { unsigned* bar; unsigned x; volatile LAS unsigned* st; };
__device__ __forceinline__ void xcd_barrier_complete(unsigned* bar, unsigned x, unsigned& nloc, unsigned& nx) {
    const unsigned G = gridDim.x * gridDim.y * gridDim.z;
    unsigned sum, cnt, mine, sp = 0u;
    for (;;) {
        sum = 0u; cnt = 0u; mine = 0u;
#pragma unroll
        for (unsigned j = 0; j < 16; ++j) { const unsigned c = xb_ld(&bar[XB_XCNT(j)]); sum += c; cnt += (c > 0u) ? 1u : 0u; mine = (j == x) ? c : mine; }
        if (sum == G) break;
        __builtin_amdgcn_s_sleep(1);
        if ((++sp & 255u) == 0u) { if (xb_ld(&bar[XB_TMO])) break; if (sp > XB_SPIN_CAP) { atomicAdd(&bar[XB_TMO], 1u); break; } }
    }
    nloc = mine > 0u ? mine : 1u; nx = cnt > 0u ? cnt : 1u;
}
__device__ __forceinline__ void xcd_barrier(const XcdBarrier& b) {
    asm volatile("s_waitcnt vmcnt(0)" ::: "memory");
    __syncthreads();
    if (threadIdx.x == 0) {
        unsigned* bar = b.bar;
        __builtin_amdgcn_s_waitcnt(0);
        unsigned nloc = b.st[0], nx = b.st[1];
        if (nloc == 0u) { xcd_barrier_complete(bar, b.x, nloc, nx); b.st[0] = nloc; b.st[1] = nx; }
        const unsigned old = xb_add(&bar[XB_XSUB(b.x)], 1u);
        const unsigned gen = old / nloc;
        if (old + 1u == (gen + 1u) * nloc) {
            __builtin_amdgcn_fence(__ATOMIC_RELEASE, "agent");
            asm volatile("s_waitcnt vmcnt(0)" ::: "memory");
            const unsigned og = xb_add(&bar[XB_TOP], 1u);
            const unsigned tg = og / nx;
            if (og + 1u == (tg + 1u) * nx) xb_add(&bar[XB_TOPGEN], 1u);
            else XB_SPIN(xb_ld(&bar[XB_TOPGEN]) == tg, bar);
            __builtin_amdgcn_fence(__ATOMIC_ACQUIRE, "agent");
            xb_add(&bar[XB_XGEN(b.x)], 1u);
            asm volatile("s_waitcnt vmcnt(0)" ::: "memory");
        } else {
            XB_SPIN(xb_ld(&bar[XB_XGEN(b.x)]) == gen, bar);
            __builtin_amdgcn_fence(__ATOMIC_ACQUIRE, "agent");
            asm volatile("s_waitcnt vmcnt(0)" ::: "memory");
        }
    }
    __syncthreads();
}

__global__ void __launch_bounds__(512, 2) mega(Args karg) {
    const int ph_lo = karg.ph_lo, ph_hi = karg.ph_hi;
    extern __shared__ __attribute__((aligned(16))) unsigned char lds_raw[];
    volatile LAS unsigned* bst = (volatile LAS unsigned*)((LAS unsigned char*)lds_raw + LDS_BARST);
#if MK_SINGLE
    if (threadIdx.x == 0) { bst[0] = 0u; bst[1] = 0u; }
    __syncthreads();
    if (threadIdx.x == 0) (void)xb_add((unsigned*)karg.ws + XB_XCNT(xb_xcc_id()), 1u);
#endif
#ifndef REP_SUB
#define REP_SUB -1
#endif
#ifndef REP_N
#define REP_N 2
#endif
    int rep = 0;
    for (int ph = ph_lo; ph < ph_hi; (REP_SUB >= 0 && ph >= 1 && (ph - 1) % 6 == REP_SUB && rep + 1 < REP_N) ? (void)++rep : (void)(rep = 0, ++ph)) {
        if (ph > ph_lo && rep == 0) { XcdBarrier xb; xb.bar = (unsigned*)kargs().ws; xb.x = xb_xcc_id(); xb.st = bst; xcd_barrier(xb); }
        const int G = launder_s((int)gridDim.x), bid = launder_s((int)blockIdx.x), tid = launder_v((int)threadIdx.x);
        CArgs& a = kargs(); LAS unsigned char* lds = lds_base();
        unsigned char* ws = a.ws;
#ifndef PROBE_SUB
#define PROBE_SUB -1
#endif
#define PS(x) (PROBE_SUB == -1 || PROBE_SUB == (x))
        if (ph == 0) { if (PS(6)) phase_convert(a, lds, G, bid, tid); continue; }
        const int layer = (ph - 1) / 6, sub = (ph - 1) % 6;
        unsigned char* wb = ws + WS_W0 + (size_t)layer * WS_WL;
        if (PS(0) && sub == 0) {
            pg8::Gemm g{(const bf16_t*)(ws + WS_XB), nullptr, nullptr, (const bf16_t*)(wb + WO_IN), nullptr, nullptr, DM};
            pg8::Sched S; S.init(MT / 256, NP / 256, 1, G, bid);
            pg8::Epi1 E{(bf16_t*)(ws + WS_P), (float*)(ws + WS_AB)};
            pg8::gemm_phase(lds, g, S, E, tid);
        } else if (PS(1) && sub == 1) {
            phase_mixers(layer, G, bid, tid);
        } else if (PS(2) && sub == 2) {
            if (bid < 32) { RR(6) gdn_chain(layer, bid, tid); }
            else {
            pg8::Gemm g{(const bf16_t*)(ws + WS_ZB), nullptr, nullptr, (const bf16_t*)(wb + WO_GLU), nullptr, nullptr, 1024};
            pg8::Sched S; S.init(MT / 256, 4, 1, G - 32, bid - 32);
            pg8::Epi2 E{(const bf16_t*)(ws + WS_ZB), (const bf16_t*)(ws + WS_P), a.in[17] + layer * 1024, (bf16_t*)(ws + WS_YA)};
            pg8::gemm_phase(lds, g, S, E, tid);
            }
        } else if (PS(3) && sub == 3) {
            pg8::Gemm g{(const bf16_t*)(ws + WS_YA), (const bf16_t*)(ws + WS_YB), (const bf16_t*)(ws + WS_YC),
                        (const bf16_t*)(wb + WO_PA), (const bf16_t*)(wb + WO_PB), (const bf16_t*)(wb + WO_PC), 1024};
            pg8::Sched S; S.init(MT / 256, 8, 3, G, bid);
            pg8::Epi3 E{(const bf16_t*)(ws + WS_P), a.in[7] + layer * 3 * DM, (float*)(ws + WS_M32), (bf16_t*)(ws + WS_MB)};
            pg8::gemm_phase(lds, g, S, E, tid);
        } else if (PS(4) && sub == 4) {
            pg8::Gemm g{(const bf16_t*)(ws + WS_MB), nullptr, nullptr, (const bf16_t*)(wb + WO_OUT), nullptr, nullptr, DM};
            pg8::Sched S; S.init(MT / 256, 8, 1, G, bid);
            const float* xp = layer == 0 ? a.in[0] : (const float*)(ws + WS_X32);
            const float* xs = layer == 0 ? a.in[1] : (const float*)(ws + WS_X32) + (size_t)TP * DM;
            pg8::Epi4 E{xp, xs, (float*)(ws + WS_H32)};
            pg8::gemm_phase(lds, g, S, E, tid);
        } else if (PS(5) && sub == 5) {
            phase_ln(a, layer, G, bid, tid);
        }
    }
}

extern "C" void kernel_launch(void* const* d_in, const int* in_sizes, int n_in, void* d_out, int out_size, void* d_ws, size_t ws_size, hipStream_t stream) {
    static int grid = 0;
    if (grid == 0) {
        if (n_in != 32 || (size_t)out_size != O_END || ws_size < WS_END) {
            fprintf(stderr, "kernel_launch: unexpected problem: n_in %d out %d ws %zu (need %zu)\n", n_in, out_size, ws_size, (size_t)WS_END); grid = -1; return; }
        int dev = 0, cus = 0, per_cu = 0;
        if (hipGetDevice(&dev) != hipSuccess || hipDeviceGetAttribute(&cus, hipDeviceAttributeMultiprocessorCount, dev) != hipSuccess) { grid = -1; return; }
        if (hipFuncSetAttribute((const void*)mega, hipFuncAttributeMaxDynamicSharedMemorySize, LDS_BYTES) != hipSuccess) { fprintf(stderr, "kernel_launch: hipFuncSetAttribute failed\n"); grid = -1; return; }
        if (hipOccupancyMaxActiveBlocksPerMultiprocessor(&per_cu, (const void*)mega, 512, LDS_BYTES) != hipSuccess || per_cu < 1) {
            fprintf(stderr, "kernel_launch: occupancy query says %d blocks per CU\n", per_cu); (void)hipGetLastError(); grid = -1; return; }
        grid = cus;
    }
    if (grid < 0) return;
    Args a{};
    for (int i = 0; i < 32; ++i) a.in[i] = (const float*)d_in[i];
    a.out = (float*)d_out; a.ws = (unsigned char*)d_ws;
#if MK_SINGLE
    a.ph_lo = 0; a.ph_hi = NPHASE;
    if (hipMemsetAsync(d_ws, 0, 16384, stream) != hipSuccess) { fprintf(stderr, "kernel_launch: memset of the barrier words failed\n"); return; }
    hipLaunchKernelGGL(mega, dim3(grid), dim3(512), LDS_BYTES, stream, a);
#else
    for (int ph = 0; ph < NPHASE; ++ph) {
        a.ph_lo = ph; a.ph_hi = ph + 1;
        hipLaunchKernelGGL(mega, dim3(grid), dim3(512), LDS_BYTES, stream, a);
    }
#endif
}
```

```cpp
#include <hip/hip_runtime.h>
#include <hip/hip_cooperative_groups.h>
#include <cstdio>
#include <cstdint>
namespace cg = cooperative_groups;

#ifndef MK_SINGLE
#define MK_SINGLE 1
#endif

#define LAS __attribute__((address_space(3)))
typedef unsigned short bf16_t;
typedef short bf16x8 __attribute__((ext_vector_type(8)));
typedef float f32x4 __attribute__((ext_vector_type(4)));
typedef float f32x2 __attribute__((ext_vector_type(2)));
typedef float f32x16 __attribute__((ext_vector_type(16)));
typedef unsigned u32x4 __attribute__((ext_vector_type(4)));
typedef unsigned u32x2 __attribute__((ext_vector_type(2)));

constexpr int DM = 2048, TP = 8192, TS = 512, MT = TP + TS;
constexpr int NIN = 15376, NP = 15616;
constexpr int C_XA = 0, C_GA = 1024, C_UB = 2048, C_VB = 3072, C_GB = 4096, C_QKV = 5120, C_GATEC = 8192, C_ZG = 9216, C_AB = 15360;
constexpr int NPHASE = 13;
constexpr float ALPHA = 1.41421356237f;

constexpr size_t MiB = 1u << 20;
constexpr size_t WS_CTL = 0;
constexpr size_t WS_W0 = 1 * MiB, WS_WL = 83 * MiB;
constexpr size_t WO_IN = 0, WO_GLU = 61 * MiB, WO_PA = 63 * MiB, WO_PB = 67 * MiB, WO_PC = 71 * MiB, WO_OUT = 75 * MiB;
constexpr size_t WS_XB = 167 * MiB, WS_P = 201 * MiB, WS_AB = 461 * MiB, WS_ZB = 462 * MiB, WS_YA = 479 * MiB, WS_YB = 496 * MiB, WS_YC = 513 * MiB;
constexpr size_t WS_M32 = 530 * MiB, WS_MB = 598 * MiB, WS_H32 = 632 * MiB, WS_X32 = 700 * MiB, WS_END = 768 * MiB;

constexpr size_t O_YP = 0, O_YS = 16777216, O_SRP = 17825792, O_SIP = 17858560, O_DP = 17891328, O_CP = 18939904,
                 O_SRS = 19013632, O_SIS = 20062208, O_DS = 21110784, O_CS = 54665216, O_GV = 57024512, O_END = 58073088;

constexpr int LDS_BYTES = 147456 + 256, LDS_BARST = 147456;

struct Args { const float* in[32]; float* out; unsigned char* ws; int ph_lo, ph_hi; };
typedef const __attribute__((address_space(4))) Args CArgs;

__device__ __forceinline__ unsigned f2bf(float f) { unsigned u = __builtin_bit_cast(unsigned, f); return (u + 0x7fffu + ((u >> 16) & 1u)) >> 16; }
__device__ __forceinline__ unsigned pk2(float lo, float hi) { return f2bf(lo) | (f2bf(hi) << 16); }
__device__ __forceinline__ float bf2f(unsigned short h) { return __builtin_bit_cast(float, (unsigned)h << 16); }
__device__ __forceinline__ float bflo(unsigned w) { return __builtin_bit_cast(float, w << 16); }
__device__ __forceinline__ float bfhi(unsigned w) { return __builtin_bit_cast(float, w & 0xffff0000u); }
__device__ __forceinline__ float sigm(float x) { return 1.f / (1.f + __expf(-x)); }
__device__ __forceinline__ float silu(float x) { return x / (1.f + __expf(-x)); }
__device__ __forceinline__ float gelu_tanh(float x) { return x * sigm(1.5957691216f * (x + 0.044715f * x * x * x)); }
__device__ __forceinline__ float softplus(float x) { return x > 20.f ? x : log1pf(expf(x)); }
__device__ __forceinline__ float wave_sum(float v) {
#pragma unroll
    for (int o = 1; o < 64; o <<= 1) v += __shfl_xor(v, o);
    return v;
}
__device__ __forceinline__ void unpack8(const u32x4 w, float (&f)[8]) {
    f[0] = bflo(w.x); f[1] = bfhi(w.x); f[2] = bflo(w.y); f[3] = bfhi(w.y); f[4] = bflo(w.z); f[5] = bfhi(w.z); f[6] = bflo(w.w); f[7] = bfhi(w.w);
}
__device__ __forceinline__ u32x4 pack8(const float (&f)[8]) { u32x4 w; w.x = pk2(f[0], f[1]); w.y = pk2(f[2], f[3]); w.z = pk2(f[4], f[5]); w.w = pk2(f[6], f[7]); return w; }
#define LDS_WAIT() asm volatile("s_waitcnt lgkmcnt(0)" ::: "memory")
__device__ __forceinline__ int launder_v(int x) { asm volatile("" : "+v"(x)); return x; }
__device__ __forceinline__ int launder_s(int x) { asm volatile("" : "+s"(x)); return x; }
__device__ __forceinline__ CArgs& kargs() { int z; asm volatile("s_mov_b32 %0, 0" : "=s"(z));
    return *(CArgs*)((const __attribute__((address_space(4))) char*)__builtin_amdgcn_kernarg_segment_ptr() + z); }
__device__ __forceinline__ LAS unsigned char* lds_base() { extern __shared__ __attribute__((aligned(16))) unsigned char lds_raw[]; int z; asm volatile("s_mov_b32 %0, 0" : "=s"(z));
    return (LAS unsigned char*)lds_raw + z; }

namespace pg8 {
constexpr int BM = 256, BK = 64, HALF = 128, HTB = HALF * BK * 2, STAGE_BYTES = 8 * HTB, NXCD = 8, WGM = 8;
__device__ __forceinline__ int lds_byte(int r, int c) { const int st = (r >> 4) * 2 + (c >> 5), rr = r & 15, cc = c & 31, ob = rr * 64 + cc * 2; return st * 1024 + (ob ^ (((ob >> 9) & 1) << 5)); }
__device__ __forceinline__ void stage_rc(int b, int& R, int& C) { const int st = b / 1024, sb = b % 1024, swz = sb ^ (((sb >> 9) & 1) << 5); R = (st >> 1) * 16 + swz / 64; C = (st & 1) * 32 + (swz % 64) / 2; }
__device__ __forceinline__ int perm32(int rho) { const int n = rho >> 4, i = rho & 15; return 8 * (i >> 2) + 4 * n + (i & 3); }

struct Unit { int pm, pn, br; };
struct Gemm { const bf16_t* A0; const bf16_t* A1; const bf16_t* A2; const bf16_t* B0; const bf16_t* B1; const bf16_t* B2; int K; };

struct Sched {
    int nM, nN, nbr, nwg, G, c;
    __device__ __forceinline__ void init(int nM_, int nN_, int nbr_, int G_, int c_) { nM = nM_; nN = nN_; nbr = nbr_; nwg = nM * nN; G = G_; c = c_; }
    __device__ __forceinline__ bool next(int i, Unit& u) const {
        const int ti = i / nbr; u.br = i - ti * nbr;
        const long L = (long)ti * G + c; if (L >= nwg) return false;
        int wgid = (int)L; { const int q = nwg / NXCD, r = nwg % NXCD, xcd = wgid % NXCD, off = wgid / NXCD; wgid = (xcd < r ? xcd * (q + 1) : r * (q + 1) + (xcd - r) * q) + off; }
        const int nig = WGM * nN, gid = wgid / nig, fm = gid * WGM, gsz = (nM - fm) < WGM ? (nM - fm) : WGM;
        u.pm = fm + ((wgid % nig) % gsz); u.pn = (wgid % nig) / gsz; return true;
    }
};

template <class Epi>
__device__ __forceinline__ void gemm_phase(LAS unsigned char* lds, const Gemm g, const Sched& S, const Epi& E, const int tid) {
    const int wid = __builtin_amdgcn_readfirstlane(tid >> 6), lane = tid & 63, wr = wid >> 2, wc = wid & 3, fr = lane & 15, fq = lane >> 4;
    const int K = g.K, nt = K / BK;
    unsigned voffA[2], voffB[2];
#pragma unroll
    for (int i = 0; i < 2; ++i) { int R, C; stage_rc(tid * 16 + i * 8192, R, C); const int Rb = (R & ~31) + perm32(R & 31);
        voffA[i] = (unsigned)(R * K + C) * 2u; voffB[i] = (unsigned)(Rb * K + C) * 2u; }
    const size_t kstep = (size_t)(BK * 2);
    const size_t hstep = (size_t)HALF * K * 2;
    const size_t tstep = 2 * hstep;
    const unsigned ldsw = (unsigned)wid * 1024u;
    const int aoff = lds_byte(wr * 64 + fr, fq * 8), boff = lds_byte(wc * 32 + fr, fq * 8);
#define PG8_SA(b, h) (((b) * 2 + (h)) * HTB)
#define PG8_SB(b, h) ((4 + (b) * 2 + (h)) * HTB)
#define PG8_STAGE(bufoff, gbase, voff) do { _Pragma("unroll") for (int _i = 0; _i < 2; ++_i) \
        __builtin_amdgcn_global_load_lds((const unsigned*)((const char*)(gbase) + (voff)[_i]), (LAS unsigned*)(lds + (bufoff) + ldsw + _i * 8192), 16, 0, 0); } while (0)
#define PG8_LDA(dst, b, h) do { _Pragma("unroll") for (int m = 0; m < 4; ++m) _Pragma("unroll") for (int k = 0; k < 2; ++k) dst[m][k] = *(const LAS bf16x8*)(lds + PG8_SA(b, h) + aoff + m * 2048 + k * 1024); } while (0)
#define PG8_LDB(dst, b, h) do { _Pragma("unroll") for (int n = 0; n < 2; ++n) _Pragma("unroll") for (int k = 0; k < 2; ++k) dst[n][k] = *(const LAS bf16x8*)(lds + PG8_SB(b, h) + boff + n * 2048 + k * 1024); } while (0)
#define PG8_MMA(ai, bj, At, Bt) do { __builtin_amdgcn_s_setprio(1); _Pragma("unroll") for (int m = 0; m < 4; ++m) _Pragma("unroll") for (int n = 0; n < 2; ++n) _Pragma("unroll") for (int k = 0; k < 2; ++k) \
        acc[ai][bj][m][n] = __builtin_amdgcn_mfma_f32_16x16x32_bf16(Bt[n][k], At[m][k], acc[ai][bj][m][n], 0, 0, 0); __builtin_amdgcn_s_setprio(0); } while (0)
#define PG8_WAIT_V(n) asm volatile("s_waitcnt vmcnt(" #n ")" ::: "memory")
#define PG8_WAIT_L(n) asm volatile("s_waitcnt lgkmcnt(" #n ")" ::: "memory")
#define PG8_BAR __builtin_amdgcn_s_barrier()
#define PG8_SCHED __builtin_amdgcn_sched_barrier(0)
#define PG8_APTR(u) ((const char*)((u).br == 0 ? g.A0 : ((u).br == 1 ? g.A1 : g.A2)) + (size_t)(u).pm * tstep)
#define PG8_BPTR(u) ((const char*)((u).br == 0 ? g.B0 : ((u).br == 1 ? g.B1 : g.B2)) + (size_t)(u).pn * tstep)
    Unit cur, nxt; int ui = 0;
    if (!S.next(0, cur)) return;
    f32x4 acc[2][2][4][2];
#pragma unroll
    for (int a = 0; a < 2; ++a)
#pragma unroll
        for (int b = 0; b < 2; ++b)
#pragma unroll
            for (int m = 0; m < 4; ++m)
#pragma unroll
                for (int n = 0; n < 2; ++n) acc[a][b][m][n] = (f32x4){0.f, 0.f, 0.f, 0.f};
    bf16x8 At[4][2], B0[2][2], B1[2][2];
    const char* cA = PG8_APTR(cur); const char* cB = PG8_BPTR(cur);
    PG8_STAGE(PG8_SB(0, 0), cB, voffB); PG8_STAGE(PG8_SB(0, 1), cB + hstep, voffB); PG8_STAGE(PG8_SA(0, 0), cA, voffA); PG8_STAGE(PG8_SA(0, 1), cA + hstep, voffA);
    if (wr == 1) PG8_BAR;
    PG8_WAIT_V(2); PG8_BAR;
    PG8_STAGE(PG8_SB(1, 0), cB + kstep, voffB); PG8_STAGE(PG8_SA(1, 0), cA + kstep, voffA); PG8_STAGE(PG8_SB(1, 1), cB + hstep + kstep, voffB);
    PG8_WAIT_V(6); PG8_BAR;
    for (;;) {
        const bool has_next = S.next(ui + 1, nxt);
        const char* nA = has_next ? PG8_APTR(nxt) : cA; const char* nB = has_next ? PG8_BPTR(nxt) : cB;
        for (int t = 0; t < nt; t += 2) {
            const bool last = (t == nt - 2);
            const char* a1 = cA + (size_t)(t + 1) * kstep;
            const char* a2 = last ? nA : cA + (size_t)(t + 2) * kstep; const char* b2 = last ? nB : cB + (size_t)(t + 2) * kstep;
            const char* a3 = a2 + kstep; const char* b3 = b2 + kstep;
            PG8_LDB(B0, 0, 0); PG8_LDB(B1, 0, 1); PG8_SCHED; PG8_LDA(At, 0, 0); PG8_STAGE(PG8_SA(1, 1), a1 + hstep, voffA);
            PG8_WAIT_V(8); PG8_WAIT_L(0); PG8_BAR; PG8_MMA(0, 0, At, B0); PG8_MMA(0, 1, At, B1); PG8_BAR; PG8_SCHED;
            PG8_LDA(At, 0, 1); PG8_STAGE(PG8_SB(0, 0), b2, voffB); PG8_STAGE(PG8_SB(0, 1), b2 + hstep, voffB); PG8_STAGE(PG8_SA(0, 0), a2, voffA);
            PG8_WAIT_V(8); PG8_WAIT_L(0); PG8_BAR; PG8_MMA(1, 0, At, B0); PG8_MMA(1, 1, At, B1); PG8_BAR; PG8_SCHED;
            PG8_LDB(B0, 1, 0); PG8_LDB(B1, 1, 1); PG8_SCHED; PG8_LDA(At, 1, 0); PG8_STAGE(PG8_SA(0, 1), a2 + hstep, voffA);
            PG8_WAIT_V(8); PG8_WAIT_L(0); PG8_BAR; PG8_MMA(0, 0, At, B0); PG8_MMA(0, 1, At, B1); PG8_BAR; PG8_SCHED;
            PG8_LDA(At, 1, 1); PG8_STAGE(PG8_SB(1, 0), b3, voffB); PG8_STAGE(PG8_SB(1, 1), b3 + hstep, voffB); PG8_STAGE(PG8_SA(1, 0), a3, voffA);
            PG8_WAIT_V(8); PG8_WAIT_L(0); PG8_BAR; PG8_MMA(1, 0, At, B0); PG8_MMA(1, 1, At, B1); PG8_BAR; PG8_SCHED;
        }
        if (wr == 0) PG8_BAR;
        E(acc, cur, wr, wc, fr, fq);
        if (!has_next) break;
#pragma unroll
        for (int a = 0; a < 2; ++a)
#pragma unroll
            for (int b = 0; b < 2; ++b)
#pragma unroll
                for (int m = 0; m < 4; ++m)
#pragma unroll
                    for (int n = 0; n < 2; ++n) acc[a][b][m][n] = (f32x4){0.f, 0.f, 0.f, 0.f};
        cur = nxt; cA = nA; cB = nB; ++ui;
        if (wr == 1) PG8_BAR;
    }
    PG8_WAIT_V(0);
    PG8_BAR;
#undef PG8_SA
#undef PG8_SB
#undef PG8_STAGE
#undef PG8_LDA
#undef PG8_LDB
#undef PG8_MMA
#undef PG8_WAIT_V
#undef PG8_WAIT_L
#undef PG8_BAR
#undef PG8_SCHED
#undef PG8_APTR
#undef PG8_BPTR
}

struct Epi1 {
    bf16_t* P; float* AB;
    __device__ __forceinline__ void operator()(const f32x4 (&acc)[2][2][4][2], const Unit& u, int wr, int wc, int fr, int fq) const {
        const int row0 = u.pm * BM + wr * 64 + fr, col0 = u.pn * BM + wc * 32 + 8 * fq;
#pragma unroll
        for (int ai = 0; ai < 2; ++ai)
#pragma unroll
            for (int m = 0; m < 4; ++m) { bf16_t* rowp = P + (size_t)(row0 + ai * HALF + m * 16) * NP + col0;
#pragma unroll
                for (int bj = 0; bj < 2; ++bj) { const f32x4 v0 = acc[ai][bj][m][0], v1 = acc[ai][bj][m][1];
                    u32x4 w; w.x = pk2(v0[0], v0[1]); w.y = pk2(v0[2], v0[3]); w.z = pk2(v1[0], v1[1]); w.w = pk2(v1[2], v1[3]);
                    *(u32x4*)(rowp + bj * HALF) = w; } }
        if (u.pn == 60 && wc == 0 && fq < 2) {
#pragma unroll
            for (int ai = 0; ai < 2; ++ai)
#pragma unroll
                for (int m = 0; m < 4; ++m) { float* ab = AB + (size_t)(row0 + ai * HALF + m * 16) * 16 + 8 * fq;
                    *(f32x4*)ab = acc[ai][0][m][0]; *(f32x4*)(ab + 4) = acc[ai][0][m][1]; }
        }
    }
};
struct Epi2 {
    const bf16_t* Zb; const bf16_t* P; const float* bglu; bf16_t* YA;
    __device__ __forceinline__ void operator()(const f32x4 (&acc)[2][2][4][2], const Unit& u, int wr, int wc, int fr, int fq) const {
        const int row0 = u.pm * BM + wr * 64 + fr, col0 = u.pn * BM + wc * 32 + 8 * fq;
#pragma unroll
        for (int bj = 0; bj < 2; ++bj) { const int col = col0 + bj * HALF;
            const f32x4 b0 = *(const f32x4*)(bglu + col), b1 = *(const f32x4*)(bglu + col + 4);
#pragma unroll
            for (int ai = 0; ai < 2; ++ai)
#pragma unroll
                for (int m = 0; m < 4; ++m) { const size_t row = (size_t)(row0 + ai * HALF + m * 16);
                    float z[8], ga[8], o[8];
                    unpack8(*(const u32x4*)(Zb + row * 1024 + col), z); unpack8(*(const u32x4*)(P + row * NP + C_GA + col), ga);
                    const f32x4 v0 = acc[ai][bj][m][0] + b0, v1 = acc[ai][bj][m][1] + b1;
#pragma unroll
                    for (int e = 0; e < 4; ++e) { o[e] = z[e] * sigm(v0[e]) * silu(ga[e]); o[4 + e] = z[4 + e] * sigm(v1[e]) * silu(ga[4 + e]); }
                    *(u32x4*)(YA + row * 1024 + col) = pack8(o); } }
    }
};
struct Epi3 {
    const bf16_t* P; const float* bgate; float* M32; bf16_t* Mb;
    __device__ __forceinline__ void operator()(const f32x4 (&acc)[2][2][4][2], const Unit& u, int wr, int wc, int fr, int fq) const {
        const int row0 = u.pm * BM + wr * 64 + fr, col0 = u.pn * BM + wc * 32 + 8 * fq, br = u.br;
#pragma unroll
        for (int bj = 0; bj < 2; ++bj) { const int col = col0 + bj * HALF;
            const f32x4 g0 = *(const f32x4*)(bgate + br * DM + col), g1 = *(const f32x4*)(bgate + br * DM + col + 4);
#pragma unroll
            for (int ai = 0; ai < 2; ++ai)
#pragma unroll
                for (int m = 0; m < 4; ++m) { const size_t row = (size_t)(row0 + ai * HALF + m * 16);
                    float zg[8], o[8];
                    unpack8(*(const u32x4*)(P + row * NP + C_ZG + br * DM + col), zg);
                    const f32x4 a0 = acc[ai][bj][m][0], a1 = acc[ai][bj][m][1];
#pragma unroll
                    for (int e = 0; e < 4; ++e) { o[e] = sigm(zg[e] + g0[e]) * a0[e]; o[4 + e] = sigm(zg[4 + e] + g1[e]) * a1[e]; }
                    float* mp = M32 + row * DM + col;
                    if (br > 0) { const f32x4 p0 = *(const f32x4*)mp, p1 = *(const f32x4*)(mp + 4);
#pragma unroll
                        for (int e = 0; e < 4; ++e) { o[e] += p0[e]; o[4 + e] += p1[e]; } }
                    if (br < 2) { *(f32x4*)mp = (f32x4){o[0], o[1], o[2], o[3]}; *(f32x4*)(mp + 4) = (f32x4){o[4], o[5], o[6], o[7]}; }
                    else *(u32x4*)(Mb + row * DM + col) = pack8(o); } }
    }
};
struct Epi4 {
    const float* xp; const float* xs; float* H32;
    __device__ __forceinline__ void operator()(const f32x4 (&acc)[2][2][4][2], const Unit& u, int wr, int wc, int fr, int fq) const {
        const int row0 = u.pm * BM + wr * 64 + fr, col0 = u.pn * BM + wc * 32 + 8 * fq;
        const float* xb = (u.pm < 32) ? xp : (xs - (size_t)TP * DM);
#pragma unroll
        for (int ai = 0; ai < 2; ++ai)
#pragma unroll
            for (int m = 0; m < 4; ++m) { const size_t row = (size_t)(row0 + ai * HALF + m * 16);
#pragma unroll
                for (int bj = 0; bj < 2; ++bj) { const int col = col0 + bj * HALF;
                    const f32x4 x0 = *(const f32x4*)(xb + row * DM + col), x1 = *(const f32x4*)(xb + row * DM + col + 4);
                    *(f32x4*)(H32 + row * DM + col) = x0 * ALPHA + acc[ai][bj][m][0];
                    *(f32x4*)(H32 + row * DM + col + 4) = x1 * ALPHA + acc[ai][bj][m][1]; } }
    }
};
}

template <bool REMAP>
__device__ __forceinline__ void transpose_item(const float* W, int K, int Nsrc, int Ndst, bf16_t* WT, LAS float* scr, int item, int lane) {
    const int nblk = Ndst / 32, kb = item / nblk, nb = item % nblk, k0 = 64 * kb, n0 = 32 * nb;
    int d = n0 + (lane & 31), s = d; bool valid = true;
    if (REMAP) { if (d < C_GATEC) s = d; else if (d < C_AB) s = d + 16; else if (d < C_AB + 16) s = 8192 + (d - C_AB); else { s = 0; valid = false; } }
#pragma unroll 8
    for (int i = 0; i < 32; ++i) { const int kk = 2 * i + (lane >> 5); scr[kk * 33 + (lane & 31)] = valid ? W[(size_t)(k0 + kk) * Nsrc + s] : 0.f; }
    LDS_WAIT();
    const int c = lane & 7;
#pragma unroll
    for (int j = 0; j < 4; ++j) { const int n = (lane >> 3) + 8 * j; const LAS float* sp = scr + (8 * c) * 33 + n;
        u32x4 o; o.x = pk2(sp[0 * 33], sp[1 * 33]); o.y = pk2(sp[2 * 33], sp[3 * 33]); o.z = pk2(sp[4 * 33], sp[5 * 33]); o.w = pk2(sp[6 * 33], sp[7 * 33]);
        *(u32x4*)(WT + (size_t)(n0 + n) * K + k0 + 8 * c) = o; }
    LDS_WAIT();
}

__device__ __forceinline__ void phase_convert(CArgs& a, LAS unsigned char* lds, int G, int vb, const int tid) {
    const int lane = tid & 63, wave = tid >> 6;
    LAS float* scr = (LAS float*)(lds + wave * 16384);
    const int gw = vb * 8 + wave, NGW = G * 8;
    constexpr int I_IN = (DM / 64) * (NP / 32), I_GLU = (1024 / 64) * (1024 / 32), I_P = (1024 / 64) * (DM / 32), I_OUT = (DM / 64) * (DM / 32);
    constexpr int I_L = I_IN + I_GLU + 3 * I_P + I_OUT;
    for (int it = gw; it < 2 * I_L; it += NGW) {
        const int l = it / I_L; int r = it - l * I_L;
        unsigned char* wb = a.ws + WS_W0 + (size_t)l * WS_WL;
        if (r < I_IN) { transpose_item<true>(a.in[6] + (size_t)l * DM * NIN, DM, NIN, NP, (bf16_t*)(wb + WO_IN), scr, r, lane); continue; } r -= I_IN;
        if (r < I_GLU) { transpose_item<false>(a.in[16] + (size_t)l * 1024 * 1024, 1024, 1024, 1024, (bf16_t*)(wb + WO_GLU), scr, r, lane); continue; } r -= I_GLU;
        if (r < I_P) { transpose_item<false>(a.in[18] + (size_t)l * 1024 * DM, 1024, DM, DM, (bf16_t*)(wb + WO_PA), scr, r, lane); continue; } r -= I_P;
        if (r < I_P) { transpose_item<false>(a.in[23] + (size_t)l * 1024 * DM, 1024, DM, DM, (bf16_t*)(wb + WO_PB), scr, r, lane); continue; } r -= I_P;
        if (r < I_P) { transpose_item<false>(a.in[28] + (size_t)l * 1024 * DM, 1024, DM, DM, (bf16_t*)(wb + WO_PC), scr, r, lane); continue; } r -= I_P;
        transpose_item<false>(a.in[29] + (size_t)l * DM * DM, DM, DM, DM, (bf16_t*)(wb + WO_OUT), scr, r, lane);
    }
    bf16_t* Xb = (bf16_t*)(a.ws + WS_XB);
    for (int m = gw; m < MT; m += NGW) {
        const float* xr = (m < TP) ? a.in[0] + (size_t)m * DM : a.in[1] + (size_t)(m - TP) * DM;
        const f32x4* xv = (const f32x4*)xr + lane; u32x2* o = (u32x2*)(Xb + (size_t)m * DM) + lane;
#pragma unroll
        for (int j = 0; j < 8; ++j) { const f32x4 v = xv[64 * j]; u32x2 w; w.x = pk2(v.x, v.y); w.y = pk2(v.z, v.w); o[64 * j] = w; }
    }
}

__device__ __forceinline__ void phase_ln(CArgs& a, int layer, int G, int vb, const int tid) {
    const int lane = tid & 63, wave = tid >> 6;
    const int gw = vb * 8 + wave, NGW = G * 8;
    const float* H32 = (const float*)(a.ws + WS_H32);
    const float* lg = a.in[30] + layer * DM; const float* lb = a.in[31] + layer * DM;
    bf16_t* Xb = (bf16_t*)(a.ws + WS_XB);
    for (int m = gw; m < MT; m += NGW) {
        const f32x4* xv = (const f32x4*)(H32 + (size_t)m * DM) + lane;
        f32x4 v[8]; float s = 0.f;
#pragma unroll
        for (int j = 0; j < 8; ++j) { v[j] = xv[64 * j]; s += (v[j].x + v[j].y) + (v[j].z + v[j].w); }
        const float mean = wave_sum(s) * (1.f / DM); float s2 = 0.f;
#pragma unroll
        for (int j = 0; j < 8; ++j) { v[j] = v[j] - mean; s2 += (v[j].x * v[j].x + v[j].y * v[j].y) + (v[j].z * v[j].z + v[j].w * v[j].w); }
        const float rstd = 1.f / sqrtf(wave_sum(s2) * (1.f / DM) + 1e-5f);
        float* dst = (layer == 0) ? (float*)(a.ws + WS_X32) + (size_t)m * DM : (m < TP ? a.out + O_YP + (size_t)m * DM : a.out + O_YS + (size_t)(m - TP) * DM);
#pragma unroll
        for (int j = 0; j < 8; ++j) { const f32x4 gg = *((const f32x4*)lg + lane + 64 * j), bb = *((const f32x4*)lb + lane + 64 * j);
            const f32x4 y = v[j] * rstd * gg + bb; *((f32x4*)dst + lane + 64 * j) = y;
            if (layer == 0) { u32x2 w; w.x = pk2(y.x, y.y); w.y = pk2(y.z, y.w); *((u32x2*)(Xb + (size_t)m * DM) + lane + 64 * j) = w; } }
    }
}

constexpr int S5_BUS = 128;
constexpr int S5_SROW = 272;
constexpr int S5_UB = 32 * S5_BUS * 4 + 32 * S5_SROW;
constexpr int S5_WLDS = S5_UB + 1024;
template <bool SAMPLE>
__device__ __forceinline__ void s5_item(int layer, int item, int wlo, int lane) {
    CArgs& a = kargs(); LAS unsigned char* wl = lds_base() + wlo;
    const int g = SAMPLE ? item : (item & 63), b = SAMPLE ? 0 : (item >> 6);
    const float* lam_re = a.in[8] + layer * 4096 + g * 64; const float* lam_im = a.in[9] + layer * 4096 + g * 64;
    const float dt = expf(a.in[10][layer * 64 + g]);
    const float* b_re = a.in[11] + (size_t)(layer * 64 + g) * 1024; const float* b_im = a.in[12] + (size_t)(layer * 64 + g) * 1024;
    const float* c_re = a.in[13] + (size_t)(layer * 64 + g) * 1024; const float* c_im = a.in[14] + (size_t)(layer * 64 + g) * 1024;
    const f32x4 dch = *(const f32x4*)(a.in[15] + layer * 1024 + g * 16 + 4 * (lane >> 4));
    const bf16_t* P = (const bf16_t*)(a.ws + WS_P); bf16_t* Zb = (bf16_t*)(a.ws + WS_ZB);
    LAS float* BU = (LAS float*)wl; LAS unsigned char* Sb = wl + 32 * S5_BUS * 4; LAS unsigned char* Ub = wl + S5_UB;
    float ar, ai;
    { const float lr = lam_re[lane], li = lam_im[lane]; const float mag = expf(lr * dt); float sn, cs; sincosf(li * dt, &sn, &cs); ar = mag * cs; ai = mag * sn; }
    bf16x8 Bf[4];
    { const int h = lane >> 5;
#pragma unroll
      for (int q = 0; q < 2; ++q) { const int pp = q * 32 + (lane & 31);
        const float lr = lam_re[pp], li = lam_im[pp]; const float mag = expf(lr * dt); float sn, cs; sincosf(li * dt, &sn, &cs);
        const float abr = mag * cs, abi = mag * sn, den = lr * lr + li * li, nr = abr - 1.f, ni = abi;
        const float f_r = (nr * lr + ni * li) / den, f_i = (ni * lr - nr * li) / den;
        float br8[8], bi8[8], or8[8], oi8[8];
        *(f32x4*)&br8[0] = *(const f32x4*)(b_re + pp * 16 + 8 * h); *(f32x4*)&br8[4] = *(const f32x4*)(b_re + pp * 16 + 8 * h + 4);
        *(f32x4*)&bi8[0] = *(const f32x4*)(b_im + pp * 16 + 8 * h); *(f32x4*)&bi8[4] = *(const f32x4*)(b_im + pp * 16 + 8 * h + 4);
#pragma unroll
        for (int e = 0; e < 8; ++e) { or8[e] = f_r * br8[e] - f_i * bi8[e]; oi8[e] = f_r * bi8[e] + f_i * br8[e]; }
        Bf[q] = __builtin_bit_cast(bf16x8, pack8(or8)); Bf[2 + q] = __builtin_bit_cast(bf16x8, pack8(oi8)); } }
    bf16x8 Cf[4];
    { const int c = lane & 15;
#pragma unroll
      for (int ks = 0; ks < 4; ++ks) { const int p0 = 16 * ks + 4 * (lane >> 4);
        const f32x4 cr = *(const f32x4*)(c_re + c * 64 + p0), ci = *(const f32x4*)(c_im + c * 64 + p0);
        float o[8] = {cr[0], -ci[0], cr[1], -ci[1], cr[2], -ci[2], cr[3], -ci[3]};
        Cf[ks] = __builtin_bit_cast(bf16x8, pack8(o)); } }
    float sr = 0.f, si = 0.f;
    const int nsc = SAMPLE ? 16 : 64;
    const float* h_re = a.in[2] + (size_t)layer * 128 * 4096 + g * 64 + lane; const float* h_im = a.in[3] + (size_t)layer * 128 * 4096 + g * 64 + lane;
    float* o_re = a.out + O_SRS + (size_t)layer * 128 * 4096 + g * 64 + lane; float* o_im = a.out + O_SIS + (size_t)layer * 128 * 4096 + g * 64 + lane;
    const bf16_t* up = P + (size_t)((SAMPLE ? TP : b * 2048) + (lane & 31)) * NP + C_XA + g * 16 + 8 * (lane >> 5);
    bf16x8 Af = *(const bf16x8*)up;
    float hr[8], hi[8];
    if (SAMPLE) {
#pragma unroll
        for (int q = 0; q < 8; ++q) { hr[q] = h_re[(size_t)q * 4096]; hi[q] = h_im[(size_t)q * 4096]; } }
    for (int sc = 0; sc < nsc; ++sc) {
        const int row0 = SAMPLE ? TP + sc * 32 : b * 2048 + sc * 32;
        const bf16x8 Ac = Af;
        float hcr[8], hci[8];
        if (SAMPLE) {
#pragma unroll
            for (int q = 0; q < 8; ++q) { hcr[q] = hr[q]; hci[q] = hi[q]; } }
        if (sc + 1 < nsc) { Af = *(const bf16x8*)(up + (size_t)(sc + 1) * 32 * NP);
            if (SAMPLE) {
#pragma unroll
                for (int q = 0; q < 8; ++q) { hr[q] = h_re[(size_t)((sc + 1) * 8 + q) * 4096]; hi[q] = h_im[(size_t)((sc + 1) * 8 + q) * 4096]; } } }
        *(LAS bf16x8*)(Ub + (lane & 31) * 32 + 16 * (lane >> 5)) = Ac;
#pragma unroll
        for (int nb = 0; nb < 4; ++nb) {
            f32x16 acc;
#pragma unroll
            for (int r = 0; r < 16; ++r) acc[r] = 0.f;
            acc = __builtin_amdgcn_mfma_f32_32x32x16_bf16(Ac, Bf[nb], acc, 0, 0, 0);
#pragma unroll
            for (int r = 0; r < 16; ++r) { const int t = (r & 3) + 8 * (r >> 2) + 4 * (lane >> 5); BU[t * S5_BUS + 32 * nb + (lane & 31)] = acc[r]; }
        }
        LDS_WAIT();
#pragma unroll
        for (int t = 0; t < 32; ++t) {
            if (SAMPLE && (t & 3) == 0) { sr = hcr[t >> 2]; si = hci[t >> 2]; }
            const float bur = BU[t * S5_BUS + lane], bui = BU[t * S5_BUS + 64 + lane];
            const float nsr = ar * sr - ai * si + bur, nsi = ar * si + ai * sr + bui;
            sr = nsr; si = nsi;
            *(LAS unsigned*)(Sb + t * S5_SROW + 4 * lane) = pk2(sr, si);
            if (SAMPLE && (t & 3) == 3) { const int bi = sc * 8 + (t >> 2); o_re[(size_t)bi * 4096] = sr; o_im[(size_t)bi * 4096] = si; }
        }
        LDS_WAIT();
#pragma unroll
        for (int mb = 0; mb < 2; ++mb) {
            f32x4 y = (f32x4){0.f, 0.f, 0.f, 0.f};
#pragma unroll
            for (int ks = 0; ks < 4; ++ks) { const bf16x8 Sf = *(const LAS bf16x8*)(Sb + (16 * mb + (lane & 15)) * S5_SROW + 64 * ks + 16 * (lane >> 4));
                y = __builtin_amdgcn_mfma_f32_16x16x32_bf16(Cf[ks], Sf, y, 0, 0, 0); }
            const int tt = 16 * mb + (lane & 15);
            const u32x2 xw = *(const LAS u32x2*)(Ub + tt * 32 + 8 * (lane >> 4));
            u32x2 o; o.x = pk2(gelu_tanh(y[0] + dch[0] * bflo(xw.x)), gelu_tanh(y[1] + dch[1] * bfhi(xw.x)));
            o.y = pk2(gelu_tanh(y[2] + dch[2] * bflo(xw.y)), gelu_tanh(y[3] + dch[3] * bfhi(xw.y)));
            *(u32x2*)(Zb + (size_t)(row0 + tt) * 1024 + g * 16 + 4 * (lane >> 4)) = o;
        }
        LDS_WAIT();
    }
    if (!SAMPLE) { a.out[O_SRP + (size_t)((layer * 4 + b) * 64 + g) * 64 + lane] = sr; a.out[O_SIP + (size_t)((layer * 4 + b) * 64 + g) * 64 + lane] = si; }
}

constexpr int GM_TROW = 80;
__device__ __forceinline__ void gmlp_prompt_item(int layer, int item, const int tid) {
    CArgs& a = kargs(); LAS unsigned char* lds = lds_base();
    const int lane = tid & 63, w = __builtin_amdgcn_readfirstlane(tid >> 6);
    const bf16_t* P = (const bf16_t*)(a.ws + WS_P); bf16_t* YB = (bf16_t*)(a.ws + WS_YB);
    const float* lng = a.in[19] + layer * 1024; const float* lnb = a.in[20] + layer * 1024;
    const int r0 = item * 128, g = w;
    LAS f32x2* stats = (LAS f32x2*)lds;
    LAS unsigned char* vt = lds + 1024 + w * (16 * GM_TROW);
    __syncthreads();
    {
#pragma unroll 1
        for (int hb = 0; hb < 2; ++hb) {
        u32x4 raw[8][2];
#pragma unroll
        for (int i = 0; i < 8; ++i) { const bf16_t* rp = P + (size_t)(r0 + 16 * w + 8 * hb + i) * NP + C_VB + lane * 16; raw[i][0] = *(const u32x4*)rp; raw[i][1] = *(const u32x4*)(rp + 8); }
#pragma unroll
        for (int i = 0; i < 8; ++i) { float x[16]; { float t8[8]; unpack8(raw[i][0], t8);
#pragma unroll
                for (int e = 0; e < 8; ++e) x[e] = t8[e];
                unpack8(raw[i][1], t8);
#pragma unroll
                for (int e = 0; e < 8; ++e) x[8 + e] = t8[e]; }
            float s = 0.f;
#pragma unroll
            for (int e = 0; e < 16; ++e) s += x[e];
            const float mean = wave_sum(s) * (1.f / 1024.f); float s2 = 0.f;
#pragma unroll
            for (int e = 0; e < 16; ++e) { const float d = x[e] - mean; s2 += d * d; }
            const float rstd = 1.f / sqrtf(wave_sum(s2) * (1.f / 1024.f) + 1e-5f);
            if (lane == 0) stats[16 * w + 8 * hb + i] = (f32x2){mean, rstd}; }
        }
    }
    __syncthreads();
    bf16x8 Wf[20];
    { const float* Ws = a.in[21] + (size_t)(layer * 8 + g) * 128 * 128;
#pragma unroll
      for (int kb = 0; kb < 4; ++kb)
#pragma unroll
        for (int ib = 2 * kb; ib < 8; ++ib) { const int fi = (kb == 0 ? 0 : kb == 1 ? 8 : kb == 2 ? 14 : 18) + ib - 2 * kb;
            const int i = 16 * ib + (lane & 15), j0 = 32 * kb + 8 * (lane >> 4);
            const f32x4 w0 = *(const f32x4*)(Ws + i * 128 + j0), w1 = *(const f32x4*)(Ws + i * 128 + j0 + 4);
            float wv[8];
#pragma unroll
            for (int e = 0; e < 8; ++e) { const float x = e < 4 ? w0[e & 3] : w1[e & 3]; wv[e] = (j0 + e <= i) ? x : 0.f; }
            Wf[fi] = __builtin_bit_cast(bf16x8, pack8(wv));
            if ((fi & 3) == 3) __builtin_amdgcn_sched_barrier(0); } }
    const float* bsp = a.in[22] + (size_t)(layer * 8 + g) * 128;
#pragma unroll 1
    for (int rnd = 0; rnd < 8; ++rnd) {
        const int cbase = g * 128 + rnd * 16;
        f32x4 acc[8];
#pragma unroll
        for (int ib = 0; ib < 8; ++ib) acc[ib] = (f32x4){0.f, 0.f, 0.f, 0.f};
        const int cg = lane & 1, j = lane >> 1;
        u32x4 raw[4];
#pragma unroll
        for (int kb = 0; kb < 4; ++kb) raw[kb] = *(const u32x4*)(P + (size_t)(r0 + 32 * kb + j) * NP + C_VB + cbase + cg * 8);
        const f32x4 g0 = *(const f32x4*)(lng + cbase + cg * 8), g1 = *(const f32x4*)(lng + cbase + cg * 8 + 4);
        const f32x4 b0 = *(const f32x4*)(lnb + cbase + cg * 8), b1 = *(const f32x4*)(lnb + cbase + cg * 8 + 4);
#pragma unroll
        for (int kb = 0; kb < 4; ++kb) {
            { float x[8]; unpack8(raw[kb], x);
              const f32x2 st = stats[32 * kb + j];
#pragma unroll
              for (int e = 0; e < 8; ++e) { const float gg = e < 4 ? g0[e & 3] : g1[e & 3], bb = e < 4 ? b0[e & 3] : b1[e & 3];
                  const float v = (x[e] - st.x) * st.y * gg + bb;
                  *(LAS bf16_t*)(vt + (cg * 8 + e) * GM_TROW + 2 * j) = (bf16_t)f2bf(v); } }
            LDS_WAIT();
            const bf16x8 Af = *(const LAS bf16x8*)(vt + (lane & 15) * GM_TROW + 16 * (lane >> 4));
#pragma unroll
            for (int ib = 2 * kb; ib < 8; ++ib) { const int fi = (kb == 0 ? 0 : kb == 1 ? 8 : kb == 2 ? 14 : 18) + ib - 2 * kb;
                acc[ib] = __builtin_amdgcn_mfma_f32_16x16x32_bf16(Af, Wf[fi], acc[ib], 0, 0, 0); }
            LDS_WAIT();
        }
#pragma unroll
        for (int ib = 0; ib < 8; ++ib) { const int i = 16 * ib + (lane & 15); const float bs = bsp[i]; const size_t row = (size_t)(r0 + i);
            const int ch = cbase + 4 * (lane >> 4);
            const u32x2 uw = *(const u32x2*)(P + row * NP + C_UB + ch), gw = *(const u32x2*)(P + row * NP + C_GB + ch);
            const f32x4 s = acc[ib] + bs;
            u32x2 o; o.x = pk2(bflo(uw.x) * s[0] * silu(bflo(gw.x)), bfhi(uw.x) * s[1] * silu(bfhi(gw.x)));
            o.y = pk2(bflo(uw.y) * s[2] * silu(bflo(gw.y)), bfhi(uw.y) * s[3] * silu(bfhi(gw.y)));
            *(u32x2*)(YB + row * 1024 + ch) = o; }
    }
}
__device__ __forceinline__ void gmlp_sample_item(int layer, int b, int lane) {
    CArgs& a = kargs();
    const bf16_t* P = (const bf16_t*)(a.ws + WS_P); bf16_t* YB = (bf16_t*)(a.ws + WS_YB);
    const float* lng = a.in[19] + layer * 1024 + lane * 16; const float* lnb = a.in[20] + layer * 1024 + lane * 16;
    const int g = lane >> 3;
    const float* Ws = a.in[21] + (size_t)(layer * 8 + g) * 128 * 128; const float* bsp = a.in[22] + (size_t)(layer * 8 + g) * 128;
    float vn[4][16];
#pragma unroll
    for (int t = 0; t < 4; ++t) { const size_t row = (size_t)(TP + b * 4 + t); const bf16_t* rp = P + row * NP + C_VB + lane * 16;
        float x[16]; { float t8[8]; unpack8(*(const u32x4*)rp, t8);
#pragma unroll
            for (int e = 0; e < 8; ++e) x[e] = t8[e];
            unpack8(*(const u32x4*)(rp + 8), t8);
#pragma unroll
            for (int e = 0; e < 8; ++e) x[8 + e] = t8[e]; }
        float s = 0.f;
#pragma unroll
        for (int e = 0; e < 16; ++e) s += x[e];
        const float mean = wave_sum(s) * (1.f / 1024.f); float s2 = 0.f;
#pragma unroll
        for (int e = 0; e < 16; ++e) { const float d = x[e] - mean; s2 += d * d; }
        const float rstd = 1.f / sqrtf(wave_sum(s2) * (1.f / 1024.f) + 1e-5f);
        float* ov = a.out + O_GV + ((size_t)(layer * 128 + b) * 4 + t) * 1024 + lane * 16;
#pragma unroll
        for (int e = 0; e < 16; ++e) vn[t][e] = (x[e] - mean) * rstd * lng[e] + lnb[e];
#pragma unroll
        for (int e = 0; e < 16; e += 4) *(f32x4*)(ov + e) = (f32x4){vn[t][e], vn[t][e + 1], vn[t][e + 2], vn[t][e + 3]}; }
#pragma unroll
    for (int i = 0; i < 4; ++i) { const size_t row = (size_t)(TP + b * 4 + i);
        float s[16]; const float bs = bsp[i];
#pragma unroll
        for (int e = 0; e < 16; ++e) s[e] = bs;
#pragma unroll
        for (int j = 0; j < 4; ++j) if (j <= i) { const float wv = Ws[i * 128 + j];
#pragma unroll
            for (int e = 0; e < 16; ++e) s[e] += wv * vn[j][e]; }
        float ub[16], gb[16];
        { float t8[8]; unpack8(*(const u32x4*)(P + row * NP + C_UB + lane * 16), t8);
#pragma unroll
          for (int e = 0; e < 8; ++e) ub[e] = t8[e];
          unpack8(*(const u32x4*)(P + row * NP + C_UB + lane * 16 + 8), t8);
#pragma unroll
          for (int e = 0; e < 8; ++e) ub[8 + e] = t8[e];
          unpack8(*(const u32x4*)(P + row * NP + C_GB + lane * 16), t8);
#pragma unroll
          for (int e = 0; e < 8; ++e) gb[e] = t8[e];
          unpack8(*(const u32x4*)(P + row * NP + C_GB + lane * 16 + 8), t8);
#pragma unroll
          for (int e = 0; e < 8; ++e) gb[8 + e] = t8[e]; }
        float o0[8], o1[8];
#pragma unroll
        for (int e = 0; e < 8; ++e) { o0[e] = ub[e] * s[e] * silu(gb[e]); o1[e] = ub[8 + e] * s[8 + e] * silu(gb[8 + e]); }
        *(u32x4*)(YB + row * 1024 + lane * 16) = pack8(o0); *(u32x4*)(YB + row * 1024 + lane * 16 + 8) = pack8(o1); }
}

template <bool SAMPLE>
__device__ __forceinline__ void gdn_item_v1(int layer, int item, const int tid) {
    CArgs& a = kargs(); LAS unsigned char* lds = lds_base();
    const int lane = tid & 63, w = tid >> 6;
    const int b = item >> 3, h = item & 7;
    const int T = SAMPLE ? 4 : 2048, rbase = SAMPLE ? TP + b * 4 : b * 2048, NB = SAMPLE ? 128 : 4;
    const bf16_t* P = (const bf16_t*)(a.ws + WS_P); const float* AB = (const float*)(a.ws + WS_AB); bf16_t* YC = (bf16_t*)(a.ws + WS_YC);
    const float* convw = a.in[24] + (size_t)layer * 4 * 3072;
    const float* sconv = a.in[5] + (size_t)(layer * 128 + b) * 3 * 3072;
    LAS float* qs = (LAS float*)lds; LAS float* ks = qs + 64 * 128; LAS float* vs = ks + 64 * 128;
    LAS float* red = vs + 64 * 128; LAS float* red2 = red + 512; LAS float* av = red2 + 512; LAS float* bv = av + 64;
    const int dv = (w & 1) * 64 + lane, sl = w >> 1, dk0 = sl * 32;
    float S[32];
    if (SAMPLE) { const float* s0 = a.in[4] + ((size_t)((layer * 128 + b) * 8 + h) * 128 + dk0) * 128 + dv;
#pragma unroll
        for (int i = 0; i < 32; ++i) S[i] = s0[(size_t)i * 128]; }
    else {
#pragma unroll
        for (int i = 0; i < 32; ++i) S[i] = 0.f; }
    const float Aexp = expf(a.in[25][layer * 8 + h]), dtb = a.in[26][layer * 8 + h];
    for (int c0 = 0; c0 < T; c0 += 64) {
        const int n = (T - c0) < 64 ? (T - c0) : 64;
        __syncthreads();
        for (int idx = tid; idx < n * 384; idx += 512) {
            const int t = idx / 384, ch = idx - t * 384, sec = ch >> 7, cc = ch & 127, col = sec * 1024 + h * 128 + cc, tg = c0 + t;
            float accv = 0.f;
#pragma unroll
            for (int j = 0; j < 4; ++j) { const int tt = tg - 3 + j; float x;
                if (tt >= 0) x = bf2f(P[(size_t)(rbase + tt) * NP + C_QKV + col]);
                else x = SAMPLE ? sconv[(3 + tt) * 3072 + col] : 0.f;
                accv += convw[j * 3072 + col] * x; }
            const float y = silu(accv);
            LAS float* dst = sec == 0 ? qs : (sec == 1 ? ks : vs); dst[t * 128 + cc] = y;
        }
        if (tid < n) { const size_t row = (size_t)(rbase + c0 + tid); const float ac = AB[row * 16 + h], bc = AB[row * 16 + 8 + h];
            const float gg = -Aexp * softplus(ac + dtb); av[tid] = expf(gg); bv[tid] = sigm(bc); }
        __syncthreads();
        for (int t = w; t < n; t += 8) {
            { const float q0 = qs[t * 128 + lane], q1 = qs[t * 128 + 64 + lane]; const float ss = wave_sum(q0 * q0 + q1 * q1);
              const float r = (1.f / sqrtf(ss + 1e-6f)) * 0.08838834764831845f; qs[t * 128 + lane] = q0 * r; qs[t * 128 + 64 + lane] = q1 * r; }
            { const float k0 = ks[t * 128 + lane], k1 = ks[t * 128 + 64 + lane]; const float ss = wave_sum(k0 * k0 + k1 * k1);
              const float r = 1.f / sqrtf(ss + 1e-6f); ks[t * 128 + lane] = k0 * r; ks[t * 128 + 64 + lane] = k1 * r; }
        }
        __syncthreads();
        for (int t = 0; t < n; ++t) {
            const float at = av[t], bt = bv[t];
            float p = 0.f;
#pragma unroll
            for (int i = 0; i < 32; i += 4) { const f32x4 kk = *(const LAS f32x4*)(ks + t * 128 + dk0 + i);
                p += kk[0] * S[i] + kk[1] * S[i + 1] + kk[2] * S[i + 2] + kk[3] * S[i + 3]; }
            red[sl * 128 + dv] = p;
            __syncthreads();
            const float kS = (red[dv] + red[128 + dv]) + (red[256 + dv] + red[384 + dv]);
            const float vnew = bt * (vs[t * 128 + dv] - at * kS);
            float po = 0.f;
#pragma unroll
            for (int i = 0; i < 32; i += 4) { const f32x4 kk = *(const LAS f32x4*)(ks + t * 128 + dk0 + i), qq = *(const LAS f32x4*)(qs + t * 128 + dk0 + i);
#pragma unroll
                for (int e = 0; e < 4; ++e) { S[i + e] = at * S[i + e] + kk[e] * vnew; po += qq[e] * S[i + e]; } }
            red2[sl * 128 + dv] = po;
            __syncthreads();
            if (sl == 0) vs[t * 128 + dv] = (red2[dv] + red2[128 + dv]) + (red2[256 + dv] + red2[384 + dv]);
        }
        __syncthreads();
        const float* ng = a.in[27] + layer * 128;
        for (int t = w; t < n; t += 8) {
            const float o0 = vs[t * 128 + lane], o1 = vs[t * 128 + 64 + lane]; const float ss = wave_sum(o0 * o0 + o1 * o1);
            const float r = 1.f / sqrtf(ss * (1.f / 128.f) + 1e-6f); const size_t row = (size_t)(rbase + c0 + t);
            const float g0 = bf2f(P[row * NP + C_GATEC + h * 128 + lane]), g1 = bf2f(P[row * NP + C_GATEC + h * 128 + 64 + lane]);
            YC[row * 1024 + h * 128 + lane] = (bf16_t)f2bf(o0 * r * ng[lane] * silu(g0));
            YC[row * 1024 + h * 128 + 64 + lane] = (bf16_t)f2bf(o1 * r * ng[64 + lane] * silu(g1));
        }
    }
    { float* so = a.out + (SAMPLE ? O_DS : O_DP) + ((size_t)((layer * NB + b) * 8 + h) * 128 + dk0) * 128 + dv;
#pragma unroll
      for (int i = 0; i < 32; ++i) so[(size_t)i * 128] = S[i]; }
    { float* co = a.out + (SAMPLE ? O_CS : O_CP) + (size_t)(layer * NB + b) * 3 * 3072;
      for (int idx = tid; idx < 3 * 384; idx += 512) { const int r = idx / 384, ch = idx - r * 384, col = (ch >> 7) * 1024 + h * 128 + (ch & 127);
          co[r * 3072 + col] = bf2f(P[(size_t)(rbase + T - 3 + r) * NP + C_QKV + col]); } }
}


constexpr size_t WS_GC = WS_M32;
constexpr int GC_STRIDE = 98304, GC_WN = 0, GC_QG = 16384, GC_KG = 32768, GC_AT = 49152, GC_U = 57344, GC_GAMMA = 90112, GC_OPS = 57344;
static_assert(WS_GC + (size_t)1024 * GC_STRIDE <= WS_H32, "chunk buffers fit in the M32|MB overlay");
constexpr int GP_QR = 0, GP_KR = 17408, GP_KBR = 34816, GP_VT = 52224, GP_KGT = 70656, GP_KT2 = 89088, GP_LM = 107520, GP_TM = 124928, GP_AS = 134144,
              GP_GC = 143360, GP_BETA = 143616, GP_GRAW = 143872, GP_WST = 0;
#define MFMA32(a, b, c) __builtin_amdgcn_mfma_f32_32x32x16_bf16((a), (b), (c), 0, 0, 0)

__device__ __forceinline__ void gdn_prep_item(int layer, int item, const int tid) {
    CArgs& a = kargs(); LAS unsigned char* lds = lds_base();
    const int lane = tid & 63, w = __builtin_amdgcn_readfirstlane(tid >> 6), hh = lane >> 5, l31 = lane & 31;
    const int b = item >> 8, h = (item >> 5) & 7, n = item & 31;
    const bf16_t* P = (const bf16_t*)(a.ws + WS_P); const float* AB = (const float*)(a.ws + WS_AB);
    unsigned char* gc = a.ws + WS_GC + (size_t)item * GC_STRIDE;
    const int t = tid >> 3, cg = tid & 7;
    const int r0 = b * 2048 + n * 64;
    __syncthreads();
    float qv[16], kv[16], vv[16];
    {
        const float* convw = a.in[24] + (size_t)layer * 4 * 3072;
#pragma unroll
        for (int sec = 0; sec < 3; ++sec) {
            const int ch = sec * 1024 + h * 128 + 16 * cg;
            float acc[16];
#pragma unroll
            for (int e = 0; e < 16; ++e) acc[e] = 0.f;
#pragma unroll
            for (int j = 0; j < 4; ++j) {
                const int tt = n * 64 + t - 3 + j; const float msk = tt < 0 ? 0.f : 1.f;
                float x[16];
                { const bf16_t* rp = P + (size_t)(b * 2048 + (tt < 0 ? 0 : tt)) * NP + C_QKV + ch; float t8[8];
                    unpack8(*(const u32x4*)rp, t8);
#pragma unroll
                    for (int e = 0; e < 8; ++e) x[e] = t8[e];
                    unpack8(*(const u32x4*)(rp + 8), t8);
#pragma unroll
                    for (int e = 0; e < 8; ++e) x[8 + e] = t8[e]; }
                const float* wp = convw + j * 3072 + ch;
#pragma unroll
                for (int e = 0; e < 16; e += 4) { const f32x4 wv = *(const f32x4*)(wp + e) * msk;
                    acc[e] += wv[0] * x[e]; acc[e + 1] += wv[1] * x[e + 1]; acc[e + 2] += wv[2] * x[e + 2]; acc[e + 3] += wv[3] * x[e + 3]; }
                if (j == 3 && n == 31 && t >= 61) { float* co = a.out + O_CP + ((size_t)(layer * 4 + b) * 3 + (t - 61)) * 3072 + ch;
#pragma unroll
                    for (int e = 0; e < 16; e += 4) *(f32x4*)(co + e) = (f32x4){x[e], x[e + 1], x[e + 2], x[e + 3]}; }
            }
            float ss = 0.f;
#pragma unroll
            for (int e = 0; e < 16; ++e) { acc[e] = silu(acc[e]); ss += acc[e] * acc[e]; }
            if (sec < 2) { ss += __shfl_xor(ss, 1); ss += __shfl_xor(ss, 2); ss += __shfl_xor(ss, 4);
                const float r = (1.f / sqrtf(ss + 1e-6f)) * (sec == 0 ? 0.08838834764831845f : 1.f);
#pragma unroll
                for (int e = 0; e < 16; ++e) { if (sec == 0) qv[e] = acc[e] * r; else kv[e] = acc[e] * r; } }
            else {
#pragma unroll
                for (int e = 0; e < 16; ++e) vv[e] = acc[e]; }
        }
        if (cg == 0) { const size_t row = (size_t)(r0 + t); const float ac = AB[row * 16 + h], bc = AB[row * 16 + 8 + h];
            const float Aexp = expf(a.in[25][layer * 8 + h]), dtb = a.in[26][layer * 8 + h];
            *(LAS float*)(lds + GP_GRAW + 4 * t) = -Aexp * softplus(ac + dtb); *(LAS float*)(lds + GP_BETA + 4 * t) = sigm(bc); }
    }
    __syncthreads();
    if (w == 0) { float g = *(LAS float*)(lds + GP_GRAW + 4 * lane);
#pragma unroll
        for (int o = 1; o < 64; o <<= 1) { const float y = __shfl_up(g, o); if (lane >= o) g += y; }
        *(LAS float*)(lds + GP_GC + 4 * lane) = g; }
    __syncthreads();
    {
        const float gct = *(LAS float*)(lds + GP_GC + 4 * t), bt = *(LAS float*)(lds + GP_BETA + 4 * t), gl = *(LAS float*)(lds + GP_GC + 4 * 63);
        const float eg = expf(gct), egl = expf(gl - gct);
        float tq[8], tk[8], tb[8];
#pragma unroll
        for (int half = 0; half < 2; ++half) {
#pragma unroll
            for (int e = 0; e < 8; ++e) { tq[e] = qv[8 * half + e]; tk[e] = kv[8 * half + e]; tb[e] = kv[8 * half + e] * bt; }
            *(LAS u32x4*)(lds + GP_QR + t * 272 + (16 * cg + 8 * half) * 2) = pack8(tq);
            *(LAS u32x4*)(lds + GP_KR + t * 272 + (16 * cg + 8 * half) * 2) = pack8(tk);
            *(LAS u32x4*)(lds + GP_KBR + t * 272 + (16 * cg + 8 * half) * 2) = pack8(tb);
        }
#pragma unroll
        for (int d = 0; d < 16; ++d) { const int rowd = 16 * cg + d;
            *(LAS bf16_t*)(lds + GP_VT + rowd * 144 + 2 * t) = (bf16_t)f2bf(vv[d] * bt);
            *(LAS bf16_t*)(lds + GP_KGT + rowd * 144 + 2 * t) = (bf16_t)f2bf(kv[d] * bt * eg);
            *(LAS bf16_t*)(lds + GP_KT2 + rowd * 144 + 2 * t) = (bf16_t)f2bf(kv[d] * egl); }
#pragma unroll
        for (int hq = 0; hq < 2; ++hq) { float o8[8];
#pragma unroll
            for (int j = 0; j < 8; ++j) o8[j] = qv[8 * (j >> 2) + 4 * hq + (j & 3)] * eg;
            *(u32x4*)(gc + GC_QG + ((((t >> 5) * 4 + (cg >> 1)) * 2 + (cg & 1)) * 64 + (t & 31) + 32 * hq) * 16) = pack8(o8); }
        if (tid == 0) *(float*)(gc + GC_GAMMA) = expf(gl);
    }
    __syncthreads();
    {
        const int typ = w >> 2, mi = (w >> 1) & 1, nj = w & 1;
        f32x16 acc;
#pragma unroll
        for (int r = 0; r < 16; ++r) acc[r] = 0.f;
        if (!(mi == 0 && nj == 1)) {
            const LAS unsigned char* Ab = lds + (typ ? GP_QR : GP_KBR) + (32 * mi + l31) * 272 + 16 * hh;
            const LAS unsigned char* Bb = lds + GP_KR + (32 * nj + l31) * 272 + 16 * hh;
#pragma unroll
            for (int ks = 0; ks < 8; ++ks) acc = MFMA32(*(const LAS bf16x8*)(Ab + 32 * ks), *(const LAS bf16x8*)(Bb + 32 * ks), acc);
        }
        const int j = 32 * nj + l31; const float gcj = *(LAS float*)(lds + GP_GC + 4 * j);
#pragma unroll
        for (int r = 0; r < 16; ++r) { const int i = 32 * mi + (r & 3) + 8 * (r >> 2) + 4 * hh;
            const float gci = *(LAS float*)(lds + GP_GC + 4 * i);
            const float d = (i >= j) ? expf(gci - gcj) : 0.f;
            if (typ == 0) *(LAS float*)(lds + GP_LM + i * 272 + 4 * j) = (i > j) ? acc[r] * d : 0.f;
            else *(LAS bf16_t*)(lds + GP_AS + i * 144 + 2 * j) = (bf16_t)f2bf((i >= j) ? acc[r] * d : 0.f); }
    }
    __syncthreads();
    if (w == 0) {
        float x[64];
        f32x4 cur[16], nxt[16];
        x[0] = (lane == 0) ? 1.f : 0.f;
        cur[0] = *(const LAS f32x4*)(lds + GP_LM + 1 * 272);
#pragma unroll
        for (int i = 1; i < 64; ++i) {
            if (i + 1 < 64) {
#pragma unroll
                for (int j4 = 0; j4 < (i + 4) / 4; ++j4) nxt[j4] = *(const LAS f32x4*)(lds + GP_LM + (i + 1) * 272 + 16 * j4);
            }
            __builtin_amdgcn_sched_barrier(0);
            float s0 = (i == lane) ? 1.f : 0.f, s1 = 0.f, s2 = 0.f, s3 = 0.f;
#pragma unroll
            for (int j4 = 0; j4 < (i + 3) / 4; ++j4) {
#pragma unroll
                for (int e = 0; e < 4; ++e) { const int j = 4 * j4 + e; if (j < i) { const float p = cur[j4][e] * x[j];
                    if (e == 0) s0 -= p; else if (e == 1) s1 -= p; else if (e == 2) s2 -= p; else s3 -= p; } } }
            x[i] = (s0 + s1) + (s2 + s3);
            __builtin_amdgcn_sched_barrier(0);
            if (i + 1 < 64) {
#pragma unroll
                for (int j4 = 0; j4 < (i + 4) / 4; ++j4) cur[j4] = nxt[j4];
            }
        }
#pragma unroll
        for (int i = 0; i < 64; ++i) *(LAS bf16_t*)(lds + GP_TM + i * 144 + 2 * lane) = (bf16_t)f2bf(x[i]);
    } else {
        for (int task = tid - 64; task < 1536; task += 448) {
            const int ll = task & 63, hq = ll >> 5;
            if (task < 1024) { const int f = task >> 6, db = f >> 2, tb = (f >> 1) & 1, s = f & 1, dk = 32 * db + (ll & 31), t0 = 32 * tb + 16 * s + 4 * hq;
                const u32x2 lo = *(const LAS u32x2*)(lds + GP_KT2 + dk * 144 + 2 * t0), hi = *(const LAS u32x2*)(lds + GP_KT2 + dk * 144 + 2 * (t0 + 8));
                *(u32x4*)(gc + GC_KG + (f * 64 + ll) * 16) = (u32x4){lo.x, lo.y, hi.x, hi.y}; }
            else { const int f = (task - 1024) >> 6, mb = f >> 2, tb = (f >> 1) & 1, s = f & 1, i = 32 * mb + (ll & 31), j0 = 32 * tb + 16 * s + 4 * hq;
                const u32x2 lo = *(const LAS u32x2*)(lds + GP_AS + i * 144 + 2 * j0), hi = *(const LAS u32x2*)(lds + GP_AS + i * 144 + 2 * (j0 + 8));
                *(u32x4*)(gc + GC_AT + (f * 64 + ll) * 16) = (u32x4){lo.x, lo.y, hi.x, hi.y}; }
        }
    }
    __syncthreads();
    {
        const LAS unsigned char* Bb = lds + (w < 4 ? GP_VT : GP_KGT) + (32 * (w & 3) + l31) * 144 + 16 * hh;
#pragma unroll
        for (int mb = 0; mb < 2; ++mb) {
            f32x16 acc;
#pragma unroll
            for (int r = 0; r < 16; ++r) acc[r] = 0.f;
            const LAS unsigned char* Ab = lds + GP_TM + (32 * mb + l31) * 144 + 16 * hh;
#pragma unroll
            for (int ks = 0; ks < 4; ++ks) acc = MFMA32(*(const LAS bf16x8*)(Ab + 32 * ks), *(const LAS bf16x8*)(Bb + 32 * ks), acc);
            if (w < 4) { unsigned* up = (unsigned*)(gc + GC_U) + ((w * 2 + mb) * 8) * 64 + lane;
#pragma unroll
                for (int q = 0; q < 8; ++q) up[q * 64] = pk2(acc[2 * q], acc[2 * q + 1]); }
            else {
#pragma unroll
                for (int r = 0; r < 16; ++r) { const int tt = 32 * mb + (r & 3) + 8 * (r >> 2) + 4 * hh;
                    *(LAS bf16_t*)(lds + GP_WST + tt * 272 + 2 * (32 * (w - 4) + l31)) = (bf16_t)f2bf(-acc[r]); } }
        }
    }
    __syncthreads();
#pragma unroll
    for (int q = 0; q < 2; ++q) { const int task = tid + 512 * q, f = task >> 6, ll = task & 63, hq = ll >> 5, mb = f >> 3, kb = (f >> 1) & 3, s = f & 1;
        const int tt = 32 * mb + (ll & 31), d0 = 32 * kb + 16 * s + 4 * hq;
        const u32x2 lo = *(const LAS u32x2*)(lds + GP_WST + tt * 272 + 2 * d0), hi = *(const LAS u32x2*)(lds + GP_WST + tt * 272 + 2 * (d0 + 8));
        *(u32x4*)(gc + GC_WN + (f * 64 + ll) * 16) = (u32x4){lo.x, lo.y, hi.x, hi.y}; }
}

__device__ __forceinline__ bf16x8 cvt_frag(const f32x16& v, int s) {
    u32x4 w; w.x = pk2(v[8 * s], v[8 * s + 1]); w.y = pk2(v[8 * s + 2], v[8 * s + 3]); w.z = pk2(v[8 * s + 4], v[8 * s + 5]); w.w = pk2(v[8 * s + 6], v[8 * s + 7]);
    return __builtin_bit_cast(bf16x8, w);
}
constexpr int CH_OB = 2 * GC_OPS;
#define CH_LOAD(dst, cidx) do { const unsigned char* _s = gcb + (size_t)(cidx) * GC_STRIDE + lt * 16; _Pragma("unroll") for (int _i = 0; _i < 14; ++_i) dst[_i] = *(const u32x4*)(_s + _i * 4096); } while (0)
#define CH_WRITE(src, bufi) do { LAS unsigned char* _d = lds + (bufi) * GC_OPS + lt * 16; _Pragma("unroll") for (int _i = 0; _i < 14; ++_i) *(LAS u32x4*)(_d + _i * 4096) = src[_i]; } while (0)
#define CH_GATE(dst, cidx) do { const bf16_t* _g = P + (size_t)(b * 2048 + (cidx) * 64 + (lt >> 4) * 4) * NP + C_GATEC + h * 128 + (lt & 15) * 8; _Pragma("unroll") for (int _q = 0; _q < 4; ++_q) dst[_q] = *(const u32x4*)(_g + (size_t)_q * NP); } while (0)
#define CH_ULOAD(dst, cidx) do { const unsigned* _u = (const unsigned*)(gcb + (size_t)(cidx) * GC_STRIDE + GC_U) + (w * 2 * 8) * 64 + lane; \
    _Pragma("unroll") for (int _m = 0; _m < 2; ++_m) _Pragma("unroll") for (int _q = 0; _q < 8; ++_q) dst[_m][_q] = _u[(_m * 8 + _q) * 64]; } while (0)
__device__ __forceinline__ void gdn_chain(int layer, int bh, const int tid) {
    CArgs& a = kargs(); LAS unsigned char* lds = lds_base();
    const int lane = tid & 63, w = __builtin_amdgcn_readfirstlane(tid >> 6), hh = lane >> 5, l31 = lane & 31;
    const int b = bh >> 3, h = bh & 7;
    const unsigned char* gcb = a.ws + WS_GC + (size_t)bh * 32 * GC_STRIDE;
    __syncthreads();
    if (w >= 4) {
        const int lt = tid - 256;
        const bf16_t* P = (const bf16_t*)(a.ws + WS_P); bf16_t* YC = (bf16_t*)(a.ws + WS_YC);
        float ngv[8]; { const float* ng = a.in[27] + layer * 128 + (lt & 15) * 8; const f32x4 n0 = *(const f32x4*)ng, n1 = *(const f32x4*)(ng + 4);
#pragma unroll
            for (int e = 0; e < 4; ++e) { ngv[e] = n0[e]; ngv[4 + e] = n1[e]; } }
        u32x4 ra[14], rb[14], gt[4];
        CH_LOAD(ra, 0); CH_LOAD(rb, 1);
        CH_WRITE(ra, 0);
        CH_LOAD(ra, 2);
        CH_GATE(gt, 0);
        __syncthreads();
#define CH_FINISH(cc) do { const int t0 = (lt >> 4) * 4, dg = lt & 15; \
            _Pragma("unroll") for (int q = 0; q < 4; ++q) { float t8[8], g8[8], o8[8]; \
                unpack8(*(const LAS u32x4*)(lds + CH_OB + ((cc) & 1) * 16384 + (t0 + q) * 256 + dg * 16), t8); unpack8(gt[q], g8); float ss = 0.f; \
                _Pragma("unroll") for (int e = 0; e < 8; ++e) ss += t8[e] * t8[e]; \
                ss += __shfl_xor(ss, 1); ss += __shfl_xor(ss, 2); ss += __shfl_xor(ss, 4); ss += __shfl_xor(ss, 8); \
                const float r = 1.f / sqrtf(ss * (1.f / 128.f) + 1e-6f); \
                _Pragma("unroll") for (int e = 0; e < 8; ++e) o8[e] = t8[e] * r * ngv[e] * silu(g8[e]); \
                *(u32x4*)(YC + (size_t)(b * 2048 + (cc) * 64 + t0 + q) * 1024 + h * 128 + dg * 8) = pack8(o8); } } while (0)
        for (int c = 0; c < 32; c += 2) {
            if (c >= 1) { CH_FINISH(c - 1); CH_GATE(gt, c); }
            CH_WRITE(rb, 1);
            if (c + 3 < 32) CH_LOAD(rb, c + 3);
            __syncthreads();
            CH_FINISH(c); CH_GATE(gt, c + 1);
            if (c + 2 < 32) { CH_WRITE(ra, 0); }
            if (c + 4 < 32) CH_LOAD(ra, c + 4);
            __syncthreads();
        }
        CH_FINISH(31);
    } else {
        f32x16 S[4];
#pragma unroll
        for (int kb = 0; kb < 4; ++kb)
#pragma unroll
            for (int r = 0; r < 16; ++r) S[kb][r] = 0.f;
        const float gam_all = (lane < 32) ? *(const float*)(gcb + (size_t)lane * GC_STRIDE + GC_GAMMA) : 0.f;
        unsigned ua[2][8], ub[2][8];
        CH_ULOAD(ua, 0); CH_ULOAD(ub, 1);
        __syncthreads();
#define CH_STEP(c, ucur) do { \
            const LAS unsigned char* ops = lds + ((c) & 1) * GC_OPS + lane * 16; \
            const float gamma = __shfl(gam_all, (c)); \
            f32x16 va[2], oa[2]; \
            _Pragma("unroll") for (int mb = 0; mb < 2; ++mb) _Pragma("unroll") for (int q = 0; q < 8; ++q) { va[mb][2 * q] = bflo(ucur[mb][q]); va[mb][2 * q + 1] = bfhi(ucur[mb][q]); } \
            _Pragma("unroll") for (int r = 0; r < 16; ++r) { oa[0][r] = 0.f; oa[1][r] = 0.f; } \
            if ((c) + 2 < 32) CH_ULOAD(ucur, (c) + 2); \
            _Pragma("unroll") for (int kb = 0; kb < 4; ++kb) _Pragma("unroll") for (int s = 0; s < 2; ++s) { const bf16x8 Bs = cvt_frag(S[kb], s); \
                _Pragma("unroll") for (int mb = 0; mb < 2; ++mb) { const int f = (mb * 4 + kb) * 2 + s; \
                    va[mb] = MFMA32(*(const LAS bf16x8*)(ops + GC_WN + f * 1024), Bs, va[mb]); \
                    oa[mb] = MFMA32(*(const LAS bf16x8*)(ops + GC_QG + f * 1024), Bs, oa[mb]); } } \
            _Pragma("unroll") for (int kb = 0; kb < 4; ++kb) _Pragma("unroll") for (int r = 0; r < 16; ++r) S[kb][r] *= gamma; \
            _Pragma("unroll") for (int tb = 0; tb < 2; ++tb) _Pragma("unroll") for (int s = 0; s < 2; ++s) { const bf16x8 Bv = cvt_frag(va[tb], s); \
                _Pragma("unroll") for (int kb = 0; kb < 4; ++kb) S[kb] = MFMA32(*(const LAS bf16x8*)(ops + GC_KG + ((kb * 2 + tb) * 2 + s) * 1024), Bv, S[kb]); \
                _Pragma("unroll") for (int mb = 0; mb < 2; ++mb) if (mb >= tb) oa[mb] = MFMA32(*(const LAS bf16x8*)(ops + GC_AT + ((mb * 2 + tb) * 2 + s) * 1024), Bv, oa[mb]); } \
            LAS unsigned char* ob = lds + CH_OB + ((c) & 1) * 16384; \
            _Pragma("unroll") for (int mb = 0; mb < 2; ++mb) _Pragma("unroll") for (int r = 0; r < 16; ++r) { const int tt = 32 * mb + (r & 3) + 8 * (r >> 2) + 4 * hh; \
                *(LAS bf16_t*)(ob + tt * 256 + 2 * (32 * w + l31)) = (bf16_t)f2bf(oa[mb][r]); } \
            __syncthreads(); } while (0)
        for (int c = 0; c < 32; c += 2) { CH_STEP(c, ua); CH_STEP(c + 1, ub); }
        float* so = a.out + O_DP + (size_t)((layer * 4 + b) * 8 + h) * 128 * 128 + 32 * w + l31;
#pragma unroll
        for (int kb = 0; kb < 4; ++kb)
#pragma unroll
            for (int r = 0; r < 16; ++r) so[(size_t)(32 * kb + (r & 3) + 8 * (r >> 2) + 4 * hh) * 128] = S[kb][r];
    }
}

__device__ __forceinline__ void gdn_sample_item(int layer, int item, const int tid) {
    CArgs& a = kargs(); LAS unsigned char* lds = lds_base();
    const int lane = tid & 63, w = __builtin_amdgcn_readfirstlane(tid >> 6);
    const int b = item >> 3, h = item & 7, rbase = TP + b * 4;
    const bf16_t* P = (const bf16_t*)(a.ws + WS_P); const float* AB = (const float*)(a.ws + WS_AB); bf16_t* YC = (bf16_t*)(a.ws + WS_YC);
    LAS float* qs = (LAS float*)lds; LAS float* ks = qs + 512; LAS float* vs = ks + 512;
    LAS float* red = vs + 512;
    LAS float* dots = red + 4096; LAS float* gcv = dots + 32; LAS float* btv = gcv + 4; LAS float* ob = btv + 4;
    const int dv = (w & 1) * 64 + lane, sl = w >> 1, dk0 = sl * 32;
    float S[32];
    { const float* s0 = a.in[4] + ((size_t)((layer * 128 + b) * 8 + h) * 128 + dk0) * 128 + dv;
#pragma unroll
      for (int i = 0; i < 32; ++i) S[i] = s0[(size_t)i * 128]; }
    __syncthreads();
    {
        const float* convw = a.in[24] + (size_t)layer * 4 * 3072; const float* sconv = a.in[5] + (size_t)(layer * 128 + b) * 3 * 3072;
        float* co = a.out + O_CS + (size_t)(layer * 128 + b) * 3 * 3072;
#pragma unroll
        for (int it3 = 0; it3 < 3; ++it3) { const int idx = tid + 512 * it3;
            const int t = idx / 384, ch = idx - t * 384, sec = ch >> 7, cc = ch & 127, col = sec * 1024 + h * 128 + cc;
            float accv = 0.f;
#pragma unroll
            for (int j = 0; j < 4; ++j) { const int tt = t - 3 + j;
                const float xp = bf2f(P[(size_t)(rbase + (tt < 0 ? 0 : tt)) * NP + C_QKV + col]), xs = sconv[(tt < 0 ? 3 + tt : 2) * 3072 + col];
                const float x = (tt >= 0) ? xp : xs;
                if (j == 3 && t >= 1) co[(t - 1) * 3072 + col] = x;
                accv += convw[j * 3072 + col] * x; }
            LAS float* dst = sec == 0 ? qs : (sec == 1 ? ks : vs); dst[t * 128 + cc] = silu(accv);
        }
        if (tid < 4) { const size_t row = (size_t)(rbase + tid); const float ac = AB[row * 16 + h], bc = AB[row * 16 + 8 + h];
            gcv[tid] = -expf(a.in[25][layer * 8 + h]) * softplus(ac + a.in[26][layer * 8 + h]); btv[tid] = sigm(bc); }
    }
    __syncthreads();
    if (w < 4) { const int t = w;
        { const float q0 = qs[t * 128 + lane], q1 = qs[t * 128 + 64 + lane]; const float ss = wave_sum(q0 * q0 + q1 * q1);
          const float r = (1.f / sqrtf(ss + 1e-6f)) * 0.08838834764831845f; qs[t * 128 + lane] = q0 * r; qs[t * 128 + 64 + lane] = q1 * r; }
        { const float k0 = ks[t * 128 + lane], k1 = ks[t * 128 + 64 + lane]; const float ss = wave_sum(k0 * k0 + k1 * k1);
          const float r = 1.f / sqrtf(ss + 1e-6f); ks[t * 128 + lane] = k0 * r; ks[t * 128 + 64 + lane] = k1 * r; } }
    __syncthreads();
    {
#pragma unroll
        for (int q = 0; q < 4; ++q) { const int id = w * 4 + q, typ = id >> 4, i = (id >> 2) & 3, j = id & 3;
            const LAS float* xa = (typ ? qs : ks) + i * 128; const LAS float* xb = ks + j * 128;
            const float d = wave_sum(xa[lane] * xb[lane] + xa[64 + lane] * xb[64 + lane]);
            if (lane == 0) dots[id] = d; }
        float pk[4], pq[4];
#pragma unroll
        for (int j = 0; j < 4; ++j) { pk[j] = 0.f; pq[j] = 0.f; }
#pragma unroll
        for (int i = 0; i < 32; i += 4)
#pragma unroll
            for (int j = 0; j < 4; ++j) { const f32x4 kk = *(const LAS f32x4*)(ks + j * 128 + dk0 + i), qq = *(const LAS f32x4*)(qs + j * 128 + dk0 + i);
                pk[j] += kk[0] * S[i] + kk[1] * S[i + 1] + kk[2] * S[i + 2] + kk[3] * S[i + 3];
                pq[j] += qq[0] * S[i] + qq[1] * S[i + 1] + qq[2] * S[i + 2] + qq[3] * S[i + 3]; }
#pragma unroll
        for (int j = 0; j < 4; ++j) { red[(j * 4 + sl) * 128 + dv] = pk[j]; red[((4 + j) * 4 + sl) * 128 + dv] = pq[j]; }
    }
    __syncthreads();
    {
        float gc[4], bt[4];
        gc[0] = gcv[0]; gc[1] = gc[0] + gcv[1]; gc[2] = gc[1] + gcv[2]; gc[3] = gc[2] + gcv[3];
#pragma unroll
        for (int j = 0; j < 4; ++j) bt[j] = btv[j];
        float L[4][4], Tm[4][4];
#pragma unroll
        for (int i = 0; i < 4; ++i)
#pragma unroll
            for (int j = 0; j < 4; ++j) L[i][j] = (i > j) ? bt[i] * dots[i * 4 + j] * expf(gc[i] - gc[j]) : 0.f;
#pragma unroll
        for (int i = 0; i < 4; ++i)
#pragma unroll
            for (int c = 0; c < 4; ++c) { float s = (i == c) ? 1.f : 0.f;
#pragma unroll
                for (int j = 0; j < 4; ++j) if (j < i) s -= L[i][j] * Tm[j][c];
                Tm[i][c] = s; }
        float kS[4], qS[4], rhs[4], vn[4];
#pragma unroll
        for (int j = 0; j < 4; ++j) { kS[j] = (red[(j * 4 + 0) * 128 + dv] + red[(j * 4 + 1) * 128 + dv]) + (red[(j * 4 + 2) * 128 + dv] + red[(j * 4 + 3) * 128 + dv]);
            qS[j] = (red[((4 + j) * 4 + 0) * 128 + dv] + red[((4 + j) * 4 + 1) * 128 + dv]) + (red[((4 + j) * 4 + 2) * 128 + dv] + red[((4 + j) * 4 + 3) * 128 + dv]);
            rhs[j] = bt[j] * (vs[j * 128 + dv] - expf(gc[j]) * kS[j]); }
#pragma unroll
        for (int i = 0; i < 4; ++i) { float s = 0.f;
#pragma unroll
            for (int j = 0; j < 4; ++j) if (j <= i) s += Tm[i][j] * rhs[j];
            vn[i] = s; }
        if (sl == 0) {
#pragma unroll
            for (int i = 0; i < 4; ++i) { float o = expf(gc[i]) * qS[i];
#pragma unroll
                for (int j = 0; j < 4; ++j) if (j <= i) o += dots[16 + i * 4 + j] * expf(gc[i] - gc[j]) * vn[j];
                ob[i * 128 + dv] = o; } }
        const float gl = gc[3], egl = expf(gl);
        float cf[4];
#pragma unroll
        for (int j = 0; j < 4; ++j) cf[j] = expf(gl - gc[j]) * vn[j];
        float* so = a.out + O_DS + ((size_t)((layer * 128 + b) * 8 + h) * 128 + dk0) * 128 + dv;
#pragma unroll
        for (int i = 0; i < 32; ++i) { float s = egl * S[i];
#pragma unroll
            for (int j = 0; j < 4; ++j) s += ks[j * 128 + dk0 + i] * cf[j];
            so[(size_t)i * 128] = s; }
    }
    __syncthreads();
    if (w < 4) { const int t = w; const float* ng = a.in[27] + layer * 128;
        const float o0 = ob[t * 128 + lane], o1 = ob[t * 128 + 64 + lane]; const float ss = wave_sum(o0 * o0 + o1 * o1);
        const float r = 1.f / sqrtf(ss * (1.f / 128.f) + 1e-6f); const size_t row = (size_t)(rbase + t);
        const float g0 = bf2f(P[row * NP + C_GATEC + h * 128 + lane]), g1 = bf2f(P[row * NP + C_GATEC + h * 128 + 64 + lane]);
        YC[row * 1024 + h * 128 + lane] = (bf16_t)f2bf(o0 * r * ng[lane] * silu(g0));
        YC[row * 1024 + h * 128 + 64 + lane] = (bf16_t)f2bf(o1 * r * ng[64 + lane] * silu(g1)); }
}

#ifndef REP_ROLE
#define REP_ROLE -1
#endif
#define RR(x) for (int _rr = 0; _rr < ((REP_ROLE == (x)) ? 2 : 1); ++_rr)
constexpr int QA_S5 = 80, QA_GM = 144, QA_PREP = 1168, QA_GMS = 1184, QA_END = 2208;
constexpr int CTL_QUEUE = 4096;
__device__ __forceinline__ void phase_mixers(int layer, int G, int bid, int tid0) {
#ifndef PROBE_MIX
#define PROBE_MIX -1
#endif
#define PM(x) (PROBE_MIX == -1 || PROBE_MIX == (x))
    volatile LAS int* qslot = (volatile LAS int*)(lds_base() + LDS_BARST + 16);
    unsigned* ctr = (unsigned*)kargs().ws + CTL_QUEUE + 64 * layer;
    for (;;) {
        const int tid = launder_v(tid0), lane = tid & 63, w = __builtin_amdgcn_readfirstlane(tid >> 6);
        __syncthreads();
        if (tid == 0) *qslot = (int)__hip_atomic_fetch_add(ctr, 1u, __ATOMIC_RELAXED, __HIP_MEMORY_SCOPE_AGENT);
        __syncthreads();
        const int it = launder_s(__builtin_amdgcn_readfirstlane(*qslot));
        if (it >= QA_END) break;
        if (it < QA_S5) { if (w < 4) { const int q = launder_s(it * 4 + w);
                if (q < 256) { if (PM(1)) s5_item<false>(layer, q, w * S5_WLDS, lane); }
                else { if (PM(2)) s5_item<true>(layer, q - 256, w * S5_WLDS, lane); } } }
        else if (it < QA_GM) { if (PM(3)) gmlp_prompt_item(layer, it - QA_S5, tid); }
        else if (it < QA_PREP) { if (PM(0)) gdn_prep_item(layer, it - QA_GM, tid); }
        else if (it < QA_GMS) { if (PM(4)) gmlp_sample_item(layer, (it - QA_PREP) * 8 + w, lane); }
        else { if (PM(5)) gdn_sample_item(layer, it - QA_GMS, tid); }
    }
}

#define XB_TMO      128
#define XB_XCNT(j)  (256  + 64 * (j))
#define XB_XSUB(j)  (1280 + 64 * (j))
#define XB_XGEN(j)  (2304 + 64 * (j))
#define XB_TOP      3328
#define XB_TOPGEN   3392
#define XCD_BAR_WORDS 3456
#define XB_SPIN_CAP (1u << 18)
__device__ __forceinline__ unsigned xb_ld(unsigned* p)              { return __hip_atomic_load(p, __ATOMIC_RELAXED, __HIP_MEMORY_SCOPE_AGENT); }
__device__ __forceinline__ unsigned xb_add(unsigned* p, unsigned v) { return __hip_atomic_fetch_add(p, v, __ATOMIC_RELAXED, __HIP_MEMORY_SCOPE_AGENT); }
__device__ __forceinline__ unsigned xb_xcc_id() { return (unsigned)__builtin_amdgcn_s_getreg((3 << 11) | 20) & 0xFu; }
#define XB_SPIN(cond, bar) do { unsigned _sp = 0; while (cond) { __builtin_amdgcn_s_sleep(1); \
    if ((++_sp & 255u) == 0u) { if (xb_ld(&(bar)[XB_TMO])) break; if (_sp > XB_SPIN_CAP) { atomicAdd(&(bar)[XB_TMO], 1u); break; } } } } while (0)
struct XcdBarrier { unsigned* bar; unsigned x; volatile LAS unsigned* st; };
__device__ __forceinline__ void xcd_barrier_complete(unsigned* bar, unsigned x, unsigned& nloc, unsigned& nx) {
    const unsigned G = gridDim.x * gridDim.y * gridDim.z;
    unsigned sum, cnt, mine, sp = 0u;
    for (;;) {
        sum = 0u; cnt = 0u; mine = 0u;
#pragma unroll
        for (unsigned j = 0; j < 16; ++j) { const unsigned c = xb_ld(&bar[XB_XCNT(j)]); sum += c; cnt += (c > 0u) ? 1u : 0u; mine = (j == x) ? c : mine; }
        if (sum == G) break;
        __builtin_amdgcn_s_sleep(1);
        if ((++sp & 255u) == 0u) { if (xb_ld(&bar[XB_TMO])) break; if (sp > XB_SPIN_CAP) { atomicAdd(&bar[XB_TMO], 1u); break; } }
    }
    nloc = mine > 0u ? mine : 1u; nx = cnt > 0u ? cnt : 1u;
}
__device__ __forceinline__ void xcd_barrier(const XcdBarrier& b) {
    asm volatile("s_waitcnt vmcnt(0)" ::: "memory");
    __syncthreads();
    if (threadIdx.x == 0) {
        unsigned* bar = b.bar;
        __builtin_amdgcn_s_waitcnt(0);
        unsigned nloc = b.st[0], nx = b.st[1];
        if (nloc == 0u) { xcd_barrier_complete(bar, b.x, nloc, nx); b.st[0] = nloc; b.st[1] = nx; }
        const unsigned old = xb_add(&bar[XB_XSUB(b.x)], 1u);
        const unsigned gen = old / nloc;
        if (old + 1u == (gen + 1u) * nloc) {
            __builtin_amdgcn_fence(__ATOMIC_RELEASE, "agent");
            asm volatile("s_waitcnt vmcnt(0)" ::: "memory");
            const unsigned og = xb_add(&bar[XB_TOP], 1u);
            const unsigned tg = og / nx;
            if (og + 1u == (tg + 1u) * nx) xb_add(&bar[XB_TOPGEN], 1u);
            else XB_SPIN(xb_ld(&bar[XB_TOPGEN]) == tg, bar);
            __builtin_amdgcn_fence(__ATOMIC_ACQUIRE, "agent");
            xb_add(&bar[XB_XGEN(b.x)], 1u);
            asm volatile("s_waitcnt vmcnt(0)" ::: "memory");
        } else {
            XB_SPIN(xb_ld(&bar[XB_XGEN(b.x)]) == gen, bar);
            __builtin_amdgcn_fence(__ATOMIC_ACQUIRE, "agent");
            asm volatile("s_waitcnt vmcnt(0)" ::: "memory");
        }
    }
    __syncthreads();
}

__global__ void __launch_bounds__(512, 2) mega(Args karg) {
    const int ph_lo = karg.ph_lo, ph_hi = karg.ph_hi;
    extern __shared__ __attribute__((aligned(16))) unsigned char lds_raw[];
    volatile LAS unsigned* bst = (volatile LAS unsigned*)((LAS unsigned char*)lds_raw + LDS_BARST);
#if MK_SINGLE
    if (threadIdx.x == 0) { bst[0] = 0u; bst[1] = 0u; }
    __syncthreads();
    if (threadIdx.x == 0) (void)xb_add((unsigned*)karg.ws + XB_XCNT(xb_xcc_id()), 1u);
#endif
#ifndef REP_SUB
#define REP_SUB -1
#endif
#ifndef REP_N
#define REP_N 2
#endif
    int rep = 0;
    for (int ph = ph_lo; ph < ph_hi; (REP_SUB >= 0 && ph >= 1 && (ph - 1) % 6 == REP_SUB && rep + 1 < REP_N) ? (void)++rep : (void)(rep = 0, ++ph)) {
        if (ph > ph_lo && rep == 0) { XcdBarrier xb; xb.bar = (unsigned*)kargs().ws; xb.x = xb_xcc_id(); xb.st = bst; xcd_barrier(xb); }
        const int G = launder_s((int)gridDim.x), bid = launder_s((int)blockIdx.x), tid = launder_v((int)threadIdx.x);
        CArgs& a = kargs(); LAS unsigned char* lds = lds_base();
        unsigned char* ws = a.ws;
#ifndef PROBE_SUB
#define PROBE_SUB -1
#endif
#define PS(x) (PROBE_SUB == -1 || PROBE_SUB == (x))
        if (ph == 0) { if (PS(6)) phase_convert(a, lds, G, bid, tid); continue; }
        const int layer = (ph - 1) / 6, sub = (ph - 1) % 6;
        unsigned char* wb = ws + WS_W0 + (size_t)layer * WS_WL;
        if (PS(0) && sub == 0) {
            pg8::Gemm g{(const bf16_t*)(ws + WS_XB), nullptr, nullptr, (const bf16_t*)(wb + WO_IN), nullptr, nullptr, DM};
            pg8::Sched S; S.init(MT / 256, NP / 256, 1, G, bid);
            pg8::Epi1 E{(bf16_t*)(ws + WS_P), (float*)(ws + WS_AB)};
            pg8::gemm_phase(lds, g, S, E, tid);
        } else if (PS(1) && sub == 1) {
            phase_mixers(layer, G, bid, tid);
        } else if (PS(2) && sub == 2) {
            if (bid < 32) { RR(6) gdn_chain(layer, bid, tid); }
            else {
            pg8::Gemm g{(const bf16_t*)(ws + WS_ZB), nullptr, nullptr, (const bf16_t*)(wb + WO_GLU), nullptr, nullptr, 1024};
            pg8::Sched S; S.init(MT / 256, 4, 1, G - 32, bid - 32);
            pg8::Epi2 E{(const bf16_t*)(ws + WS_ZB), (const bf16_t*)(ws + WS_P), a.in[17] + layer * 1024, (bf16_t*)(ws + WS_YA)};
            pg8::gemm_phase(lds, g, S, E, tid);
            }
        } else if (PS(3) && sub == 3) {
            pg8::Gemm g{(const bf16_t*)(ws + WS_YA), (const bf16_t*)(ws + WS_YB), (const bf16_t*)(ws + WS_YC),
                        (const bf16_t*)(wb + WO_PA), (const bf16_t*)(wb + WO_PB), (const bf16_t*)(wb + WO_PC), 1024};
            pg8::Sched S; S.init(MT / 256, 8, 3, G, bid);
            pg8::Epi3 E{(const bf16_t*)(ws + WS_P), a.in[7] + layer * 3 * DM, (float*)(ws + WS_M32), (bf16_t*)(ws + WS_MB)};
            pg8::gemm_phase(lds, g, S, E, tid);
        } else if (PS(4) && sub == 4) {
            pg8::Gemm g{(const bf16_t*)(ws + WS_MB), nullptr, nullptr, (const bf16_t*)(wb + WO_OUT), nullptr, nullptr, DM};
            pg8::Sched S; S.init(MT / 256, 8, 1, G, bid);
            const float* xp = layer == 0 ? a.in[0] : (const float*)(ws + WS_X32);
            const float* xs = layer == 0 ? a.in[1] : (const float*)(ws + WS_X32) + (size_t)TP * DM;
            pg8::Epi4 E{xp, xs, (float*)(ws + WS_H32)};
            pg8::gemm_phase(lds, g, S, E, tid);
        } else if (PS(5) && sub == 5) {
            phase_ln(a, layer, G, bid, tid);
        }
    }
}

extern "C" void kernel_launch(void* const* d_in, const int* in_sizes, int n_in, void* d_out, int out_size, void* d_ws, size_t ws_size, hipStream_t stream) {
    static int grid = 0;
    if (grid == 0) {
        if (n_in != 32 || (size_t)out_size != O_END || ws_size < WS_END) {
            fprintf(stderr, "kernel_launch: unexpected problem: n_in %d out %d ws %zu (need %zu)\n", n_in, out_size, ws_size, (size_t)WS_END); grid = -1; return; }
        int dev = 0, cus = 0, per_cu = 0;
        if (hipGetDevice(&dev) != hipSuccess || hipDeviceGetAttribute(&cus, hipDeviceAttributeMultiprocessorCount, dev) != hipSuccess) { grid = -1; return; }
        if (hipFuncSetAttribute((const void*)mega, hipFuncAttributeMaxDynamicSharedMemorySize, LDS_BYTES) != hipSuccess) { fprintf(stderr, "kernel_launch: hipFuncSetAttribute failed\n"); grid = -1; return; }
        if (hipOccupancyMaxActiveBlocksPerMultiprocessor(&per_cu, (const void*)mega, 512, LDS_BYTES) != hipSuccess || per_cu < 1) {
            fprintf(stderr, "kernel_launch: occupancy query says %d blocks per CU\n", per_cu); (void)hipGetLastError(); grid = -1; return; }
        grid = cus;
    }
    if (grid < 0) return;
    Args a{};
    for (int i = 0; i < 32; ++i) a.in[i] = (const float*)d_in[i];
    a.out = (float*)d_out; a.ws = (unsigned char*)d_ws;
#if MK_SINGLE
    a.ph_lo = 0; a.ph_hi = NPHASE;
    if (hipMemsetAsync(d_ws, 0, 32768, stream) != hipSuccess) { fprintf(stderr, "kernel_launch: memset of the barrier words failed\n"); return; }
    hipLaunchKernelGGL(mega, dim3(grid), dim3(512), LDS_BYTES, stream, a);
#else
    for (int ph = 0; ph < NPHASE; ++ph) {
        a.ph_lo = ph; a.ph_hi = ph + 1;
        hipLaunchKernelGGL(mega, dim3(grid), dim3(512), LDS_BYTES, stream, a);
    }
#endif
}
```

```cpp
#include <hip/hip_runtime.h>
#include <hip/hip_cooperative_groups.h>
#include <cstdio>
#include <cstdint>
namespace cg = cooperative_groups;

#ifndef MK_SINGLE
#define MK_SINGLE 1
#endif

#define LAS __attribute__((address_space(3)))
typedef unsigned short bf16_t;
typedef short bf16x8 __attribute__((ext_vector_type(8)));
typedef float f32x4 __attribute__((ext_vector_type(4)));
typedef float f32x2 __attribute__((ext_vector_type(2)));
typedef float f32x16 __attribute__((ext_vector_type(16)));
typedef unsigned u32x4 __attribute__((ext_vector_type(4)));
typedef unsigned u32x2 __attribute__((ext_vector_type(2)));

constexpr int DM = 2048, TP = 8192, TS = 512, MT = TP + TS;
constexpr int NIN = 15376, NP = 15616;
constexpr int C_XA = 0, C_GA = 1024, C_UB = 2048, C_VB = 3072, C_GB = 4096, C_QKV = 5120, C_GATEC = 8192, C_ZG = 9216, C_AB = 15360;
constexpr int NPHASE = 13;
constexpr float ALPHA = 1.41421356237f;

constexpr size_t MiB = 1u << 20;
constexpr size_t WS_CTL = 0;
constexpr size_t WS_W0 = 1 * MiB, WS_WL = 83 * MiB;
constexpr size_t WO_IN = 0, WO_GLU = 61 * MiB, WO_PA = 63 * MiB, WO_PB = 67 * MiB, WO_PC = 71 * MiB, WO_OUT = 75 * MiB;
constexpr size_t WS_XB = 167 * MiB, WS_P = 201 * MiB, WS_AB = 461 * MiB, WS_ZB = 462 * MiB, WS_YA = 479 * MiB, WS_YB = 496 * MiB, WS_YC = 513 * MiB;
constexpr size_t WS_M32 = 530 * MiB, WS_MB = 598 * MiB, WS_H32 = 632 * MiB, WS_X32 = 700 * MiB, WS_END = 768 * MiB;

constexpr size_t O_YP = 0, O_YS = 16777216, O_SRP = 17825792, O_SIP = 17858560, O_DP = 17891328, O_CP = 18939904,
                 O_SRS = 19013632, O_SIS = 20062208, O_DS = 21110784, O_CS = 54665216, O_GV = 57024512, O_END = 58073088;

constexpr int LDS_BYTES = 147456 + 256, LDS_BARST = 147456;

struct Args { const float* in[32]; float* out; unsigned char* ws; int ph_lo, ph_hi; };
typedef const __attribute__((address_space(4))) Args CArgs;

typedef __bf16 bf16x2_t __attribute__((ext_vector_type(2)));
__device__ __forceinline__ unsigned pk2(float lo, float hi) { const f32x2 v = {lo, hi}; return __builtin_bit_cast(unsigned, __builtin_convertvector(v, bf16x2_t)); }
__device__ __forceinline__ unsigned f2bf(float f) { return pk2(f, 0.f) & 0xffffu; }
__device__ __forceinline__ float bf2f(unsigned short h) { return __builtin_bit_cast(float, (unsigned)h << 16); }
__device__ __forceinline__ float bflo(unsigned w) { return __builtin_bit_cast(float, w << 16); }
__device__ __forceinline__ float bfhi(unsigned w) { return __builtin_bit_cast(float, w & 0xffff0000u); }
__device__ __forceinline__ float sigm(float x) { return 1.f / (1.f + __expf(-x)); }
__device__ __forceinline__ float silu(float x) { return x / (1.f + __expf(-x)); }
__device__ __forceinline__ float gelu_tanh(float x) { return x * sigm(1.5957691216f * (x + 0.044715f * x * x * x)); }
__device__ __forceinline__ float softplus(float x) { return x > 20.f ? x : log1pf(expf(x)); }
__device__ __forceinline__ float wave_sum(float v) {
#pragma unroll
    for (int o = 1; o < 64; o <<= 1) v += __shfl_xor(v, o);
    return v;
}
__device__ __forceinline__ void unpack8(const u32x4 w, float (&f)[8]) {
    f[0] = bflo(w.x); f[1] = bfhi(w.x); f[2] = bflo(w.y); f[3] = bfhi(w.y); f[4] = bflo(w.z); f[5] = bfhi(w.z); f[6] = bflo(w.w); f[7] = bfhi(w.w);
}
__device__ __forceinline__ u32x4 pack8(const float (&f)[8]) { u32x4 w; w.x = pk2(f[0], f[1]); w.y = pk2(f[2], f[3]); w.z = pk2(f[4], f[5]); w.w = pk2(f[6], f[7]); return w; }
#define LDS_WAIT() asm volatile("s_waitcnt lgkmcnt(0)" ::: "memory")
__device__ __forceinline__ int launder_v(int x) { asm volatile("" : "+v"(x)); return x; }
__device__ __forceinline__ int launder_s(int x) { asm volatile("" : "+s"(x)); return x; }
__device__ __forceinline__ CArgs& kargs() { int z; asm volatile("s_mov_b32 %0, 0" : "=s"(z));
    return *(CArgs*)((const __attribute__((address_space(4))) char*)__builtin_amdgcn_kernarg_segment_ptr() + z); }
__device__ __forceinline__ LAS unsigned char* lds_base() { extern __shared__ __attribute__((aligned(16))) unsigned char lds_raw[]; int z; asm volatile("s_mov_b32 %0, 0" : "=s"(z));
    return (LAS unsigned char*)lds_raw + z; }

namespace pg8 {
constexpr int BM = 256, BK = 64, HALF = 128, HTB = HALF * BK * 2, STAGE_BYTES = 8 * HTB, NXCD = 8, WGM = 8;
__device__ __forceinline__ int lds_byte(int r, int c) { const int st = (r >> 4) * 2 + (c >> 5), rr = r & 15, cc = c & 31, ob = rr * 64 + cc * 2; return st * 1024 + (ob ^ (((ob >> 9) & 1) << 5)); }
__device__ __forceinline__ void stage_rc(int b, int& R, int& C) { const int st = b / 1024, sb = b % 1024, swz = sb ^ (((sb >> 9) & 1) << 5); R = (st >> 1) * 16 + swz / 64; C = (st & 1) * 32 + (swz % 64) / 2; }
__device__ __forceinline__ int perm32(int rho) { const int n = rho >> 4, i = rho & 15; return 8 * (i >> 2) + 4 * n + (i & 3); }

struct Unit { int pm, pn, br; };
struct Gemm { const bf16_t* A0; const bf16_t* A1; const bf16_t* A2; const bf16_t* B0; const bf16_t* B1; const bf16_t* B2; int K; };

struct Sched {
    int nM, nN, nbr, nwg, G, c;
    __device__ __forceinline__ void init(int nM_, int nN_, int nbr_, int G_, int c_) { nM = nM_; nN = nN_; nbr = nbr_; nwg = nM * nN; G = G_; c = c_; }
    __device__ __forceinline__ bool next(int i, Unit& u) const {
        const int ti = i / nbr; u.br = i - ti * nbr;
        const long L = (long)ti * G + c; if (L >= nwg) return false;
        int wgid = (int)L; { const int q = nwg / NXCD, r = nwg % NXCD, xcd = wgid % NXCD, off = wgid / NXCD; wgid = (xcd < r ? xcd * (q + 1) : r * (q + 1) + (xcd - r) * q) + off; }
        const int nig = WGM * nN, gid = wgid / nig, fm = gid * WGM, gsz = (nM - fm) < WGM ? (nM - fm) : WGM;
        u.pm = fm + ((wgid % nig) % gsz); u.pn = (wgid % nig) / gsz; return true;
    }
};

template <class Epi>
__device__ __forceinline__ void gemm_phase(LAS unsigned char* lds, const Gemm g, const Sched& S, const Epi& E, const int tid) {
    const int wid = __builtin_amdgcn_readfirstlane(tid >> 6), lane = tid & 63, wr = wid >> 2, wc = wid & 3, fr = lane & 15, fq = lane >> 4;
    const int K = g.K, nt = K / BK;
    unsigned voffA[2], voffB[2];
#pragma unroll
    for (int i = 0; i < 2; ++i) { int R, C; stage_rc(tid * 16 + i * 8192, R, C); const int Rb = (R & ~31) + perm32(R & 31);
        voffA[i] = (unsigned)(R * K + C) * 2u; voffB[i] = (unsigned)(Rb * K + C) * 2u; }
    const size_t kstep = (size_t)(BK * 2);
    const size_t hstep = (size_t)HALF * K * 2;
    const size_t tstep = 2 * hstep;
    const unsigned ldsw = (unsigned)wid * 1024u;
    const int aoff = lds_byte(wr * 64 + fr, fq * 8), boff = lds_byte(wc * 32 + fr, fq * 8);
#define PG8_SA(b, h) (((b) * 2 + (h)) * HTB)
#define PG8_SB(b, h) ((4 + (b) * 2 + (h)) * HTB)
#define PG8_STAGE(bufoff, gbase, voff) do { _Pragma("unroll") for (int _i = 0; _i < 2; ++_i) \
        __builtin_amdgcn_global_load_lds((const unsigned*)((const char*)(gbase) + (voff)[_i]), (LAS unsigned*)(lds + (bufoff) + ldsw + _i * 8192), 16, 0, 0); } while (0)
#define PG8_LDA(dst, b, h) do { _Pragma("unroll") for (int m = 0; m < 4; ++m) _Pragma("unroll") for (int k = 0; k < 2; ++k) dst[m][k] = *(const LAS bf16x8*)(lds + PG8_SA(b, h) + aoff + m * 2048 + k * 1024); } while (0)
#define PG8_LDB(dst, b, h) do { _Pragma("unroll") for (int n = 0; n < 2; ++n) _Pragma("unroll") for (int k = 0; k < 2; ++k) dst[n][k] = *(const LAS bf16x8*)(lds + PG8_SB(b, h) + boff + n * 2048 + k * 1024); } while (0)
#define PG8_MMA(ai, bj, At, Bt) do { __builtin_amdgcn_s_setprio(1); _Pragma("unroll") for (int m = 0; m < 4; ++m) _Pragma("unroll") for (int n = 0; n < 2; ++n) _Pragma("unroll") for (int k = 0; k < 2; ++k) \
        acc[ai][bj][m][n] = __builtin_amdgcn_mfma_f32_16x16x32_bf16(Bt[n][k], At[m][k], acc[ai][bj][m][n], 0, 0, 0); __builtin_amdgcn_s_setprio(0); } while (0)
#define PG8_WAIT_V(n) asm volatile("s_waitcnt vmcnt(" #n ")" ::: "memory")
#define PG8_WAIT_L(n) asm volatile("s_waitcnt lgkmcnt(" #n ")" ::: "memory")
#define PG8_BAR __builtin_amdgcn_s_barrier()
#define PG8_SCHED __builtin_amdgcn_sched_barrier(0)
#define PG8_APTR(u) ((const char*)((u).br == 0 ? g.A0 : ((u).br == 1 ? g.A1 : g.A2)) + (size_t)(u).pm * tstep)
#define PG8_BPTR(u) ((const char*)((u).br == 0 ? g.B0 : ((u).br == 1 ? g.B1 : g.B2)) + (size_t)(u).pn * tstep)
    Unit cur, nxt; int ui = 0;
    if (!S.next(0, cur)) return;
    f32x4 acc[2][2][4][2];
#pragma unroll
    for (int a = 0; a < 2; ++a)
#pragma unroll
        for (int b = 0; b < 2; ++b)
#pragma unroll
            for (int m = 0; m < 4; ++m)
#pragma unroll
                for (int n = 0; n < 2; ++n) acc[a][b][m][n] = (f32x4){0.f, 0.f, 0.f, 0.f};
    bf16x8 At[4][2], B0[2][2], B1[2][2];
    const char* cA = PG8_APTR(cur); const char* cB = PG8_BPTR(cur);
    PG8_STAGE(PG8_SB(0, 0), cB, voffB); PG8_STAGE(PG8_SB(0, 1), cB + hstep, voffB); PG8_STAGE(PG8_SA(0, 0), cA, voffA); PG8_STAGE(PG8_SA(0, 1), cA + hstep, voffA);
    if (wr == 1) PG8_BAR;
    PG8_WAIT_V(2); PG8_BAR;
    PG8_STAGE(PG8_SB(1, 0), cB + kstep, voffB); PG8_STAGE(PG8_SA(1, 0), cA + kstep, voffA); PG8_STAGE(PG8_SB(1, 1), cB + hstep + kstep, voffB);
    PG8_WAIT_V(6); PG8_BAR;
    for (;;) {
        const bool has_next = S.next(ui + 1, nxt);
        const char* nA = has_next ? PG8_APTR(nxt) : cA; const char* nB = has_next ? PG8_BPTR(nxt) : cB;
        for (int t = 0; t < nt; t += 2) {
            const bool last = (t == nt - 2);
            const char* a1 = cA + (size_t)(t + 1) * kstep;
            const char* a2 = last ? nA : cA + (size_t)(t + 2) * kstep; const char* b2 = last ? nB : cB + (size_t)(t + 2) * kstep;
            const char* a3 = a2 + kstep; const char* b3 = b2 + kstep;
            PG8_LDB(B0, 0, 0); PG8_LDB(B1, 0, 1); PG8_SCHED; PG8_LDA(At, 0, 0); PG8_STAGE(PG8_SA(1, 1), a1 + hstep, voffA);
            PG8_WAIT_V(8); PG8_WAIT_L(0); PG8_BAR; PG8_MMA(0, 0, At, B0); PG8_MMA(0, 1, At, B1); PG8_BAR; PG8_SCHED;
            PG8_LDA(At, 0, 1); PG8_STAGE(PG8_SB(0, 0), b2, voffB); PG8_STAGE(PG8_SB(0, 1), b2 + hstep, voffB); PG8_STAGE(PG8_SA(0, 0), a2, voffA);
            PG8_WAIT_V(8); PG8_WAIT_L(0); PG8_BAR; PG8_MMA(1, 0, At, B0); PG8_MMA(1, 1, At, B1); PG8_BAR; PG8_SCHED;
            PG8_LDB(B0, 1, 0); PG8_LDB(B1, 1, 1); PG8_SCHED; PG8_LDA(At, 1, 0); PG8_STAGE(PG8_SA(0, 1), a2 + hstep, voffA);
            PG8_WAIT_V(8); PG8_WAIT_L(0); PG8_BAR; PG8_MMA(0, 0, At, B0); PG8_MMA(0, 1, At, B1); PG8_BAR; PG8_SCHED;
            PG8_LDA(At, 1, 1); PG8_STAGE(PG8_SB(1, 0), b3, voffB); PG8_STAGE(PG8_SB(1, 1), b3 + hstep, voffB); PG8_STAGE(PG8_SA(1, 0), a3, voffA);
            PG8_WAIT_V(8); PG8_WAIT_L(0); PG8_BAR; PG8_MMA(1, 0, At, B0); PG8_MMA(1, 1, At, B1); PG8_BAR; PG8_SCHED;
        }
        if (wr == 0) PG8_BAR;
        E(acc, cur, wr, wc, fr, fq);
        if (!has_next) break;
#pragma unroll
        for (int a = 0; a < 2; ++a)
#pragma unroll
            for (int b = 0; b < 2; ++b)
#pragma unroll
                for (int m = 0; m < 4; ++m)
#pragma unroll
                    for (int n = 0; n < 2; ++n) acc[a][b][m][n] = (f32x4){0.f, 0.f, 0.f, 0.f};
        cur = nxt; cA = nA; cB = nB; ++ui;
        if (wr == 1) PG8_BAR;
    }
    PG8_WAIT_V(0);
    PG8_BAR;
#undef PG8_SA
#undef PG8_SB
#undef PG8_STAGE
#undef PG8_LDA
#undef PG8_LDB
#undef PG8_MMA
#undef PG8_WAIT_V
#undef PG8_WAIT_L
#undef PG8_BAR
#undef PG8_SCHED
#undef PG8_APTR
#undef PG8_BPTR
}

struct Epi1 {
    bf16_t* P; float* AB;
    __device__ __forceinline__ void operator()(const f32x4 (&acc)[2][2][4][2], const Unit& u, int wr, int wc, int fr, int fq) const {
        const int row0 = u.pm * BM + wr * 64 + fr, col0 = u.pn * BM + wc * 32 + 8 * fq;
#pragma unroll
        for (int ai = 0; ai < 2; ++ai)
#pragma unroll
            for (int m = 0; m < 4; ++m) { bf16_t* rowp = P + (size_t)(row0 + ai * HALF + m * 16) * NP + col0;
#pragma unroll
                for (int bj = 0; bj < 2; ++bj) { const f32x4 v0 = acc[ai][bj][m][0], v1 = acc[ai][bj][m][1];
                    u32x4 w; w.x = pk2(v0[0], v0[1]); w.y = pk2(v0[2], v0[3]); w.z = pk2(v1[0], v1[1]); w.w = pk2(v1[2], v1[3]);
                    *(u32x4*)(rowp + bj * HALF) = w; } }
        if (u.pn == 60 && wc == 0 && fq < 2) {
#pragma unroll
            for (int ai = 0; ai < 2; ++ai)
#pragma unroll
                for (int m = 0; m < 4; ++m) { float* ab = AB + (size_t)(row0 + ai * HALF + m * 16) * 16 + 8 * fq;
                    *(f32x4*)ab = acc[ai][0][m][0]; *(f32x4*)(ab + 4) = acc[ai][0][m][1]; }
        }
    }
};
struct Epi2 {
    const bf16_t* Zb; const bf16_t* P; const float* bglu; bf16_t* YA;
    __device__ __forceinline__ void operator()(const f32x4 (&acc)[2][2][4][2], const Unit& u, int wr, int wc, int fr, int fq) const {
        const int row0 = u.pm * BM + wr * 64 + fr, col0 = u.pn * BM + wc * 32 + 8 * fq;
#pragma unroll
        for (int bj = 0; bj < 2; ++bj) { const int col = col0 + bj * HALF;
            const f32x4 b0 = *(const f32x4*)(bglu + col), b1 = *(const f32x4*)(bglu + col + 4);
#pragma unroll
            for (int ai = 0; ai < 2; ++ai)
#pragma unroll
                for (int m = 0; m < 4; ++m) { const size_t row = (size_t)(row0 + ai * HALF + m * 16);
                    float z[8], ga[8], o[8];
                    unpack8(*(const u32x4*)(Zb + row * 1024 + col), z); unpack8(*(const u32x4*)(P + row * NP + C_GA + col), ga);
                    const f32x4 v0 = acc[ai][bj][m][0] + b0, v1 = acc[ai][bj][m][1] + b1;
#pragma unroll
                    for (int e = 0; e < 4; ++e) { o[e] = z[e] * sigm(v0[e]) * silu(ga[e]); o[4 + e] = z[4 + e] * sigm(v1[e]) * silu(ga[4 + e]); }
                    *(u32x4*)(YA + row * 1024 + col) = pack8(o); } }
    }
};
struct Epi3 {
    const bf16_t* P; const float* bgate; float* M32; bf16_t* Mb;
    __device__ __forceinline__ void operator()(const f32x4 (&acc)[2][2][4][2], const Unit& u, int wr, int wc, int fr, int fq) const {
        const int row0 = u.pm * BM + wr * 64 + fr, col0 = u.pn * BM + wc * 32 + 8 * fq, br = u.br;
#pragma unroll
        for (int bj = 0; bj < 2; ++bj) { const int col = col0 + bj * HALF;
            const f32x4 g0 = *(const f32x4*)(bgate + br * DM + col), g1 = *(const f32x4*)(bgate + br * DM + col + 4);
#pragma unroll
            for (int ai = 0; ai < 2; ++ai)
#pragma unroll
                for (int m = 0; m < 4; ++m) { const size_t row = (size_t)(row0 + ai * HALF + m * 16);
                    float zg[8], o[8];
                    unpack8(*(const u32x4*)(P + row * NP + C_ZG + br * DM + col), zg);
                    const f32x4 a0 = acc[ai][bj][m][0], a1 = acc[ai][bj][m][1];
#pragma unroll
                    for (int e = 0; e < 4; ++e) { o[e] = sigm(zg[e] + g0[e]) * a0[e]; o[4 + e] = sigm(zg[4 + e] + g1[e]) * a1[e]; }
                    float* mp = M32 + row * DM + col;
                    if (br > 0) { const f32x4 p0 = *(const f32x4*)mp, p1 = *(const f32x4*)(mp + 4);
#pragma unroll
                        for (int e = 0; e < 4; ++e) { o[e] += p0[e]; o[4 + e] += p1[e]; } }
                    if (br < 2) { *(f32x4*)mp = (f32x4){o[0], o[1], o[2], o[3]}; *(f32x4*)(mp + 4) = (f32x4){o[4], o[5], o[6], o[7]}; }
                    else *(u32x4*)(Mb + row * DM + col) = pack8(o); } }
    }
};
struct Epi4 {
    const float* xp; const float* xs; float* H32;
    __device__ __forceinline__ void operator()(const f32x4 (&acc)[2][2][4][2], const Unit& u, int wr, int wc, int fr, int fq) const {
        const int row0 = u.pm * BM + wr * 64 + fr, col0 = u.pn * BM + wc * 32 + 8 * fq;
        const float* xb = (u.pm < 32) ? xp : (xs - (size_t)TP * DM);
#pragma unroll
        for (int ai = 0; ai < 2; ++ai)
#pragma unroll
            for (int m = 0; m < 4; ++m) { const size_t row = (size_t)(row0 + ai * HALF + m * 16);
#pragma unroll
                for (int bj = 0; bj < 2; ++bj) { const int col = col0 + bj * HALF;
                    const f32x4 x0 = *(const f32x4*)(xb + row * DM + col), x1 = *(const f32x4*)(xb + row * DM + col + 4);
                    *(f32x4*)(H32 + row * DM + col) = x0 * ALPHA + acc[ai][bj][m][0];
                    *(f32x4*)(H32 + row * DM + col + 4) = x1 * ALPHA + acc[ai][bj][m][1]; } }
    }
};
}

template <bool REMAP>
__device__ __forceinline__ void transpose_item(const float* W, int K, int Nsrc, int Ndst, bf16_t* WT, LAS float* scr, int item, int lane) {
    const int nblk = Ndst / 32, kb = item / nblk, nb = item % nblk, k0 = 64 * kb, n0 = 32 * nb;
    int d = n0 + (lane & 31), s = d; bool valid = true;
    if (REMAP) { if (d < C_GATEC) s = d; else if (d < C_AB) s = d + 16; else if (d < C_AB + 16) s = 8192 + (d - C_AB); else { s = 0; valid = false; } }
#pragma unroll 8
    for (int i = 0; i < 32; ++i) { const int kk = 2 * i + (lane >> 5); scr[kk * 33 + (lane & 31)] = valid ? W[(size_t)(k0 + kk) * Nsrc + s] : 0.f; }
    LDS_WAIT();
    const int c = lane & 7;
#pragma unroll
    for (int j = 0; j < 4; ++j) { const int n = (lane >> 3) + 8 * j; const LAS float* sp = scr + (8 * c) * 33 + n;
        u32x4 o; o.x = pk2(sp[0 * 33], sp[1 * 33]); o.y = pk2(sp[2 * 33], sp[3 * 33]); o.z = pk2(sp[4 * 33], sp[5 * 33]); o.w = pk2(sp[6 * 33], sp[7 * 33]);
        *(u32x4*)(WT + (size_t)(n0 + n) * K + k0 + 8 * c) = o; }
    LDS_WAIT();
}

__device__ __forceinline__ void phase_convert(CArgs& a, LAS unsigned char* lds, int G, int vb, const int tid) {
    const int lane = tid & 63, wave = tid >> 6;
    LAS float* scr = (LAS float*)(lds + wave * 16384);
    const int gw = vb * 8 + wave, NGW = G * 8;
    constexpr int I_IN = (DM / 64) * (NP / 32), I_GLU = (1024 / 64) * (1024 / 32), I_P = (1024 / 64) * (DM / 32), I_OUT = (DM / 64) * (DM / 32);
    constexpr int I_L = I_IN + I_GLU + 3 * I_P + I_OUT;
    for (int it = gw; it < 2 * I_L; it += NGW) {
        const int l = it / I_L; int r = it - l * I_L;
        unsigned char* wb = a.ws + WS_W0 + (size_t)l * WS_WL;
        if (r < I_IN) { transpose_item<true>(a.in[6] + (size_t)l * DM * NIN, DM, NIN, NP, (bf16_t*)(wb + WO_IN), scr, r, lane); continue; } r -= I_IN;
        if (r < I_GLU) { transpose_item<false>(a.in[16] + (size_t)l * 1024 * 1024, 1024, 1024, 1024, (bf16_t*)(wb + WO_GLU), scr, r, lane); continue; } r -= I_GLU;
        if (r < I_P) { transpose_item<false>(a.in[18] + (size_t)l * 1024 * DM, 1024, DM, DM, (bf16_t*)(wb + WO_PA), scr, r, lane); continue; } r -= I_P;
        if (r < I_P) { transpose_item<false>(a.in[23] + (size_t)l * 1024 * DM, 1024, DM, DM, (bf16_t*)(wb + WO_PB), scr, r, lane); continue; } r -= I_P;
        if (r < I_P) { transpose_item<false>(a.in[28] + (size_t)l * 1024 * DM, 1024, DM, DM, (bf16_t*)(wb + WO_PC), scr, r, lane); continue; } r -= I_P;
        transpose_item<false>(a.in[29] + (size_t)l * DM * DM, DM, DM, DM, (bf16_t*)(wb + WO_OUT), scr, r, lane);
    }
    bf16_t* Xb = (bf16_t*)(a.ws + WS_XB);
    for (int m = gw; m < MT; m += NGW) {
        const float* xr = (m < TP) ? a.in[0] + (size_t)m * DM : a.in[1] + (size_t)(m - TP) * DM;
        const f32x4* xv = (const f32x4*)xr + lane; u32x2* o = (u32x2*)(Xb + (size_t)m * DM) + lane;
#pragma unroll
        for (int j = 0; j < 8; ++j) { const f32x4 v = xv[64 * j]; u32x2 w; w.x = pk2(v.x, v.y); w.y = pk2(v.z, v.w); o[64 * j] = w; }
    }
}

__device__ __forceinline__ void phase_ln(CArgs& a, int layer, int G, int vb, const int tid) {
    const int lane = tid & 63, wave = tid >> 6;
    const int gw = vb * 8 + wave, NGW = G * 8;
    const float* H32 = (const float*)(a.ws + WS_H32);
    const float* lg = a.in[30] + layer * DM; const float* lb = a.in[31] + layer * DM;
    bf16_t* Xb = (bf16_t*)(a.ws + WS_XB);
    for (int m = gw; m < MT; m += NGW) {
        const f32x4* xv = (const f32x4*)(H32 + (size_t)m * DM) + lane;
        f32x4 v[8]; float s = 0.f;
#pragma unroll
        for (int j = 0; j < 8; ++j) { v[j] = xv[64 * j]; s += (v[j].x + v[j].y) + (v[j].z + v[j].w); }
        const float mean = wave_sum(s) * (1.f / DM); float s2 = 0.f;
#pragma unroll
        for (int j = 0; j < 8; ++j) { v[j] = v[j] - mean; s2 += (v[j].x * v[j].x + v[j].y * v[j].y) + (v[j].z * v[j].z + v[j].w * v[j].w); }
        const float rstd = 1.f / sqrtf(wave_sum(s2) * (1.f / DM) + 1e-5f);
        float* dst = (layer == 0) ? (float*)(a.ws + WS_X32) + (size_t)m * DM : (m < TP ? a.out + O_YP + (size_t)m * DM : a.out + O_YS + (size_t)(m - TP) * DM);
#pragma unroll
        for (int j = 0; j < 8; ++j) { const f32x4 gg = *((const f32x4*)lg + lane + 64 * j), bb = *((const f32x4*)lb + lane + 64 * j);
            const f32x4 y = v[j] * rstd * gg + bb; *((f32x4*)dst + lane + 64 * j) = y;
            if (layer == 0) { u32x2 w; w.x = pk2(y.x, y.y); w.y = pk2(y.z, y.w); *((u32x2*)(Xb + (size_t)m * DM) + lane + 64 * j) = w; } }
    }
}

constexpr int S5_BUS = 128;
constexpr int S5_SROW = 272;
constexpr int S5_UB = 32 * S5_BUS * 4 + 32 * S5_SROW;
constexpr int S5_WLDS = S5_UB + 1024;
template <bool SAMPLE>
__device__ __forceinline__ void s5_item(int layer, int item, int wlo, int lane) {
    CArgs& a = kargs(); LAS unsigned char* wl = lds_base() + wlo;
    const int g = SAMPLE ? item : (item & 63), b = SAMPLE ? 0 : (item >> 6);
    const float* lam_re = a.in[8] + layer * 4096 + g * 64; const float* lam_im = a.in[9] + layer * 4096 + g * 64;
    const float dt = expf(a.in[10][layer * 64 + g]);
    const float* b_re = a.in[11] + (size_t)(layer * 64 + g) * 1024; const float* b_im = a.in[12] + (size_t)(layer * 64 + g) * 1024;
    const float* c_re = a.in[13] + (size_t)(layer * 64 + g) * 1024; const float* c_im = a.in[14] + (size_t)(layer * 64 + g) * 1024;
    const f32x4 dch = *(const f32x4*)(a.in[15] + layer * 1024 + g * 16 + 4 * (lane >> 4));
    const bf16_t* P = (const bf16_t*)(a.ws + WS_P); bf16_t* Zb = (bf16_t*)(a.ws + WS_ZB);
    LAS float* BU = (LAS float*)wl; LAS unsigned char* Sb = wl + 32 * S5_BUS * 4; LAS unsigned char* Ub = wl + S5_UB;
    float ar, ai;
    { const float lr = lam_re[lane], li = lam_im[lane]; const float mag = expf(lr * dt); float sn, cs; sincosf(li * dt, &sn, &cs); ar = mag * cs; ai = mag * sn; }
    bf16x8 Bf[4];
    { const int h = lane >> 5;
#pragma unroll
      for (int q = 0; q < 2; ++q) { const int pp = q * 32 + (lane & 31);
        const float lr = lam_re[pp], li = lam_im[pp]; const float mag = expf(lr * dt); float sn, cs; sincosf(li * dt, &sn, &cs);
        const float abr = mag * cs, abi = mag * sn, den = lr * lr + li * li, nr = abr - 1.f, ni = abi;
        const float f_r = (nr * lr + ni * li) / den, f_i = (ni * lr - nr * li) / den;
        float br8[8], bi8[8], or8[8], oi8[8];
        *(f32x4*)&br8[0] = *(const f32x4*)(b_re + pp * 16 + 8 * h); *(f32x4*)&br8[4] = *(const f32x4*)(b_re + pp * 16 + 8 * h + 4);
        *(f32x4*)&bi8[0] = *(const f32x4*)(b_im + pp * 16 + 8 * h); *(f32x4*)&bi8[4] = *(const f32x4*)(b_im + pp * 16 + 8 * h + 4);
#pragma unroll
        for (int e = 0; e < 8; ++e) { or8[e] = f_r * br8[e] - f_i * bi8[e]; oi8[e] = f_r * bi8[e] + f_i * br8[e]; }
        Bf[q] = __builtin_bit_cast(bf16x8, pack8(or8)); Bf[2 + q] = __builtin_bit_cast(bf16x8, pack8(oi8)); } }
    bf16x8 Cf[4];
    { const int c = lane & 15;
#pragma unroll
      for (int ks = 0; ks < 4; ++ks) { const int p0 = 16 * ks + 4 * (lane >> 4);
        const f32x4 cr = *(const f32x4*)(c_re + c * 64 + p0), ci = *(const f32x4*)(c_im + c * 64 + p0);
        float o[8] = {cr[0], -ci[0], cr[1], -ci[1], cr[2], -ci[2], cr[3], -ci[3]};
        Cf[ks] = __builtin_bit_cast(bf16x8, pack8(o)); } }
    float sr = 0.f, si = 0.f;
    const int nsc = SAMPLE ? 16 : 64;
    const float* h_re = a.in[2] + (size_t)layer * 128 * 4096 + g * 64 + lane; const float* h_im = a.in[3] + (size_t)layer * 128 * 4096 + g * 64 + lane;
    float* o_re = a.out + O_SRS + (size_t)layer * 128 * 4096 + g * 64 + lane; float* o_im = a.out + O_SIS + (size_t)layer * 128 * 4096 + g * 64 + lane;
    const bf16_t* up = P + (size_t)((SAMPLE ? TP : b * 2048) + (lane & 31)) * NP + C_XA + g * 16 + 8 * (lane >> 5);
    bf16x8 Af = *(const bf16x8*)up;
    float hr[8], hi[8];
    if (SAMPLE) {
#pragma unroll
        for (int q = 0; q < 8; ++q) { hr[q] = h_re[(size_t)q * 4096]; hi[q] = h_im[(size_t)q * 4096]; } }
    for (int sc = 0; sc < nsc; ++sc) {
        const int row0 = SAMPLE ? TP + sc * 32 : b * 2048 + sc * 32;
        const bf16x8 Ac = Af;
        float hcr[8], hci[8];
        if (SAMPLE) {
#pragma unroll
            for (int q = 0; q < 8; ++q) { hcr[q] = hr[q]; hci[q] = hi[q]; } }
        if (sc + 1 < nsc) { Af = *(const bf16x8*)(up + (size_t)(sc + 1) * 32 * NP);
            if (SAMPLE) {
#pragma unroll
                for (int q = 0; q < 8; ++q) { hr[q] = h_re[(size_t)((sc + 1) * 8 + q) * 4096]; hi[q] = h_im[(size_t)((sc + 1) * 8 + q) * 4096]; } } }
        *(LAS bf16x8*)(Ub + (lane & 31) * 32 + 16 * (lane >> 5)) = Ac;
#pragma unroll
        for (int nb = 0; nb < 4; ++nb) {
            f32x16 acc;
#pragma unroll
            for (int r = 0; r < 16; ++r) acc[r] = 0.f;
            acc = __builtin_amdgcn_mfma_f32_32x32x16_bf16(Ac, Bf[nb], acc, 0, 0, 0);
#pragma unroll
            for (int r = 0; r < 16; ++r) { const int t = (r & 3) + 8 * (r >> 2) + 4 * (lane >> 5); BU[t * S5_BUS + 32 * nb + (lane & 31)] = acc[r]; }
        }
        LDS_WAIT();
#pragma unroll
        for (int t = 0; t < 32; ++t) {
            if (SAMPLE && (t & 3) == 0) { sr = hcr[t >> 2]; si = hci[t >> 2]; }
            const float bur = BU[t * S5_BUS + lane], bui = BU[t * S5_BUS + 64 + lane];
            const float nsr = ar * sr - ai * si + bur, nsi = ar * si + ai * sr + bui;
            sr = nsr; si = nsi;
            *(LAS unsigned*)(Sb + t * S5_SROW + 4 * lane) = pk2(sr, si);
            if (SAMPLE && (t & 3) == 3) { const int bi = sc * 8 + (t >> 2); o_re[(size_t)bi * 4096] = sr; o_im[(size_t)bi * 4096] = si; }
        }
        LDS_WAIT();
#pragma unroll
        for (int mb = 0; mb < 2; ++mb) {
            f32x4 y = (f32x4){0.f, 0.f, 0.f, 0.f};
#pragma unroll
            for (int ks = 0; ks < 4; ++ks) { const bf16x8 Sf = *(const LAS bf16x8*)(Sb + (16 * mb + (lane & 15)) * S5_SROW + 64 * ks + 16 * (lane >> 4));
                y = __builtin_amdgcn_mfma_f32_16x16x32_bf16(Cf[ks], Sf, y, 0, 0, 0); }
            const int tt = 16 * mb + (lane & 15);
            const u32x2 xw = *(const LAS u32x2*)(Ub + tt * 32 + 8 * (lane >> 4));
            u32x2 o; o.x = pk2(gelu_tanh(y[0] + dch[0] * bflo(xw.x)), gelu_tanh(y[1] + dch[1] * bfhi(xw.x)));
            o.y = pk2(gelu_tanh(y[2] + dch[2] * bflo(xw.y)), gelu_tanh(y[3] + dch[3] * bfhi(xw.y)));
            *(u32x2*)(Zb + (size_t)(row0 + tt) * 1024 + g * 16 + 4 * (lane >> 4)) = o;
        }
        LDS_WAIT();
    }
    if (!SAMPLE) { a.out[O_SRP + (size_t)((layer * 4 + b) * 64 + g) * 64 + lane] = sr; a.out[O_SIP + (size_t)((layer * 4 + b) * 64 + g) * 64 + lane] = si; }
}

constexpr int GM_TROW = 80;
__device__ __forceinline__ void gmlp_prompt_item(int layer, int item, const int tid) {
    CArgs& a = kargs(); LAS unsigned char* lds = lds_base();
    const int lane = tid & 63, w = __builtin_amdgcn_readfirstlane(tid >> 6);
    const bf16_t* P = (const bf16_t*)(a.ws + WS_P); bf16_t* YB = (bf16_t*)(a.ws + WS_YB);
    const float* lng = a.in[19] + layer * 1024; const float* lnb = a.in[20] + layer * 1024;
    const int r0 = item * 128, g = w;
    LAS f32x2* stats = (LAS f32x2*)lds;
    LAS unsigned char* vt = lds + 1024 + w * (16 * GM_TROW);
    __syncthreads();
    {
#pragma unroll 1
        for (int hb = 0; hb < 2; ++hb) {
        u32x4 raw[8][2];
#pragma unroll
        for (int i = 0; i < 8; ++i) { const bf16_t* rp = P + (size_t)(r0 + 16 * w + 8 * hb + i) * NP + C_VB + lane * 16; raw[i][0] = *(const u32x4*)rp; raw[i][1] = *(const u32x4*)(rp + 8); }
#pragma unroll
        for (int i = 0; i < 8; ++i) { float x[16]; { float t8[8]; unpack8(raw[i][0], t8);
#pragma unroll
                for (int e = 0; e < 8; ++e) x[e] = t8[e];
                unpack8(raw[i][1], t8);
#pragma unroll
                for (int e = 0; e < 8; ++e) x[8 + e] = t8[e]; }
            float s = 0.f;
#pragma unroll
            for (int e = 0; e < 16; ++e) s += x[e];
            const float mean = wave_sum(s) * (1.f / 1024.f); float s2 = 0.f;
#pragma unroll
            for (int e = 0; e < 16; ++e) { const float d = x[e] - mean; s2 += d * d; }
            const float rstd = 1.f / sqrtf(wave_sum(s2) * (1.f / 1024.f) + 1e-5f);
            if (lane == 0) stats[16 * w + 8 * hb + i] = (f32x2){mean, rstd}; }
        }
    }
    __syncthreads();
    bf16x8 Wf[20];
    { const float* Ws = a.in[21] + (size_t)(layer * 8 + g) * 128 * 128;
#pragma unroll
      for (int kb = 0; kb < 4; ++kb)
#pragma unroll
        for (int ib = 2 * kb; ib < 8; ++ib) { const int fi = (kb == 0 ? 0 : kb == 1 ? 8 : kb == 2 ? 14 : 18) + ib - 2 * kb;
            const int i = 16 * ib + (lane & 15), j0 = 32 * kb + 8 * (lane >> 4);
            const f32x4 w0 = *(const f32x4*)(Ws + i * 128 + j0), w1 = *(const f32x4*)(Ws + i * 128 + j0 + 4);
            float wv[8];
#pragma unroll
            for (int e = 0; e < 8; ++e) { const float x = e < 4 ? w0[e & 3] : w1[e & 3]; wv[e] = (j0 + e <= i) ? x : 0.f; }
            Wf[fi] = __builtin_bit_cast(bf16x8, pack8(wv));
            if ((fi & 3) == 3) __builtin_amdgcn_sched_barrier(0); } }
    const float* bsp = a.in[22] + (size_t)(layer * 8 + g) * 128;
#pragma unroll 1
    for (int rnd = 0; rnd < 8; ++rnd) {
        const int cbase = g * 128 + rnd * 16;
        f32x4 acc[8];
#pragma unroll
        for (int ib = 0; ib < 8; ++ib) acc[ib] = (f32x4){0.f, 0.f, 0.f, 0.f};
        const int cg = lane & 1, j = lane >> 1;
        u32x4 raw[4];
#pragma unroll
        for (int kb = 0; kb < 4; ++kb) raw[kb] = *(const u32x4*)(P + (size_t)(r0 + 32 * kb + j) * NP + C_VB + cbase + cg * 8);
        const f32x4 g0 = *(const f32x4*)(lng + cbase + cg * 8), g1 = *(const f32x4*)(lng + cbase + cg * 8 + 4);
        const f32x4 b0 = *(const f32x4*)(lnb + cbase + cg * 8), b1 = *(const f32x4*)(lnb + cbase + cg * 8 + 4);
#pragma unroll
        for (int kb = 0; kb < 4; ++kb) {
            { float x[8]; unpack8(raw[kb], x);
              const f32x2 st = stats[32 * kb + j];
#pragma unroll
              for (int e = 0; e < 8; ++e) { const float gg = e < 4 ? g0[e & 3] : g1[e & 3], bb = e < 4 ? b0[e & 3] : b1[e & 3];
                  const float v = (x[e] - st.x) * st.y * gg + bb;
                  *(LAS bf16_t*)(vt + (cg * 8 + e) * GM_TROW + 2 * j) = (bf16_t)f2bf(v); } }
            LDS_WAIT();
            const bf16x8 Af = *(const LAS bf16x8*)(vt + (lane & 15) * GM_TROW + 16 * (lane >> 4));
#pragma unroll
            for (int ib = 2 * kb; ib < 8; ++ib) { const int fi = (kb == 0 ? 0 : kb == 1 ? 8 : kb == 2 ? 14 : 18) + ib - 2 * kb;
                acc[ib] = __builtin_amdgcn_mfma_f32_16x16x32_bf16(Af, Wf[fi], acc[ib], 0, 0, 0); }
            LDS_WAIT();
        }
#pragma unroll
        for (int ib = 0; ib < 8; ++ib) { const int i = 16 * ib + (lane & 15); const float bs = bsp[i]; const size_t row = (size_t)(r0 + i);
            const int ch = cbase + 4 * (lane >> 4);
            const u32x2 uw = *(const u32x2*)(P + row * NP + C_UB + ch), gw = *(const u32x2*)(P + row * NP + C_GB + ch);
            const f32x4 s = acc[ib] + bs;
            u32x2 o; o.x = pk2(bflo(uw.x) * s[0] * silu(bflo(gw.x)), bfhi(uw.x) * s[1] * silu(bfhi(gw.x)));
            o.y = pk2(bflo(uw.y) * s[2] * silu(bflo(gw.y)), bfhi(uw.y) * s[3] * silu(bfhi(gw.y)));
            *(u32x2*)(YB + row * 1024 + ch) = o; }
    }
}
__device__ __forceinline__ void gmlp_sample_item(int layer, int b, int lane) {
    CArgs& a = kargs();
    const bf16_t* P = (const bf16_t*)(a.ws + WS_P); bf16_t* YB = (bf16_t*)(a.ws + WS_YB);
    const float* lng = a.in[19] + layer * 1024 + lane * 16; const float* lnb = a.in[20] + layer * 1024 + lane * 16;
    const int g = lane >> 3;
    const float* Ws = a.in[21] + (size_t)(layer * 8 + g) * 128 * 128; const float* bsp = a.in[22] + (size_t)(layer * 8 + g) * 128;
    float vn[4][16];
#pragma unroll
    for (int t = 0; t < 4; ++t) { const size_t row = (size_t)(TP + b * 4 + t); const bf16_t* rp = P + row * NP + C_VB + lane * 16;
        float x[16]; { float t8[8]; unpack8(*(const u32x4*)rp, t8);
#pragma unroll
            for (int e = 0; e < 8; ++e) x[e] = t8[e];
            unpack8(*(const u32x4*)(rp + 8), t8);
#pragma unroll
            for (int e = 0; e < 8; ++e) x[8 + e] = t8[e]; }
        float s = 0.f;
#pragma unroll
        for (int e = 0; e < 16; ++e) s += x[e];
        const float mean = wave_sum(s) * (1.f / 1024.f); float s2 = 0.f;
#pragma unroll
        for (int e = 0; e < 16; ++e) { const float d = x[e] - mean; s2 += d * d; }
        const float rstd = 1.f / sqrtf(wave_sum(s2) * (1.f / 1024.f) + 1e-5f);
        float* ov = a.out + O_GV + ((size_t)(layer * 128 + b) * 4 + t) * 1024 + lane * 16;
#pragma unroll
        for (int e = 0; e < 16; ++e) vn[t][e] = (x[e] - mean) * rstd * lng[e] + lnb[e];
#pragma unroll
        for (int e = 0; e < 16; e += 4) *(f32x4*)(ov + e) = (f32x4){vn[t][e], vn[t][e + 1], vn[t][e + 2], vn[t][e + 3]}; }
#pragma unroll
    for (int i = 0; i < 4; ++i) { const size_t row = (size_t)(TP + b * 4 + i);
        float s[16]; const float bs = bsp[i];
#pragma unroll
        for (int e = 0; e < 16; ++e) s[e] = bs;
#pragma unroll
        for (int j = 0; j < 4; ++j) if (j <= i) { const float wv = Ws[i * 128 + j];
#pragma unroll
            for (int e = 0; e < 16; ++e) s[e] += wv * vn[j][e]; }
        float ub[16], gb[16];
        { float t8[8]; unpack8(*(const u32x4*)(P + row * NP + C_UB + lane * 16), t8);
#pragma unroll
          for (int e = 0; e < 8; ++e) ub[e] = t8[e];
          unpack8(*(const u32x4*)(P + row * NP + C_UB + lane * 16 + 8), t8);
#pragma unroll
          for (int e = 0; e < 8; ++e) ub[8 + e] = t8[e];
          unpack8(*(const u32x4*)(P + row * NP + C_GB + lane * 16), t8);
#pragma unroll
          for (int e = 0; e < 8; ++e) gb[e] = t8[e];
          unpack8(*(const u32x4*)(P + row * NP + C_GB + lane * 16 + 8), t8);
#pragma unroll
          for (int e = 0; e < 8; ++e) gb[8 + e] = t8[e]; }
        float o0[8], o1[8];
#pragma unroll
        for (int e = 0; e < 8; ++e) { o0[e] = ub[e] * s[e] * silu(gb[e]); o1[e] = ub[8 + e] * s[8 + e] * silu(gb[8 + e]); }
        *(u32x4*)(YB + row * 1024 + lane * 16) = pack8(o0); *(u32x4*)(YB + row * 1024 + lane * 16 + 8) = pack8(o1); }
}

template <bool SAMPLE>
__device__ __forceinline__ void gdn_item_v1(int layer, int item, const int tid) {
    CArgs& a = kargs(); LAS unsigned char* lds = lds_base();
    const int lane = tid & 63, w = tid >> 6;
    const int b = item >> 3, h = item & 7;
    const int T = SAMPLE ? 4 : 2048, rbase = SAMPLE ? TP + b * 4 : b * 2048, NB = SAMPLE ? 128 : 4;
    const bf16_t* P = (const bf16_t*)(a.ws + WS_P); const float* AB = (const float*)(a.ws + WS_AB); bf16_t* YC = (bf16_t*)(a.ws + WS_YC);
    const float* convw = a.in[24] + (size_t)layer * 4 * 3072;
    const float* sconv = a.in[5] + (size_t)(layer * 128 + b) * 3 * 3072;
    LAS float* qs = (LAS float*)lds; LAS float* ks = qs + 64 * 128; LAS float* vs = ks + 64 * 128;
    LAS float* red = vs + 64 * 128; LAS float* red2 = red + 512; LAS float* av = red2 + 512; LAS float* bv = av + 64;
    const int dv = (w & 1) * 64 + lane, sl = w >> 1, dk0 = sl * 32;
    float S[32];
    if (SAMPLE) { const float* s0 = a.in[4] + ((size_t)((layer * 128 + b) * 8 + h) * 128 + dk0) * 128 + dv;
#pragma unroll
        for (int i = 0; i < 32; ++i) S[i] = s0[(size_t)i * 128]; }
    else {
#pragma unroll
        for (int i = 0; i < 32; ++i) S[i] = 0.f; }
    const float Aexp = expf(a.in[25][layer * 8 + h]), dtb = a.in[26][layer * 8 + h];
    for (int c0 = 0; c0 < T; c0 += 64) {
        const int n = (T - c0) < 64 ? (T - c0) : 64;
        __syncthreads();
        for (int idx = tid; idx < n * 384; idx += 512) {
            const int t = idx / 384, ch = idx - t * 384, sec = ch >> 7, cc = ch & 127, col = sec * 1024 + h * 128 + cc, tg = c0 + t;
            float accv = 0.f;
#pragma unroll
            for (int j = 0; j < 4; ++j) { const int tt = tg - 3 + j; float x;
                if (tt >= 0) x = bf2f(P[(size_t)(rbase + tt) * NP + C_QKV + col]);
                else x = SAMPLE ? sconv[(3 + tt) * 3072 + col] : 0.f;
                accv += convw[j * 3072 + col] * x; }
            const float y = silu(accv);
            LAS float* dst = sec == 0 ? qs : (sec == 1 ? ks : vs); dst[t * 128 + cc] = y;
        }
        if (tid < n) { const size_t row = (size_t)(rbase + c0 + tid); const float ac = AB[row * 16 + h], bc = AB[row * 16 + 8 + h];
            const float gg = -Aexp * softplus(ac + dtb); av[tid] = expf(gg); bv[tid] = sigm(bc); }
        __syncthreads();
        for (int t = w; t < n; t += 8) {
            { const float q0 = qs[t * 128 + lane], q1 = qs[t * 128 + 64 + lane]; const float ss = wave_sum(q0 * q0 + q1 * q1);
              const float r = (1.f / sqrtf(ss + 1e-6f)) * 0.08838834764831845f; qs[t * 128 + lane] = q0 * r; qs[t * 128 + 64 + lane] = q1 * r; }
            { const float k0 = ks[t * 128 + lane], k1 = ks[t * 128 + 64 + lane]; const float ss = wave_sum(k0 * k0 + k1 * k1);
              const float r = 1.f / sqrtf(ss + 1e-6f); ks[t * 128 + lane] = k0 * r; ks[t * 128 + 64 + lane] = k1 * r; }
        }
        __syncthreads();
        for (int t = 0; t < n; ++t) {
            const float at = av[t], bt = bv[t];
            float p = 0.f;
#pragma unroll
            for (int i = 0; i < 32; i += 4) { const f32x4 kk = *(const LAS f32x4*)(ks + t * 128 + dk0 + i);
                p += kk[0] * S[i] + kk[1] * S[i + 1] + kk[2] * S[i + 2] + kk[3] * S[i + 3]; }
            red[sl * 128 + dv] = p;
            __syncthreads();
            const float kS = (red[dv] + red[128 + dv]) + (red[256 + dv] + red[384 + dv]);
            const float vnew = bt * (vs[t * 128 + dv] - at * kS);
            float po = 0.f;
#pragma unroll
            for (int i = 0; i < 32; i += 4) { const f32x4 kk = *(const LAS f32x4*)(ks + t * 128 + dk0 + i), qq = *(const LAS f32x4*)(qs + t * 128 + dk0 + i);
#pragma unroll
                for (int e = 0; e < 4; ++e) { S[i + e] = at * S[i + e] + kk[e] * vnew; po += qq[e] * S[i + e]; } }
            red2[sl * 128 + dv] = po;
            __syncthreads();
            if (sl == 0) vs[t * 128 + dv] = (red2[dv] + red2[128 + dv]) + (red2[256 + dv] + red2[384 + dv]);
        }
        __syncthreads();
        const float* ng = a.in[27] + layer * 128;
        for (int t = w; t < n; t += 8) {
            const float o0 = vs[t * 128 + lane], o1 = vs[t * 128 + 64 + lane]; const float ss = wave_sum(o0 * o0 + o1 * o1);
            const float r = 1.f / sqrtf(ss * (1.f / 128.f) + 1e-6f); const size_t row = (size_t)(rbase + c0 + t);
            const float g0 = bf2f(P[row * NP + C_GATEC + h * 128 + lane]), g1 = bf2f(P[row * NP + C_GATEC + h * 128 + 64 + lane]);
            YC[row * 1024 + h * 128 + lane] = (bf16_t)f2bf(o0 * r * ng[lane] * silu(g0));
            YC[row * 1024 + h * 128 + 64 + lane] = (bf16_t)f2bf(o1 * r * ng[64 + lane] * silu(g1));
        }
    }
    { float* so = a.out + (SAMPLE ? O_DS : O_DP) + ((size_t)((layer * NB + b) * 8 + h) * 128 + dk0) * 128 + dv;
#pragma unroll
      for (int i = 0; i < 32; ++i) so[(size_t)i * 128] = S[i]; }
    { float* co = a.out + (SAMPLE ? O_CS : O_CP) + (size_t)(layer * NB + b) * 3 * 3072;
      for (int idx = tid; idx < 3 * 384; idx += 512) { const int r = idx / 384, ch = idx - r * 384, col = (ch >> 7) * 1024 + h * 128 + (ch & 127);
          co[r * 3072 + col] = bf2f(P[(size_t)(rbase + T - 3 + r) * NP + C_QKV + col]); } }
}


constexpr size_t WS_GC = WS_M32;
constexpr int GC_STRIDE = 98304, GC_WN = 0, GC_QG = 16384, GC_KG = 32768, GC_AT = 49152, GC_U = 57344, GC_GAMMA = 90112, GC_OPS = 57344;
static_assert(WS_GC + (size_t)1024 * GC_STRIDE <= WS_H32, "chunk buffers fit in the M32|MB overlay");
constexpr int GP_QR = 0, GP_KR = 17408, GP_KBR = 34816, GP_VT = 52224, GP_KGT = 70656, GP_KT2 = 89088, GP_LM = 107520, GP_TM = 124928, GP_AS = 134144,
              GP_GC = 143360, GP_BETA = 143616, GP_GRAW = 143872, GP_WST = 0;
#define MFMA32(a, b, c) __builtin_amdgcn_mfma_f32_32x32x16_bf16((a), (b), (c), 0, 0, 0)

__device__ __forceinline__ void gdn_prep_item(int layer, int item, const int tid) {
    CArgs& a = kargs(); LAS unsigned char* lds = lds_base();
    const int lane = tid & 63, w = __builtin_amdgcn_readfirstlane(tid >> 6), hh = lane >> 5, l31 = lane & 31;
    const int b = item >> 8, h = (item >> 5) & 7, n = item & 31;
    const bf16_t* P = (const bf16_t*)(a.ws + WS_P); const float* AB = (const float*)(a.ws + WS_AB);
    unsigned char* gc = a.ws + WS_GC + (size_t)item * GC_STRIDE;
    const int t = tid >> 3, cg = tid & 7;
    const int r0 = b * 2048 + n * 64;
    __syncthreads();
    float qv[16], kv[16], vv[16];
    {
        const float* convw = a.in[24] + (size_t)layer * 4 * 3072;
#pragma unroll
        for (int sec = 0; sec < 3; ++sec) {
            const int ch = sec * 1024 + h * 128 + 16 * cg;
            float acc[16];
#pragma unroll
            for (int e = 0; e < 16; ++e) acc[e] = 0.f;
#pragma unroll
            for (int j = 0; j < 4; ++j) {
                const int tt = n * 64 + t - 3 + j; const float msk = tt < 0 ? 0.f : 1.f;
                float x[16];
                { const bf16_t* rp = P + (size_t)(b * 2048 + (tt < 0 ? 0 : tt)) * NP + C_QKV + ch; float t8[8];
                    unpack8(*(const u32x4*)rp, t8);
#pragma unroll
                    for (int e = 0; e < 8; ++e) x[e] = t8[e];
                    unpack8(*(const u32x4*)(rp + 8), t8);
#pragma unroll
                    for (int e = 0; e < 8; ++e) x[8 + e] = t8[e]; }
                const float* wp = convw + j * 3072 + ch;
#pragma unroll
                for (int e = 0; e < 16; e += 4) { const f32x4 wv = *(const f32x4*)(wp + e) * msk;
                    acc[e] += wv[0] * x[e]; acc[e + 1] += wv[1] * x[e + 1]; acc[e + 2] += wv[2] * x[e + 2]; acc[e + 3] += wv[3] * x[e + 3]; }
                if (j == 3 && n == 31 && t >= 61) { float* co = a.out + O_CP + ((size_t)(layer * 4 + b) * 3 + (t - 61)) * 3072 + ch;
#pragma unroll
                    for (int e = 0; e < 16; e += 4) *(f32x4*)(co + e) = (f32x4){x[e], x[e + 1], x[e + 2], x[e + 3]}; }
            }
            float ss = 0.f;
#pragma unroll
            for (int e = 0; e < 16; ++e) { acc[e] = silu(acc[e]); ss += acc[e] * acc[e]; }
            if (sec < 2) { ss += __shfl_xor(ss, 1); ss += __shfl_xor(ss, 2); ss += __shfl_xor(ss, 4);
                const float r = (1.f / sqrtf(ss + 1e-6f)) * (sec == 0 ? 0.08838834764831845f : 1.f);
#pragma unroll
                for (int e = 0; e < 16; ++e) { if (sec == 0) qv[e] = acc[e] * r; else kv[e] = acc[e] * r; } }
            else {
#pragma unroll
                for (int e = 0; e < 16; ++e) vv[e] = acc[e]; }
        }
        if (cg == 0) { const size_t row = (size_t)(r0 + t); const float ac = AB[row * 16 + h], bc = AB[row * 16 + 8 + h];
            const float Aexp = expf(a.in[25][layer * 8 + h]), dtb = a.in[26][layer * 8 + h];
            *(LAS float*)(lds + GP_GRAW + 4 * t) = -Aexp * softplus(ac + dtb); *(LAS float*)(lds + GP_BETA + 4 * t) = sigm(bc); }
    }
    __syncthreads();
    if (w == 0) { float g = *(LAS float*)(lds + GP_GRAW + 4 * lane);
#pragma unroll
        for (int o = 1; o < 64; o <<= 1) { const float y = __shfl_up(g, o); if (lane >= o) g += y; }
        *(LAS float*)(lds + GP_GC + 4 * lane) = g; }
    __syncthreads();
    {
        const float gct = *(LAS float*)(lds + GP_GC + 4 * t), bt = *(LAS float*)(lds + GP_BETA + 4 * t), gl = *(LAS float*)(lds + GP_GC + 4 * 63);
        const float eg = expf(gct), egl = expf(gl - gct);
        float tq[8], tk[8], tb[8];
#pragma unroll
        for (int half = 0; half < 2; ++half) {
#pragma unroll
            for (int e = 0; e < 8; ++e) { tq[e] = qv[8 * half + e]; tk[e] = kv[8 * half + e]; tb[e] = kv[8 * half + e] * bt; }
            *(LAS u32x4*)(lds + GP_QR + t * 272 + (16 * cg + 8 * half) * 2) = pack8(tq);
            *(LAS u32x4*)(lds + GP_KR + t * 272 + (16 * cg + 8 * half) * 2) = pack8(tk);
            *(LAS u32x4*)(lds + GP_KBR + t * 272 + (16 * cg + 8 * half) * 2) = pack8(tb);
        }
#pragma unroll
        for (int d = 0; d < 16; ++d) { const int rowd = 16 * cg + d;
            *(LAS bf16_t*)(lds + GP_VT + rowd * 144 + 2 * t) = (bf16_t)f2bf(vv[d] * bt);
            *(LAS bf16_t*)(lds + GP_KGT + rowd * 144 + 2 * t) = (bf16_t)f2bf(kv[d] * bt * eg);
            *(LAS bf16_t*)(lds + GP_KT2 + rowd * 144 + 2 * t) = (bf16_t)f2bf(kv[d] * egl); }
#pragma unroll
        for (int hq = 0; hq < 2; ++hq) { float o8[8];
#pragma unroll
            for (int j = 0; j < 8; ++j) o8[j] = qv[8 * (j >> 2) + 4 * hq + (j & 3)] * eg;
            *(u32x4*)(gc + GC_QG + ((((t >> 5) * 4 + (cg >> 1)) * 2 + (cg & 1)) * 64 + (t & 31) + 32 * hq) * 16) = pack8(o8); }
        if (tid == 0) *(float*)(gc + GC_GAMMA) = expf(gl);
    }
    __syncthreads();
    {
        const int typ = w >> 2, mi = (w >> 1) & 1, nj = w & 1;
        f32x16 acc;
#pragma unroll
        for (int r = 0; r < 16; ++r) acc[r] = 0.f;
        if (!(mi == 0 && nj == 1)) {
            const LAS unsigned char* Ab = lds + (typ ? GP_QR : GP_KBR) + (32 * mi + l31) * 272 + 16 * hh;
            const LAS unsigned char* Bb = lds + GP_KR + (32 * nj + l31) * 272 + 16 * hh;
#pragma unroll
            for (int ks = 0; ks < 8; ++ks) acc = MFMA32(*(const LAS bf16x8*)(Ab + 32 * ks), *(const LAS bf16x8*)(Bb + 32 * ks), acc);
        }
        const int j = 32 * nj + l31; const float gcj = *(LAS float*)(lds + GP_GC + 4 * j);
#pragma unroll
        for (int r = 0; r < 16; ++r) { const int i = 32 * mi + (r & 3) + 8 * (r >> 2) + 4 * hh;
            const float gci = *(LAS float*)(lds + GP_GC + 4 * i);
            const float d = (i >= j) ? expf(gci - gcj) : 0.f;
            if (typ == 0) *(LAS float*)(lds + GP_LM + i * 272 + 4 * j) = (i > j) ? acc[r] * d : 0.f;
            else *(LAS bf16_t*)(lds + GP_AS + i * 144 + 2 * j) = (bf16_t)f2bf((i >= j) ? acc[r] * d : 0.f); }
    }
    __syncthreads();
    if (w == 0) {
        float x[64];
        f32x4 cur[16], nxt[16];
        x[0] = (lane == 0) ? 1.f : 0.f;
        cur[0] = *(const LAS f32x4*)(lds + GP_LM + 1 * 272);
#pragma unroll
        for (int i = 1; i < 64; ++i) {
            if (i + 1 < 64) {
#pragma unroll
                for (int j4 = 0; j4 < (i + 4) / 4; ++j4) nxt[j4] = *(const LAS f32x4*)(lds + GP_LM + (i + 1) * 272 + 16 * j4);
            }
            __builtin_amdgcn_sched_barrier(0);
            float s0 = (i == lane) ? 1.f : 0.f, s1 = 0.f, s2 = 0.f, s3 = 0.f;
#pragma unroll
            for (int j4 = 0; j4 < (i + 3) / 4; ++j4) {
#pragma unroll
                for (int e = 0; e < 4; ++e) { const int j = 4 * j4 + e; if (j < i) { const float p = cur[j4][e] * x[j];
                    if (e == 0) s0 -= p; else if (e == 1) s1 -= p; else if (e == 2) s2 -= p; else s3 -= p; } } }
            x[i] = (s0 + s1) + (s2 + s3);
            __builtin_amdgcn_sched_barrier(0);
            if (i + 1 < 64) {
#pragma unroll
                for (int j4 = 0; j4 < (i + 4) / 4; ++j4) cur[j4] = nxt[j4];
            }
        }
#pragma unroll
        for (int i = 0; i < 64; ++i) *(LAS bf16_t*)(lds + GP_TM + i * 144 + 2 * lane) = (bf16_t)f2bf(x[i]);
    } else {
        for (int task = tid - 64; task < 1536; task += 448) {
            const int ll = task & 63, hq = ll >> 5;
            if (task < 1024) { const int f = task >> 6, db = f >> 2, tb = (f >> 1) & 1, s = f & 1, dk = 32 * db + (ll & 31), t0 = 32 * tb + 16 * s + 4 * hq;
                const u32x2 lo = *(const LAS u32x2*)(lds + GP_KT2 + dk * 144 + 2 * t0), hi = *(const LAS u32x2*)(lds + GP_KT2 + dk * 144 + 2 * (t0 + 8));
                *(u32x4*)(gc + GC_KG + (f * 64 + ll) * 16) = (u32x4){lo.x, lo.y, hi.x, hi.y}; }
            else { const int f = (task - 1024) >> 6, mb = f >> 2, tb = (f >> 1) & 1, s = f & 1, i = 32 * mb + (ll & 31), j0 = 32 * tb + 16 * s + 4 * hq;
                const u32x2 lo = *(const LAS u32x2*)(lds + GP_AS + i * 144 + 2 * j0), hi = *(const LAS u32x2*)(lds + GP_AS + i * 144 + 2 * (j0 + 8));
                *(u32x4*)(gc + GC_AT + (f * 64 + ll) * 16) = (u32x4){lo.x, lo.y, hi.x, hi.y}; }
        }
    }
    __syncthreads();
    {
        const LAS unsigned char* Bb = lds + (w < 4 ? GP_VT : GP_KGT) + (32 * (w & 3) + l31) * 144 + 16 * hh;
#pragma unroll
        for (int mb = 0; mb < 2; ++mb) {
            f32x16 acc;
#pragma unroll
            for (int r = 0; r < 16; ++r) acc[r] = 0.f;
            const LAS unsigned char* Ab = lds + GP_TM + (32 * mb + l31) * 144 + 16 * hh;
#pragma unroll
            for (int ks = 0; ks < 4; ++ks) acc = MFMA32(*(const LAS bf16x8*)(Ab + 32 * ks), *(const LAS bf16x8*)(Bb + 32 * ks), acc);
            if (w < 4) { unsigned* up = (unsigned*)(gc + GC_U) + ((w * 2 + mb) * 8) * 64 + lane;
#pragma unroll
                for (int q = 0; q < 8; ++q) up[q * 64] = pk2(acc[2 * q], acc[2 * q + 1]); }
            else {
#pragma unroll
                for (int r = 0; r < 16; ++r) { const int tt = 32 * mb + (r & 3) + 8 * (r >> 2) + 4 * hh;
                    *(LAS bf16_t*)(lds + GP_WST + tt * 272 + 2 * (32 * (w - 4) + l31)) = (bf16_t)f2bf(-acc[r]); } }
        }
    }
    __syncthreads();
#pragma unroll
    for (int q = 0; q < 2; ++q) { const int task = tid + 512 * q, f = task >> 6, ll = task & 63, hq = ll >> 5, mb = f >> 3, kb = (f >> 1) & 3, s = f & 1;
        const int tt = 32 * mb + (ll & 31), d0 = 32 * kb + 16 * s + 4 * hq;
        const u32x2 lo = *(const LAS u32x2*)(lds + GP_WST + tt * 272 + 2 * d0), hi = *(const LAS u32x2*)(lds + GP_WST + tt * 272 + 2 * (d0 + 8));
        *(u32x4*)(gc + GC_WN + (f * 64 + ll) * 16) = (u32x4){lo.x, lo.y, hi.x, hi.y}; }
}

__device__ __forceinline__ bf16x8 cvt_frag(const f32x16& v, int s) {
    u32x4 w; w.x = pk2(v[8 * s], v[8 * s + 1]); w.y = pk2(v[8 * s + 2], v[8 * s + 3]); w.z = pk2(v[8 * s + 4], v[8 * s + 5]); w.w = pk2(v[8 * s + 6], v[8 * s + 7]);
    return __builtin_bit_cast(bf16x8, w);
}
constexpr int CH_OB = 2 * GC_OPS;
#define CH_LOAD(dst, cidx) do { const unsigned char* _s = gcb + (size_t)(cidx) * GC_STRIDE + lt * 16; _Pragma("unroll") for (int _i = 0; _i < 14; ++_i) dst[_i] = *(const u32x4*)(_s + _i * 4096); } while (0)
#define CH_WRITE(src, bufi) do { LAS unsigned char* _d = lds + (bufi) * GC_OPS + lt * 16; _Pragma("unroll") for (int _i = 0; _i < 14; ++_i) *(LAS u32x4*)(_d + _i * 4096) = src[_i]; } while (0)
#define CH_GATE(dst, cidx) do { const bf16_t* _g = P + (size_t)(b * 2048 + (cidx) * 64 + (lt >> 4) * 4) * NP + C_GATEC + h * 128 + (lt & 15) * 8; _Pragma("unroll") for (int _q = 0; _q < 4; ++_q) dst[_q] = *(const u32x4*)(_g + (size_t)_q * NP); } while (0)
#define CH_ULOAD(dst, cidx) do { const unsigned* _u = (const unsigned*)(gcb + (size_t)(cidx) * GC_STRIDE + GC_U) + (w * 2 * 8) * 64 + lane; \
    _Pragma("unroll") for (int _m = 0; _m < 2; ++_m) _Pragma("unroll") for (int _q = 0; _q < 8; ++_q) dst[_m][_q] = _u[(_m * 8 + _q) * 64]; } while (0)
__device__ __forceinline__ void gdn_chain(int layer, int bh, const int tid) {
    CArgs& a = kargs(); LAS unsigned char* lds = lds_base();
    const int lane = tid & 63, w = __builtin_amdgcn_readfirstlane(tid >> 6), hh = lane >> 5, l31 = lane & 31;
    const int b = bh >> 3, h = bh & 7;
    const unsigned char* gcb = a.ws + WS_GC + (size_t)bh * 32 * GC_STRIDE;
    __syncthreads();
    if (w >= 4) {
        const int lt = tid - 256;
        const bf16_t* P = (const bf16_t*)(a.ws + WS_P); bf16_t* YC = (bf16_t*)(a.ws + WS_YC);
        float ngv[8]; { const float* ng = a.in[27] + layer * 128 + (lt & 15) * 8; const f32x4 n0 = *(const f32x4*)ng, n1 = *(const f32x4*)(ng + 4);
#pragma unroll
            for (int e = 0; e < 4; ++e) { ngv[e] = n0[e]; ngv[4 + e] = n1[e]; } }
        u32x4 ra[14], rb[14], gt[4];
        CH_LOAD(ra, 0); CH_LOAD(rb, 1);
        CH_WRITE(ra, 0);
        CH_LOAD(ra, 2);
        CH_GATE(gt, 0);
        __syncthreads();
#define CH_FINISH(cc) do { const int t0 = (lt >> 4) * 4, dg = lt & 15; \
            _Pragma("unroll") for (int q = 0; q < 4; ++q) { float t8[8], g8[8], o8[8]; \
                unpack8(*(const LAS u32x4*)(lds + CH_OB + ((cc) & 1) * 16384 + (t0 + q) * 256 + dg * 16), t8); unpack8(gt[q], g8); float ss = 0.f; \
                _Pragma("unroll") for (int e = 0; e < 8; ++e) ss += t8[e] * t8[e]; \
                ss += __shfl_xor(ss, 1); ss += __shfl_xor(ss, 2); ss += __shfl_xor(ss, 4); ss += __shfl_xor(ss, 8); \
                const float r = 1.f / sqrtf(ss * (1.f / 128.f) + 1e-6f); \
                _Pragma("unroll") for (int e = 0; e < 8; ++e) o8[e] = t8[e] * r * ngv[e] * silu(g8[e]); \
                *(u32x4*)(YC + (size_t)(b * 2048 + (cc) * 64 + t0 + q) * 1024 + h * 128 + dg * 8) = pack8(o8); } } while (0)
        for (int c = 0; c < 32; c += 2) {
            if (c >= 1) { CH_FINISH(c - 1); CH_GATE(gt, c); }
            CH_WRITE(rb, 1);
            if (c + 3 < 32) CH_LOAD(rb, c + 3);
            __syncthreads();
            CH_FINISH(c); CH_GATE(gt, c + 1);
            if (c + 2 < 32) { CH_WRITE(ra, 0); }
            if (c + 4 < 32) CH_LOAD(ra, c + 4);
            __syncthreads();
        }
        CH_FINISH(31);
    } else {
        f32x16 S[4];
#pragma unroll
        for (int kb = 0; kb < 4; ++kb)
#pragma unroll
            for (int r = 0; r < 16; ++r) S[kb][r] = 0.f;
        const float gam_all = (lane < 32) ? *(const float*)(gcb + (size_t)lane * GC_STRIDE + GC_GAMMA) : 0.f;
        unsigned ua[2][8], ub[2][8];
        CH_ULOAD(ua, 0); CH_ULOAD(ub, 1);
        __syncthreads();
#define CH_STEP(c, ucur) do { \
            const LAS unsigned char* ops = lds + ((c) & 1) * GC_OPS + lane * 16; \
            const float gamma = __shfl(gam_all, (c)); \
            f32x16 va[2], oa[2]; \
            _Pragma("unroll") for (int mb = 0; mb < 2; ++mb) _Pragma("unroll") for (int q = 0; q < 8; ++q) { va[mb][2 * q] = bflo(ucur[mb][q]); va[mb][2 * q + 1] = bfhi(ucur[mb][q]); } \
            _Pragma("unroll") for (int r = 0; r < 16; ++r) { oa[0][r] = 0.f; oa[1][r] = 0.f; } \
            if ((c) + 2 < 32) CH_ULOAD(ucur, (c) + 2); \
            _Pragma("unroll") for (int kb = 0; kb < 4; ++kb) _Pragma("unroll") for (int s = 0; s < 2; ++s) { const bf16x8 Bs = cvt_frag(S[kb], s); \
                _Pragma("unroll") for (int mb = 0; mb < 2; ++mb) { const int f = (mb * 4 + kb) * 2 + s; \
                    va[mb] = MFMA32(*(const LAS bf16x8*)(ops + GC_WN + f * 1024), Bs, va[mb]); \
                    oa[mb] = MFMA32(*(const LAS bf16x8*)(ops + GC_QG + f * 1024), Bs, oa[mb]); } } \
            _Pragma("unroll") for (int kb = 0; kb < 4; ++kb) _Pragma("unroll") for (int r = 0; r < 16; ++r) S[kb][r] *= gamma; \
            _Pragma("unroll") for (int tb = 0; tb < 2; ++tb) _Pragma("unroll") for (int s = 0; s < 2; ++s) { const bf16x8 Bv = cvt_frag(va[tb], s); \
                _Pragma("unroll") for (int kb = 0; kb < 4; ++kb) S[kb] = MFMA32(*(const LAS bf16x8*)(ops + GC_KG + ((kb * 2 + tb) * 2 + s) * 1024), Bv, S[kb]); \
                _Pragma("unroll") for (int mb = 0; mb < 2; ++mb) if (mb >= tb) oa[mb] = MFMA32(*(const LAS bf16x8*)(ops + GC_AT + ((mb * 2 + tb) * 2 + s) * 1024), Bv, oa[mb]); } \
            LAS unsigned char* ob = lds + CH_OB + ((c) & 1) * 16384; \
            _Pragma("unroll") for (int mb = 0; mb < 2; ++mb) _Pragma("unroll") for (int r = 0; r < 16; ++r) { const int tt = 32 * mb + (r & 3) + 8 * (r >> 2) + 4 * hh; \
                *(LAS bf16_t*)(ob + tt * 256 + 2 * (32 * w + l31)) = (bf16_t)f2bf(oa[mb][r]); } \
            __syncthreads(); } while (0)
        for (int c = 0; c < 32; c += 2) { CH_STEP(c, ua); CH_STEP(c + 1, ub); }
        float* so = a.out + O_DP + (size_t)((layer * 4 + b) * 8 + h) * 128 * 128 + 32 * w + l31;
#pragma unroll
        for (int kb = 0; kb < 4; ++kb)
#pragma unroll
            for (int r = 0; r < 16; ++r) so[(size_t)(32 * kb + (r & 3) + 8 * (r >> 2) + 4 * hh) * 128] = S[kb][r];
    }
}

__device__ __forceinline__ void gdn_sample_item(int layer, int item, const int tid) {
    CArgs& a = kargs(); LAS unsigned char* lds = lds_base();
    const int lane = tid & 63, w = __builtin_amdgcn_readfirstlane(tid >> 6);
    const int b = item >> 3, h = item & 7, rbase = TP + b * 4;
    const bf16_t* P = (const bf16_t*)(a.ws + WS_P); const float* AB = (const float*)(a.ws + WS_AB); bf16_t* YC = (bf16_t*)(a.ws + WS_YC);
    LAS float* qs = (LAS float*)lds; LAS float* ks = qs + 512; LAS float* vs = ks + 512;
    LAS float* red = vs + 512;
    LAS float* dots = red + 4096; LAS float* gcv = dots + 32; LAS float* btv = gcv + 4; LAS float* ob = btv + 4;
    const int dv = (w & 1) * 64 + lane, sl = w >> 1, dk0 = sl * 32;
    float S[32];
    { const float* s0 = a.in[4] + ((size_t)((layer * 128 + b) * 8 + h) * 128 + dk0) * 128 + dv;
#pragma unroll
      for (int i = 0; i < 32; ++i) S[i] = s0[(size_t)i * 128]; }
    __syncthreads();
    {
        const float* convw = a.in[24] + (size_t)layer * 4 * 3072; const float* sconv = a.in[5] + (size_t)(layer * 128 + b) * 3 * 3072;
        float* co = a.out + O_CS + (size_t)(layer * 128 + b) * 3 * 3072;
#pragma unroll
        for (int it3 = 0; it3 < 3; ++it3) { const int idx = tid + 512 * it3;
            const int t = idx / 384, ch = idx - t * 384, sec = ch >> 7, cc = ch & 127, col = sec * 1024 + h * 128 + cc;
            float accv = 0.f;
#pragma unroll
            for (int j = 0; j < 4; ++j) { const int tt = t - 3 + j;
                const float xp = bf2f(P[(size_t)(rbase + (tt < 0 ? 0 : tt)) * NP + C_QKV + col]), xs = sconv[(tt < 0 ? 3 + tt : 2) * 3072 + col];
                const float x = (tt >= 0) ? xp : xs;
                if (j == 3 && t >= 1) co[(t - 1) * 3072 + col] = x;
                accv += convw[j * 3072 + col] * x; }
            LAS float* dst = sec == 0 ? qs : (sec == 1 ? ks : vs); dst[t * 128 + cc] = silu(accv);
        }
        if (tid < 4) { const size_t row = (size_t)(rbase + tid); const float ac = AB[row * 16 + h], bc = AB[row * 16 + 8 + h];
            gcv[tid] = -expf(a.in[25][layer * 8 + h]) * softplus(ac + a.in[26][layer * 8 + h]); btv[tid] = sigm(bc); }
    }
    __syncthreads();
    if (w < 4) { const int t = w;
        { const float q0 = qs[t * 128 + lane], q1 = qs[t * 128 + 64 + lane]; const float ss = wave_sum(q0 * q0 + q1 * q1);
          const float r = (1.f / sqrtf(ss + 1e-6f)) * 0.08838834764831845f; qs[t * 128 + lane] = q0 * r; qs[t * 128 + 64 + lane] = q1 * r; }
        { const float k0 = ks[t * 128 + lane], k1 = ks[t * 128 + 64 + lane]; const float ss = wave_sum(k0 * k0 + k1 * k1);
          const float r = 1.f / sqrtf(ss + 1e-6f); ks[t * 128 + lane] = k0 * r; ks[t * 128 + 64 + lane] = k1 * r; } }
    __syncthreads();
    {
#pragma unroll
        for (int q = 0; q < 4; ++q) { const int id = w * 4 + q, typ = id >> 4, i = (id >> 2) & 3, j = id & 3;
            const LAS float* xa = (typ ? qs : ks) + i * 128; const LAS float* xb = ks + j * 128;
            const float d = wave_sum(xa[lane] * xb[lane] + xa[64 + lane] * xb[64 + lane]);
            if (lane == 0) dots[id] = d; }
        float pk[4], pq[4];
#pragma unroll
        for (int j = 0; j < 4; ++j) { pk[j] = 0.f; pq[j] = 0.f; }
#pragma unroll
        for (int i = 0; i < 32; i += 4)
#pragma unroll
            for (int j = 0; j < 4; ++j) { const f32x4 kk = *(const LAS f32x4*)(ks + j * 128 + dk0 + i), qq = *(const LAS f32x4*)(qs + j * 128 + dk0 + i);
                pk[j] += kk[0] * S[i] + kk[1] * S[i + 1] + kk[2] * S[i + 2] + kk[3] * S[i + 3];
                pq[j] += qq[0] * S[i] + qq[1] * S[i + 1] + qq[2] * S[i + 2] + qq[3] * S[i + 3]; }
#pragma unroll
        for (int j = 0; j < 4; ++j) { red[(j * 4 + sl) * 128 + dv] = pk[j]; red[((4 + j) * 4 + sl) * 128 + dv] = pq[j]; }
    }
    __syncthreads();
    {
        float gc[4], bt[4];
        gc[0] = gcv[0]; gc[1] = gc[0] + gcv[1]; gc[2] = gc[1] + gcv[2]; gc[3] = gc[2] + gcv[3];
#pragma unroll
        for (int j = 0; j < 4; ++j) bt[j] = btv[j];
        float L[4][4], Tm[4][4];
#pragma unroll
        for (int i = 0; i < 4; ++i)
#pragma unroll
            for (int j = 0; j < 4; ++j) L[i][j] = (i > j) ? bt[i] * dots[i * 4 + j] * expf(gc[i] - gc[j]) : 0.f;
#pragma unroll
        for (int i = 0; i < 4; ++i)
#pragma unroll
            for (int c = 0; c < 4; ++c) { float s = (i == c) ? 1.f : 0.f;
#pragma unroll
                for (int j = 0; j < 4; ++j) if (j < i) s -= L[i][j] * Tm[j][c];
                Tm[i][c] = s; }
        float kS[4], qS[4], rhs[4], vn[4];
#pragma unroll
        for (int j = 0; j < 4; ++j) { kS[j] = (red[(j * 4 + 0) * 128 + dv] + red[(j * 4 + 1) * 128 + dv]) + (red[(j * 4 + 2) * 128 + dv] + red[(j * 4 + 3) * 128 + dv]);
            qS[j] = (red[((4 + j) * 4 + 0) * 128 + dv] + red[((4 + j) * 4 + 1) * 128 + dv]) + (red[((4 + j) * 4 + 2) * 128 + dv] + red[((4 + j) * 4 + 3) * 128 + dv]);
            rhs[j] = bt[j] * (vs[j * 128 + dv] - expf(gc[j]) * kS[j]); }
#pragma unroll
        for (int i = 0; i < 4; ++i) { float s = 0.f;
#pragma unroll
            for (int j = 0; j < 4; ++j) if (j <= i) s += Tm[i][j] * rhs[j];
            vn[i] = s; }
        if (sl == 0) {
#pragma unroll
            for (int i = 0; i < 4; ++i) { float o = expf(gc[i]) * qS[i];
#pragma unroll
                for (int j = 0; j < 4; ++j) if (j <= i) o += dots[16 + i * 4 + j] * expf(gc[i] - gc[j]) * vn[j];
                ob[i * 128 + dv] = o; } }
        const float gl = gc[3], egl = expf(gl);
        float cf[4];
#pragma unroll
        for (int j = 0; j < 4; ++j) cf[j] = expf(gl - gc[j]) * vn[j];
        float* so = a.out + O_DS + ((size_t)((layer * 128 + b) * 8 + h) * 128 + dk0) * 128 + dv;
#pragma unroll
        for (int i = 0; i < 32; ++i) { float s = egl * S[i];
#pragma unroll
            for (int j = 0; j < 4; ++j) s += ks[j * 128 + dk0 + i] * cf[j];
            so[(size_t)i * 128] = s; }
    }
    __syncthreads();
    if (w < 4) { const int t = w; const float* ng = a.in[27] + layer * 128;
        const float o0 = ob[t * 128 + lane], o1 = ob[t * 128 + 64 + lane]; const float ss = wave_sum(o0 * o0 + o1 * o1);
        const float r = 1.f / sqrtf(ss * (1.f / 128.f) + 1e-6f); const size_t row = (size_t)(rbase + t);
        const float g0 = bf2f(P[row * NP + C_GATEC + h * 128 + lane]), g1 = bf2f(P[row * NP + C_GATEC + h * 128 + 64 + lane]);
        YC[row * 1024 + h * 128 + lane] = (bf16_t)f2bf(o0 * r * ng[lane] * silu(g0));
        YC[row * 1024 + h * 128 + 64 + lane] = (bf16_t)f2bf(o1 * r * ng[64 + lane] * silu(g1)); }
}

#ifndef REP_ROLE
#define REP_ROLE -1
#endif
#define RR(x) for (int _rr = 0; _rr < ((REP_ROLE == (x)) ? 2 : 1); ++_rr)
constexpr int QA_S5 = 80, QA_GM = 144, QA_PREP = 1168, QA_GMS = 1184, QA_END = 2208;
constexpr int CTL_QUEUE = 4096;
__device__ __forceinline__ void phase_mixers(int layer, int G, int bid, int tid0) {
#ifndef PROBE_MIX
#define PROBE_MIX -1
#endif
#define PM(x) (PROBE_MIX == -1 || PROBE_MIX == (x))
    volatile LAS int* qslot = (volatile LAS int*)(lds_base() + LDS_BARST + 16);
    unsigned* ctr = (unsigned*)kargs().ws + CTL_QUEUE + 64 * layer;
    for (;;) {
        const int tid = launder_v(tid0), lane = tid & 63, w = __builtin_amdgcn_readfirstlane(tid >> 6);
        __syncthreads();
        if (tid == 0) *qslot = (int)__hip_atomic_fetch_add(ctr, 1u, __ATOMIC_RELAXED, __HIP_MEMORY_SCOPE_AGENT);
        __syncthreads();
        const int it = launder_s(__builtin_amdgcn_readfirstlane(*qslot));
        if (it >= QA_END) break;
        if (it < QA_S5) { if (w < 4) { const int q = launder_s(it * 4 + w);
                if (q < 256) { if (PM(1)) s5_item<false>(layer, q, w * S5_WLDS, lane); }
                else { if (PM(2)) s5_item<true>(layer, q - 256, w * S5_WLDS, lane); } } }
        else if (it < QA_GM) { if (PM(3)) gmlp_prompt_item(layer, it - QA_S5, tid); }
        else if (it < QA_PREP) { if (PM(0)) gdn_prep_item(layer, it - QA_GM, tid); }
        else if (it < QA_GMS) { if (PM(4)) gmlp_sample_item(layer, (it - QA_PREP) * 8 + w, lane); }
        else { if (PM(5)) gdn_sample_item(layer, it - QA_GMS, tid); }
    }
}

#define XB_TMO      128
#define XB_XCNT(j)  (256  + 64 * (j))
#define XB_XSUB(j)  (1280 + 64 * (j))
#define XB_XGEN(j)  (2304 + 64 * (j))
#define XB_TOP      3328
#define XB_TOPGEN   3392
#define XCD_BAR_WORDS 3456
#define XB_SPIN_CAP (1u << 18)
__device__ __forceinline__ unsigned xb_ld(unsigned* p)              { return __hip_atomic_load(p, __ATOMIC_RELAXED, __HIP_MEMORY_SCOPE_AGENT); }
__device__ __forceinline__ unsigned xb_add(unsigned* p, unsigned v) { return __hip_atomic_fetch_add(p, v, __ATOMIC_RELAXED, __HIP_MEMORY_SCOPE_AGENT); }
__device__ __forceinline__ unsigned xb_xcc_id() { return (unsigned)__builtin_amdgcn_s_getreg((3 << 11) | 20) & 0xFu; }
#define XB_SPIN(cond, bar) do { unsigned _sp = 0; while (cond) { __builtin_amdgcn_s_sleep(1); \
    if ((++_sp & 255u) == 0u) { if (xb_ld(&(bar)[XB_TMO])) break; if (_sp > XB_SPIN_CAP) { atomicAdd(&(bar)[XB_TMO], 1u); break; } } } } while (0)
struct XcdBarrier { unsigned* bar; unsigned x; volatile LAS unsigned* st; };
__device__ __forceinline__ void xcd_barrier_complete(unsigned* bar, unsigned x, unsigned& nloc, unsigned& nx) {
    const unsigned G = gridDim.x * gridDim.y * gridDim.z;
    unsigned sum, cnt, mine, sp = 0u;
    for (;;) {
        sum = 0u; cnt = 0u; mine = 0u;
#pragma unroll
        for (unsigned j = 0; j < 16; ++j) { const unsigned c = xb_ld(&bar[XB_XCNT(j)]); sum += c; cnt += (c > 0u) ? 1u : 0u; mine = (j == x) ? c : mine; }
        if (sum == G) break;
        __builtin_amdgcn_s_sleep(1);
        if ((++sp & 255u) == 0u) { if (xb_ld(&bar[XB_TMO])) break; if (sp > XB_SPIN_CAP) { atomicAdd(&bar[XB_TMO], 1u); break; } }
    }
    nloc = mine > 0u ? mine : 1u; nx = cnt > 0u ? cnt : 1u;
}
__device__ __forceinline__ void xcd_barrier(const XcdBarrier& b) {
    asm volatile("s_waitcnt vmcnt(0)" ::: "memory");
    __syncthreads();
    if (threadIdx.x == 0) {
        unsigned* bar = b.bar;
        __builtin_amdgcn_s_waitcnt(0);
        unsigned nloc = b.st[0], nx = b.st[1];
        if (nloc == 0u) { xcd_barrier_complete(bar, b.x, nloc, nx); b.st[0] = nloc; b.st[1] = nx; }
        const unsigned old = xb_add(&bar[XB_XSUB(b.x)], 1u);
        const unsigned gen = old / nloc;
        if (old + 1u == (gen + 1u) * nloc) {
            __builtin_amdgcn_fence(__ATOMIC_RELEASE, "agent");
            asm volatile("s_waitcnt vmcnt(0)" ::: "memory");
            const unsigned og = xb_add(&bar[XB_TOP], 1u);
            const unsigned tg = og / nx;
            if (og + 1u == (tg + 1u) * nx) xb_add(&bar[XB_TOPGEN], 1u);
            else XB_SPIN(xb_ld(&bar[XB_TOPGEN]) == tg, bar);
            __builtin_amdgcn_fence(__ATOMIC_ACQUIRE, "agent");
            xb_add(&bar[XB_XGEN(b.x)], 1u);
            asm volatile("s_waitcnt vmcnt(0)" ::: "memory");
        } else {
            XB_SPIN(xb_ld(&bar[XB_XGEN(b.x)]) == gen, bar);
            __builtin_amdgcn_fence(__ATOMIC_ACQUIRE, "agent");
            asm volatile("s_waitcnt vmcnt(0)" ::: "memory");
        }
    }
    __syncthreads();
}

__global__ void __launch_bounds__(512, 2) mega(Args karg) {
    const int ph_lo = karg.ph_lo, ph_hi = karg.ph_hi;
    extern __shared__ __attribute__((aligned(16))) unsigned char lds_raw[];
    volatile LAS unsigned* bst = (volatile LAS unsigned*)((LAS unsigned char*)lds_raw + LDS_BARST);
#if MK_SINGLE
    if (threadIdx.x == 0) { bst[0] = 0u; bst[1] = 0u; }
    __syncthreads();
    if (threadIdx.x == 0) (void)xb_add((unsigned*)karg.ws + XB_XCNT(xb_xcc_id()), 1u);
#endif
#ifndef REP_SUB
#define REP_SUB -1
#endif
#ifndef REP_N
#define REP_N 2
#endif
    int rep = 0;
    for (int ph = ph_lo; ph < ph_hi; (REP_SUB >= 0 && ph >= 1 && (ph - 1) % 6 == REP_SUB && rep + 1 < REP_N) ? (void)++rep : (void)(rep = 0, ++ph)) {
        if (ph > ph_lo && rep == 0) { XcdBarrier xb; xb.bar = (unsigned*)kargs().ws; xb.x = xb_xcc_id(); xb.st = bst; xcd_barrier(xb); }
        const int G = launder_s((int)gridDim.x), bid = launder_s((int)blockIdx.x), tid = launder_v((int)threadIdx.x);
        CArgs& a = kargs(); LAS unsigned char* lds = lds_base();
        unsigned char* ws = a.ws;
#ifndef PROBE_SUB
#define PROBE_SUB -1
#endif
#define PS(x) (PROBE_SUB == -1 || PROBE_SUB == (x))
        if (ph == 0) { if (PS(6)) phase_convert(a, lds, G, bid, tid); continue; }
        const int layer = (ph - 1) / 6, sub = (ph - 1) % 6;
        unsigned char* wb = ws + WS_W0 + (size_t)layer * WS_WL;
        if (PS(0) && sub == 0) {
            pg8::Gemm g{(const bf16_t*)(ws + WS_XB), nullptr, nullptr, (const bf16_t*)(wb + WO_IN), nullptr, nullptr, DM};
            pg8::Sched S; S.init(MT / 256, NP / 256, 1, G, bid);
            pg8::Epi1 E{(bf16_t*)(ws + WS_P), (float*)(ws + WS_AB)};
            pg8::gemm_phase(lds, g, S, E, tid);
        } else if (PS(1) && sub == 1) {
            phase_mixers(layer, G, bid, tid);
        } else if (PS(2) && sub == 2) {
            if (bid < 32) { RR(6) gdn_chain(layer, bid, tid); }
            else {
            pg8::Gemm g{(const bf16_t*)(ws + WS_ZB), nullptr, nullptr, (const bf16_t*)(wb + WO_GLU), nullptr, nullptr, 1024};
            pg8::Sched S; S.init(MT / 256, 4, 1, G - 32, bid - 32);
            pg8::Epi2 E{(const bf16_t*)(ws + WS_ZB), (const bf16_t*)(ws + WS_P), a.in[17] + layer * 1024, (bf16_t*)(ws + WS_YA)};
            pg8::gemm_phase(lds, g, S, E, tid);
            }
        } else if (PS(3) && sub == 3) {
            pg8::Gemm g{(const bf16_t*)(ws + WS_YA), (const bf16_t*)(ws + WS_YB), (const bf16_t*)(ws + WS_YC),
                        (const bf16_t*)(wb + WO_PA), (const bf16_t*)(wb + WO_PB), (const bf16_t*)(wb + WO_PC), 1024};
            pg8::Sched S; S.init(MT / 256, 8, 3, G, bid);
            pg8::Epi3 E{(const bf16_t*)(ws + WS_P), a.in[7] + layer * 3 * DM, (float*)(ws + WS_M32), (bf16_t*)(ws + WS_MB)};
            pg8::gemm_phase(lds, g, S, E, tid);
        } else if (PS(4) && sub == 4) {
            pg8::Gemm g{(const bf16_t*)(ws + WS_MB), nullptr, nullptr, (const bf16_t*)(wb + WO_OUT), nullptr, nullptr, DM};
            pg8::Sched S; S.init(MT / 256, 8, 1, G, bid);
            const float* xp = layer == 0 ? a.in[0] : (const float*)(ws + WS_X32);
            const float* xs = layer == 0 ? a.in[1] : (const float*)(ws + WS_X32) + (size_t)TP * DM;
            pg8::Epi4 E{xp, xs, (float*)(ws + WS_H32)};
            pg8::gemm_phase(lds, g, S, E, tid);
        } else if (PS(5) && sub == 5) {
            phase_ln(a, layer, G, bid, tid);
        }
    }
}

extern "C" void kernel_launch(void* const* d_in, const int* in_sizes, int n_in, void* d_out, int out_size, void* d_ws, size_t ws_size, hipStream_t stream) {
    static int grid = 0;
    if (grid == 0) {
        if (n_in != 32 || (size_t)out_size != O_END || ws_size < WS_END) {
            fprintf(stderr, "kernel_launch: unexpected problem: n_in %d out %d ws %zu (need %zu)\n", n_in, out_size, ws_size, (size_t)WS_END); grid = -1; return; }
        int dev = 0, cus = 0, per_cu = 0;
        if (hipGetDevice(&dev) != hipSuccess || hipDeviceGetAttribute(&cus, hipDeviceAttributeMultiprocessorCount, dev) != hipSuccess) { grid = -1; return; }
        if (hipFuncSetAttribute((const void*)mega, hipFuncAttributeMaxDynamicSharedMemorySize, LDS_BYTES) != hipSuccess) { fprintf(stderr, "kernel_launch: hipFuncSetAttribute failed\n"); grid = -1; return; }
        if (hipOccupancyMaxActiveBlocksPerMultiprocessor(&per_cu, (const void*)mega, 512, LDS_BYTES) != hipSuccess || per_cu < 1) {
            fprintf(stderr, "kernel_launch: occupancy query says %d blocks per CU\n", per_cu); (void)hipGetLastError(); grid = -1; return; }
        grid = cus;
    }
    if (grid < 0) return;
    Args a{};
    for (int i = 0; i < 32; ++i) a.in[i] = (const float*)d_in[i];
    a.out = (float*)d_out; a.ws = (unsigned char*)d_ws;
#if MK_SINGLE
    a.ph_lo = 0; a.ph_hi = NPHASE;
    if (hipMemsetAsync(d_ws, 0, 32768, stream) != hipSuccess) { fprintf(stderr, "kernel_launch: memset of the barrier words failed\n"); return; }
    hipLaunchKernelGGL(mega, dim3(grid), dim3(512), LDS_BYTES, stream, a);
#else
    for (int ph = 0; ph < NPHASE; ++ph) {
        a.ph_lo = ph; a.ph_hi = ph + 1;
        hipLaunchKernelGGL(mega, dim3(grid), dim3(512), LDS_BYTES, stream, a);
    }
#endif
}
```

```cpp
#include <hip/hip_runtime.h>
#include <hip/hip_cooperative_groups.h>
#include <cstdio>
#include <cstdint>
namespace cg = cooperative_groups;

#ifndef MK_SINGLE
#define MK_SINGLE 1
#endif

#define LAS __attribute__((address_space(3)))
typedef unsigned short bf16_t;
typedef short bf16x8 __attribute__((ext_vector_type(8)));
typedef float f32x4 __attribute__((ext_vector_type(4)));
typedef float f32x2 __attribute__((ext_vector_type(2)));
typedef float f32x16 __attribute__((ext_vector_type(16)));
typedef unsigned u32x4 __attribute__((ext_vector_type(4)));
typedef unsigned u32x2 __attribute__((ext_vector_type(2)));

constexpr int DM = 2048, TP = 8192, TS = 512, MT = TP + TS;
constexpr int NIN = 15376, NP = 15616;
constexpr int C_XA = 0, C_GA = 1024, C_UB = 2048, C_VB = 3072, C_GB = 4096, C_QKV = 5120, C_GATEC = 8192, C_ZG = 9216, C_AB = 15360;
constexpr int NPHASE = 13;
constexpr float ALPHA = 1.41421356237f;

constexpr size_t MiB = 1u << 20;
constexpr size_t WS_CTL = 0;
constexpr size_t WS_W0 = 1 * MiB, WS_WL = 83 * MiB;
constexpr size_t WO_IN = 0, WO_GLU = 61 * MiB, WO_PA = 63 * MiB, WO_PB = 67 * MiB, WO_PC = 71 * MiB, WO_OUT = 75 * MiB;
constexpr size_t WS_XB = 167 * MiB, WS_P = 201 * MiB, WS_AB = 461 * MiB, WS_ZB = 462 * MiB, WS_YA = 479 * MiB, WS_YB = 496 * MiB, WS_YC = 513 * MiB;
constexpr size_t WS_M32 = 530 * MiB, WS_MB = 598 * MiB, WS_H32 = 632 * MiB, WS_X32 = 700 * MiB, WS_END = 768 * MiB;

constexpr size_t O_YP = 0, O_YS = 16777216, O_SRP = 17825792, O_SIP = 17858560, O_DP = 17891328, O_CP = 18939904,
                 O_SRS = 19013632, O_SIS = 20062208, O_DS = 21110784, O_CS = 54665216, O_GV = 57024512, O_END = 58073088;

constexpr int LDS_BYTES = 147456 + 256, LDS_BARST = 147456;

struct Args { const float* in[32]; float* out; unsigned char* ws; int ph_lo, ph_hi; };
typedef const __attribute__((address_space(4))) Args CArgs;

typedef __bf16 bf16x2_t __attribute__((ext_vector_type(2)));
__device__ __forceinline__ unsigned pk2(float lo, float hi) { const f32x2 v = {lo, hi}; return __builtin_bit_cast(unsigned, __builtin_convertvector(v, bf16x2_t)); }
__device__ __forceinline__ unsigned f2bf(float f) { return pk2(f, 0.f) & 0xffffu; }
__device__ __forceinline__ float bf2f(unsigned short h) { return __builtin_bit_cast(float, (unsigned)h << 16); }
__device__ __forceinline__ float bflo(unsigned w) { return __builtin_bit_cast(float, w << 16); }
__device__ __forceinline__ float bfhi(unsigned w) { return __builtin_bit_cast(float, w & 0xffff0000u); }
__device__ __forceinline__ float fexp(float x) { return __builtin_amdgcn_exp2f(x * 1.4426950408889634f); }
__device__ __forceinline__ float sigm(float x) { return __builtin_amdgcn_rcpf(1.f + fexp(-x)); }
__device__ __forceinline__ float silu(float x) { return x * sigm(x); }
__device__ __forceinline__ float rsq(float x) { return __builtin_amdgcn_rsqf(x); }
__device__ __forceinline__ float gelu_tanh(float x) { return x * sigm(1.5957691216f * (x + 0.044715f * x * x * x)); }
__device__ __forceinline__ float softplus(float x) { return x > 20.f ? x : log1pf(expf(x)); }
__device__ __forceinline__ float wave_sum(float v) {
#pragma unroll
    for (int o = 1; o < 64; o <<= 1) v += __shfl_xor(v, o);
    return v;
}
__device__ __forceinline__ void unpack8(const u32x4 w, float (&f)[8]) {
    f[0] = bflo(w.x); f[1] = bfhi(w.x); f[2] = bflo(w.y); f[3] = bfhi(w.y); f[4] = bflo(w.z); f[5] = bfhi(w.z); f[6] = bflo(w.w); f[7] = bfhi(w.w);
}
__device__ __forceinline__ u32x4 pack8(const float (&f)[8]) { u32x4 w; w.x = pk2(f[0], f[1]); w.y = pk2(f[2], f[3]); w.z = pk2(f[4], f[5]); w.w = pk2(f[6], f[7]); return w; }
#define LDS_WAIT() asm volatile("s_waitcnt lgkmcnt(0)" ::: "memory")
__device__ __forceinline__ int launder_v(int x) { asm volatile("" : "+v"(x)); return x; }
__device__ __forceinline__ int launder_s(int x) { asm volatile("" : "+s"(x)); return x; }
__device__ __forceinline__ CArgs& kargs() { int z; asm volatile("s_mov_b32 %0, 0" : "=s"(z));
    return *(CArgs*)((const __attribute__((address_space(4))) char*)__builtin_amdgcn_kernarg_segment_ptr() + z); }
__device__ __forceinline__ LAS unsigned char* lds_base() { extern __shared__ __attribute__((aligned(16))) unsigned char lds_raw[]; int z; asm volatile("s_mov_b32 %0, 0" : "=s"(z));
    return (LAS unsigned char*)lds_raw + z; }

namespace pg8 {
constexpr int BM = 256, BK = 64, HALF = 128, HTB = HALF * BK * 2, STAGE_BYTES = 8 * HTB, NXCD = 8, WGM = 8;
__device__ __forceinline__ int lds_byte(int r, int c) { const int st = (r >> 4) * 2 + (c >> 5), rr = r & 15, cc = c & 31, ob = rr * 64 + cc * 2; return st * 1024 + (ob ^ (((ob >> 9) & 1) << 5)); }
__device__ __forceinline__ void stage_rc(int b, int& R, int& C) { const int st = b / 1024, sb = b % 1024, swz = sb ^ (((sb >> 9) & 1) << 5); R = (st >> 1) * 16 + swz / 64; C = (st & 1) * 32 + (swz % 64) / 2; }
__device__ __forceinline__ int perm32(int rho) { const int n = rho >> 4, i = rho & 15; return 8 * (i >> 2) + 4 * n + (i & 3); }

struct Unit { int pm, pn, br; };
struct Gemm { const bf16_t* A0; const bf16_t* A1; const bf16_t* A2; const bf16_t* B0; const bf16_t* B1; const bf16_t* B2; int K; };

struct Sched {
    int nM, nN, nbr, nwg, G, c;
    __device__ __forceinline__ void init(int nM_, int nN_, int nbr_, int G_, int c_) { nM = nM_; nN = nN_; nbr = nbr_; nwg = nM * nN; G = G_; c = c_; }
    __device__ __forceinline__ bool next(int i, Unit& u) const {
        const int ti = i / nbr; u.br = i - ti * nbr;
        const long L = (long)ti * G + c; if (L >= nwg) return false;
        int wgid = (int)L; { const int q = nwg / NXCD, r = nwg % NXCD, xcd = wgid % NXCD, off = wgid / NXCD; wgid = (xcd < r ? xcd * (q + 1) : r * (q + 1) + (xcd - r) * q) + off; }
        const int nig = WGM * nN, gid = wgid / nig, fm = gid * WGM, gsz = (nM - fm) < WGM ? (nM - fm) : WGM;
        u.pm = fm + ((wgid % nig) % gsz); u.pn = (wgid % nig) / gsz; return true;
    }
};

template <class Epi>
__device__ __forceinline__ void gemm_phase(LAS unsigned char* lds, const Gemm g, const Sched& S, const Epi& E, const int tid) {
    const int wid = __builtin_amdgcn_readfirstlane(tid >> 6), lane = tid & 63, wr = wid >> 2, wc = wid & 3, fr = lane & 15, fq = lane >> 4;
    const int K = g.K, nt = K / BK;
    unsigned voffA[2], voffB[2];
#pragma unroll
    for (int i = 0; i < 2; ++i) { int R, C; stage_rc(tid * 16 + i * 8192, R, C); const int Rb = (R & ~31) + perm32(R & 31);
        voffA[i] = (unsigned)(R * K + C) * 2u; voffB[i] = (unsigned)(Rb * K + C) * 2u; }
    const size_t kstep = (size_t)(BK * 2);
    const size_t hstep = (size_t)HALF * K * 2;
    const size_t tstep = 2 * hstep;
    const unsigned ldsw = (unsigned)wid * 1024u;
    const int aoff = lds_byte(wr * 64 + fr, fq * 8), boff = lds_byte(wc * 32 + fr, fq * 8);
#define PG8_SA(b, h) (((b) * 2 + (h)) * HTB)
#define PG8_SB(b, h) ((4 + (b) * 2 + (h)) * HTB)
#define PG8_STAGE(bufoff, gbase, voff) do { _Pragma("unroll") for (int _i = 0; _i < 2; ++_i) \
        __builtin_amdgcn_global_load_lds((const unsigned*)((const char*)(gbase) + (voff)[_i]), (LAS unsigned*)(lds + (bufoff) + ldsw + _i * 8192), 16, 0, 0); } while (0)
#define PG8_LDA(dst, b, h) do { _Pragma("unroll") for (int m = 0; m < 4; ++m) _Pragma("unroll") for (int k = 0; k < 2; ++k) dst[m][k] = *(const LAS bf16x8*)(lds + PG8_SA(b, h) + aoff + m * 2048 + k * 1024); } while (0)
#define PG8_LDB(dst, b, h) do { _Pragma("unroll") for (int n = 0; n < 2; ++n) _Pragma("unroll") for (int k = 0; k < 2; ++k) dst[n][k] = *(const LAS bf16x8*)(lds + PG8_SB(b, h) + boff + n * 2048 + k * 1024); } while (0)
#define PG8_MMA(ai, bj, At, Bt) do { __builtin_amdgcn_s_setprio(1); _Pragma("unroll") for (int m = 0; m < 4; ++m) _Pragma("unroll") for (int n = 0; n < 2; ++n) _Pragma("unroll") for (int k = 0; k < 2; ++k) \
        acc[ai][bj][m][n] = __builtin_amdgcn_mfma_f32_16x16x32_bf16(Bt[n][k], At[m][k], acc[ai][bj][m][n], 0, 0, 0); __builtin_amdgcn_s_setprio(0); } while (0)
#define PG8_WAIT_V(n) asm volatile("s_waitcnt vmcnt(" #n ")" ::: "memory")
#define PG8_WAIT_L(n) asm volatile("s_waitcnt lgkmcnt(" #n ")" ::: "memory")
#define PG8_BAR __builtin_amdgcn_s_barrier()
#define PG8_SCHED __builtin_amdgcn_sched_barrier(0)
#define PG8_APTR(u) ((const char*)((u).br == 0 ? g.A0 : ((u).br == 1 ? g.A1 : g.A2)) + (size_t)(u).pm * tstep)
#define PG8_BPTR(u) ((const char*)((u).br == 0 ? g.B0 : ((u).br == 1 ? g.B1 : g.B2)) + (size_t)(u).pn * tstep)
    Unit cur, nxt; int ui = 0;
    if (!S.next(0, cur)) return;
    f32x4 acc[2][2][4][2];
#pragma unroll
    for (int a = 0; a < 2; ++a)
#pragma unroll
        for (int b = 0; b < 2; ++b)
#pragma unroll
            for (int m = 0; m < 4; ++m)
#pragma unroll
                for (int n = 0; n < 2; ++n) acc[a][b][m][n] = (f32x4){0.f, 0.f, 0.f, 0.f};
    bf16x8 At[4][2], B0[2][2], B1[2][2];
    const char* cA = PG8_APTR(cur); const char* cB = PG8_BPTR(cur);
    PG8_STAGE(PG8_SB(0, 0), cB, voffB); PG8_STAGE(PG8_SB(0, 1), cB + hstep, voffB); PG8_STAGE(PG8_SA(0, 0), cA, voffA); PG8_STAGE(PG8_SA(0, 1), cA + hstep, voffA);
    if (wr == 1) PG8_BAR;
    PG8_WAIT_V(2); PG8_BAR;
    PG8_STAGE(PG8_SB(1, 0), cB + kstep, voffB); PG8_STAGE(PG8_SA(1, 0), cA + kstep, voffA); PG8_STAGE(PG8_SB(1, 1), cB + hstep + kstep, voffB);
    PG8_WAIT_V(6); PG8_BAR;
    for (;;) {
        const bool has_next = S.next(ui + 1, nxt);
        const char* nA = has_next ? PG8_APTR(nxt) : cA; const char* nB = has_next ? PG8_BPTR(nxt) : cB;
        for (int t = 0; t < nt; t += 2) {
            const bool last = (t == nt - 2);
            const char* a1 = cA + (size_t)(t + 1) * kstep;
            const char* a2 = last ? nA : cA + (size_t)(t + 2) * kstep; const char* b2 = last ? nB : cB + (size_t)(t + 2) * kstep;
            const char* a3 = a2 + kstep; const char* b3 = b2 + kstep;
            PG8_LDB(B0, 0, 0); PG8_LDB(B1, 0, 1); PG8_SCHED; PG8_LDA(At, 0, 0); PG8_STAGE(PG8_SA(1, 1), a1 + hstep, voffA);
            PG8_WAIT_V(8); PG8_WAIT_L(0); PG8_BAR; PG8_MMA(0, 0, At, B0); PG8_MMA(0, 1, At, B1); PG8_BAR; PG8_SCHED;
            PG8_LDA(At, 0, 1); PG8_STAGE(PG8_SB(0, 0), b2, voffB); PG8_STAGE(PG8_SB(0, 1), b2 + hstep, voffB); PG8_STAGE(PG8_SA(0, 0), a2, voffA);
            PG8_WAIT_V(8); PG8_WAIT_L(0); PG8_BAR; PG8_MMA(1, 0, At, B0); PG8_MMA(1, 1, At, B1); PG8_BAR; PG8_SCHED;
            PG8_LDB(B0, 1, 0); PG8_LDB(B1, 1, 1); PG8_SCHED; PG8_LDA(At, 1, 0); PG8_STAGE(PG8_SA(0, 1), a2 + hstep, voffA);
            PG8_WAIT_V(8); PG8_WAIT_L(0); PG8_BAR; PG8_MMA(0, 0, At, B0); PG8_MMA(0, 1, At, B1); PG8_BAR; PG8_SCHED;
            PG8_LDA(At, 1, 1); PG8_STAGE(PG8_SB(1, 0), b3, voffB); PG8_STAGE(PG8_SB(1, 1), b3 + hstep, voffB); PG8_STAGE(PG8_SA(1, 0), a3, voffA);
            PG8_WAIT_V(8); PG8_WAIT_L(0); PG8_BAR; PG8_MMA(1, 0, At, B0); PG8_MMA(1, 1, At, B1); PG8_BAR; PG8_SCHED;
        }
        if (wr == 0) PG8_BAR;
        E(acc, cur, wr, wc, fr, fq);
        if (!has_next) break;
#pragma unroll
        for (int a = 0; a < 2; ++a)
#pragma unroll
            for (int b = 0; b < 2; ++b)
#pragma unroll
                for (int m = 0; m < 4; ++m)
#pragma unroll
                    for (int n = 0; n < 2; ++n) acc[a][b][m][n] = (f32x4){0.f, 0.f, 0.f, 0.f};
        cur = nxt; cA = nA; cB = nB; ++ui;
        if (wr == 1) PG8_BAR;
    }
    PG8_WAIT_V(0);
    PG8_BAR;
#undef PG8_SA
#undef PG8_SB
#undef PG8_STAGE
#undef PG8_LDA
#undef PG8_LDB
#undef PG8_MMA
#undef PG8_WAIT_V
#undef PG8_WAIT_L
#undef PG8_BAR
#undef PG8_SCHED
#undef PG8_APTR
#undef PG8_BPTR
}

struct Epi1 {
    bf16_t* P; float* AB;
    __device__ __forceinline__ void operator()(const f32x4 (&acc)[2][2][4][2], const Unit& u, int wr, int wc, int fr, int fq) const {
        const int row0 = u.pm * BM + wr * 64 + fr, col0 = u.pn * BM + wc * 32 + 8 * fq;
#pragma unroll
        for (int ai = 0; ai < 2; ++ai)
#pragma unroll
            for (int m = 0; m < 4; ++m) { bf16_t* rowp = P + (size_t)(row0 + ai * HALF + m * 16) * NP + col0;
#pragma unroll
                for (int bj = 0; bj < 2; ++bj) { const f32x4 v0 = acc[ai][bj][m][0], v1 = acc[ai][bj][m][1];
                    u32x4 w; w.x = pk2(v0[0], v0[1]); w.y = pk2(v0[2], v0[3]); w.z = pk2(v1[0], v1[1]); w.w = pk2(v1[2], v1[3]);
                    *(u32x4*)(rowp + bj * HALF) = w; } }
        if (u.pn == 60 && wc == 0 && fq < 2) {
#pragma unroll
            for (int ai = 0; ai < 2; ++ai)
#pragma unroll
                for (int m = 0; m < 4; ++m) { float* ab = AB + (size_t)(row0 + ai * HALF + m * 16) * 16 + 8 * fq;
                    *(f32x4*)ab = acc[ai][0][m][0]; *(f32x4*)(ab + 4) = acc[ai][0][m][1]; }
        }
    }
};
struct Epi2 {
    const bf16_t* Zb; const bf16_t* P; const float* bglu; bf16_t* YA;
    __device__ __forceinline__ void operator()(const f32x4 (&acc)[2][2][4][2], const Unit& u, int wr, int wc, int fr, int fq) const {
        const int row0 = u.pm * BM + wr * 64 + fr, col0 = u.pn * BM + wc * 32 + 8 * fq;
#pragma unroll
        for (int bj = 0; bj < 2; ++bj) { const int col = col0 + bj * HALF;
            const f32x4 b0 = *(const f32x4*)(bglu + col), b1 = *(const f32x4*)(bglu + col + 4);
#pragma unroll
            for (int ai = 0; ai < 2; ++ai)
#pragma unroll
                for (int m = 0; m < 4; ++m) { const size_t row = (size_t)(row0 + ai * HALF + m * 16);
                    float z[8], ga[8], o[8];
                    unpack8(*(const u32x4*)(Zb + row * 1024 + col), z); unpack8(*(const u32x4*)(P + row * NP + C_GA + col), ga);
                    const f32x4 v0 = acc[ai][bj][m][0] + b0, v1 = acc[ai][bj][m][1] + b1;
#pragma unroll
                    for (int e = 0; e < 4; ++e) { o[e] = z[e] * sigm(v0[e]) * silu(ga[e]); o[4 + e] = z[4 + e] * sigm(v1[e]) * silu(ga[4 + e]); }
                    *(u32x4*)(YA + row * 1024 + col) = pack8(o); } }
    }
};
struct Epi3 {
    const bf16_t* P; const float* bgate; float* M32; bf16_t* Mb;
    __device__ __forceinline__ void operator()(const f32x4 (&acc)[2][2][4][2], const Unit& u, int wr, int wc, int fr, int fq) const {
        const int row0 = u.pm * BM + wr * 64 + fr, col0 = u.pn * BM + wc * 32 + 8 * fq, br = u.br;
#pragma unroll
        for (int bj = 0; bj < 2; ++bj) { const int col = col0 + bj * HALF;
            const f32x4 g0 = *(const f32x4*)(bgate + br * DM + col), g1 = *(const f32x4*)(bgate + br * DM + col + 4);
#pragma unroll
            for (int ai = 0; ai < 2; ++ai)
#pragma unroll
                for (int m = 0; m < 4; ++m) { const size_t row = (size_t)(row0 + ai * HALF + m * 16);
                    float zg[8], o[8];
                    unpack8(*(const u32x4*)(P + row * NP + C_ZG + br * DM + col), zg);
                    const f32x4 a0 = acc[ai][bj][m][0], a1 = acc[ai][bj][m][1];
#pragma unroll
                    for (int e = 0; e < 4; ++e) { o[e] = sigm(zg[e] + g0[e]) * a0[e]; o[4 + e] = sigm(zg[4 + e] + g1[e]) * a1[e]; }
                    float* mp = M32 + row * DM + col;
                    if (br > 0) { const f32x4 p0 = *(const f32x4*)mp, p1 = *(const f32x4*)(mp + 4);
#pragma unroll
                        for (int e = 0; e < 4; ++e) { o[e] += p0[e]; o[4 + e] += p1[e]; } }
                    if (br < 2) { *(f32x4*)mp = (f32x4){o[0], o[1], o[2], o[3]}; *(f32x4*)(mp + 4) = (f32x4){o[4], o[5], o[6], o[7]}; }
                    else *(u32x4*)(Mb + row * DM + col) = pack8(o); } }
    }
};
struct Epi4 {
    const float* xp; const float* xs; float* H32;
    __device__ __forceinline__ void operator()(const f32x4 (&acc)[2][2][4][2], const Unit& u, int wr, int wc, int fr, int fq) const {
        const int row0 = u.pm * BM + wr * 64 + fr, col0 = u.pn * BM + wc * 32 + 8 * fq;
        const float* xb = (u.pm < 32) ? xp : (xs - (size_t)TP * DM);
#pragma unroll
        for (int ai = 0; ai < 2; ++ai)
#pragma unroll
            for (int m = 0; m < 4; ++m) { const size_t row = (size_t)(row0 + ai * HALF + m * 16);
#pragma unroll
                for (int bj = 0; bj < 2; ++bj) { const int col = col0 + bj * HALF;
                    const f32x4 x0 = *(const f32x4*)(xb + row * DM + col), x1 = *(const f32x4*)(xb + row * DM + col + 4);
                    *(f32x4*)(H32 + row * DM + col) = x0 * ALPHA + acc[ai][bj][m][0];
                    *(f32x4*)(H32 + row * DM + col + 4) = x1 * ALPHA + acc[ai][bj][m][1]; } }
    }
};
}

template <bool REMAP>
__device__ __forceinline__ void transpose_item(const float* W, int K, int Nsrc, int Ndst, bf16_t* WT, LAS float* scr, int item, int lane) {
    const int nblk = Ndst / 32, kb = item / nblk, nb = item % nblk, k0 = 64 * kb, n0 = 32 * nb;
    int d = n0 + (lane & 31), s = d; bool valid = true;
    if (REMAP) { if (d < C_GATEC) s = d; else if (d < C_AB) s = d + 16; else if (d < C_AB + 16) s = 8192 + (d - C_AB); else { s = 0; valid = false; } }
#pragma unroll 8
    for (int i = 0; i < 32; ++i) { const int kk = 2 * i + (lane >> 5); scr[kk * 33 + (lane & 31)] = valid ? W[(size_t)(k0 + kk) * Nsrc + s] : 0.f; }
    LDS_WAIT();
    const int c = lane & 7;
#pragma unroll
    for (int j = 0; j < 4; ++j) { const int n = (lane >> 3) + 8 * j; const LAS float* sp = scr + (8 * c) * 33 + n;
        u32x4 o; o.x = pk2(sp[0 * 33], sp[1 * 33]); o.y = pk2(sp[2 * 33], sp[3 * 33]); o.z = pk2(sp[4 * 33], sp[5 * 33]); o.w = pk2(sp[6 * 33], sp[7 * 33]);
        *(u32x4*)(WT + (size_t)(n0 + n) * K + k0 + 8 * c) = o; }
    LDS_WAIT();
}

__device__ __forceinline__ void phase_convert(CArgs& a, LAS unsigned char* lds, int G, int vb, const int tid) {
    const int lane = tid & 63, wave = tid >> 6;
    LAS float* scr = (LAS float*)(lds + wave * 16384);
    const int gw = vb * 8 + wave, NGW = G * 8;
    constexpr int I_IN = (DM / 64) * (NP / 32), I_GLU = (1024 / 64) * (1024 / 32), I_P = (1024 / 64) * (DM / 32), I_OUT = (DM / 64) * (DM / 32);
    constexpr int I_L = I_IN + I_GLU + 3 * I_P + I_OUT;
    for (int it = gw; it < 2 * I_L; it += NGW) {
        const int l = it / I_L; int r = it - l * I_L;
        unsigned char* wb = a.ws + WS_W0 + (size_t)l * WS_WL;
        if (r < I_IN) { transpose_item<true>(a.in[6] + (size_t)l * DM * NIN, DM, NIN, NP, (bf16_t*)(wb + WO_IN), scr, r, lane); continue; } r -= I_IN;
        if (r < I_GLU) { transpose_item<false>(a.in[16] + (size_t)l * 1024 * 1024, 1024, 1024, 1024, (bf16_t*)(wb + WO_GLU), scr, r, lane); continue; } r -= I_GLU;
        if (r < I_P) { transpose_item<false>(a.in[18] + (size_t)l * 1024 * DM, 1024, DM, DM, (bf16_t*)(wb + WO_PA), scr, r, lane); continue; } r -= I_P;
        if (r < I_P) { transpose_item<false>(a.in[23] + (size_t)l * 1024 * DM, 1024, DM, DM, (bf16_t*)(wb + WO_PB), scr, r, lane); continue; } r -= I_P;
        if (r < I_P) { transpose_item<false>(a.in[28] + (size_t)l * 1024 * DM, 1024, DM, DM, (bf16_t*)(wb + WO_PC), scr, r, lane); continue; } r -= I_P;
        transpose_item<false>(a.in[29] + (size_t)l * DM * DM, DM, DM, DM, (bf16_t*)(wb + WO_OUT), scr, r, lane);
    }
    bf16_t* Xb = (bf16_t*)(a.ws + WS_XB);
    for (int m = gw; m < MT; m += NGW) {
        const float* xr = (m < TP) ? a.in[0] + (size_t)m * DM : a.in[1] + (size_t)(m - TP) * DM;
        const f32x4* xv = (const f32x4*)xr + lane; u32x2* o = (u32x2*)(Xb + (size_t)m * DM) + lane;
#pragma unroll
        for (int j = 0; j < 8; ++j) { const f32x4 v = xv[64 * j]; u32x2 w; w.x = pk2(v.x, v.y); w.y = pk2(v.z, v.w); o[64 * j] = w; }
    }
}

__device__ __forceinline__ void phase_ln(CArgs& a, int layer, int G, int vb, const int tid) {
    const int lane = tid & 63, wave = tid >> 6;
    const int gw = vb * 8 + wave, NGW = G * 8;
    const float* H32 = (const float*)(a.ws + WS_H32);
    const float* lg = a.in[30] + layer * DM; const float* lb = a.in[31] + layer * DM;
    bf16_t* Xb = (bf16_t*)(a.ws + WS_XB);
    for (int m = gw; m < MT; m += NGW) {
        const f32x4* xv = (const f32x4*)(H32 + (size_t)m * DM) + lane;
        f32x4 v[8]; float s = 0.f;
#pragma unroll
        for (int j = 0; j < 8; ++j) { v[j] = xv[64 * j]; s += (v[j].x + v[j].y) + (v[j].z + v[j].w); }
        const float mean = wave_sum(s) * (1.f / DM); float s2 = 0.f;
#pragma unroll
        for (int j = 0; j < 8; ++j) { v[j] = v[j] - mean; s2 += (v[j].x * v[j].x + v[j].y * v[j].y) + (v[j].z * v[j].z + v[j].w * v[j].w); }
        const float rstd = rsq(wave_sum(s2) * (1.f / DM) + 1e-5f);
        float* dst = (layer == 0) ? (float*)(a.ws + WS_X32) + (size_t)m * DM : (m < TP ? a.out + O_YP + (size_t)m * DM : a.out + O_YS + (size_t)(m - TP) * DM);
#pragma unroll
        for (int j = 0; j < 8; ++j) { const f32x4 gg = *((const f32x4*)lg + lane + 64 * j), bb = *((const f32x4*)lb + lane + 64 * j);
            const f32x4 y = v[j] * rstd * gg + bb; *((f32x4*)dst + lane + 64 * j) = y;
            if (layer == 0) { u32x2 w; w.x = pk2(y.x, y.y); w.y = pk2(y.z, y.w); *((u32x2*)(Xb + (size_t)m * DM) + lane + 64 * j) = w; } }
    }
}

constexpr int S5_BUS = 128;
constexpr int S5_SROW = 272;
constexpr int S5_UB = 32 * S5_BUS * 4 + 32 * S5_SROW;
constexpr int S5_WLDS = S5_UB + 1024;
template <bool SAMPLE>
__device__ __forceinline__ void s5_item(int layer, int item, int wlo, int lane) {
    CArgs& a = kargs(); LAS unsigned char* wl = lds_base() + wlo;
    const int g = SAMPLE ? item : (item & 63), b = SAMPLE ? 0 : (item >> 6);
    const float* lam_re = a.in[8] + layer * 4096 + g * 64; const float* lam_im = a.in[9] + layer * 4096 + g * 64;
    const float dt = expf(a.in[10][layer * 64 + g]);
    const float* b_re = a.in[11] + (size_t)(layer * 64 + g) * 1024; const float* b_im = a.in[12] + (size_t)(layer * 64 + g) * 1024;
    const float* c_re = a.in[13] + (size_t)(layer * 64 + g) * 1024; const float* c_im = a.in[14] + (size_t)(layer * 64 + g) * 1024;
    const f32x4 dch = *(const f32x4*)(a.in[15] + layer * 1024 + g * 16 + 4 * (lane >> 4));
    const bf16_t* P = (const bf16_t*)(a.ws + WS_P); bf16_t* Zb = (bf16_t*)(a.ws + WS_ZB);
    LAS float* BU = (LAS float*)wl; LAS unsigned char* Sb = wl + 32 * S5_BUS * 4; LAS unsigned char* Ub = wl + S5_UB;
    float ar, ai;
    { const float lr = lam_re[lane], li = lam_im[lane]; const float mag = expf(lr * dt); float sn, cs; sincosf(li * dt, &sn, &cs); ar = mag * cs; ai = mag * sn; }
    bf16x8 Bf[4];
    { const int h = lane >> 5;
#pragma unroll
      for (int q = 0; q < 2; ++q) { const int pp = q * 32 + (lane & 31);
        const float lr = lam_re[pp], li = lam_im[pp]; const float mag = expf(lr * dt); float sn, cs; sincosf(li * dt, &sn, &cs);
        const float abr = mag * cs, abi = mag * sn, den = lr * lr + li * li, nr = abr - 1.f, ni = abi;
        const float f_r = (nr * lr + ni * li) / den, f_i = (ni * lr - nr * li) / den;
        float br8[8], bi8[8], or8[8], oi8[8];
        *(f32x4*)&br8[0] = *(const f32x4*)(b_re + pp * 16 + 8 * h); *(f32x4*)&br8[4] = *(const f32x4*)(b_re + pp * 16 + 8 * h + 4);
        *(f32x4*)&bi8[0] = *(const f32x4*)(b_im + pp * 16 + 8 * h); *(f32x4*)&bi8[4] = *(const f32x4*)(b_im + pp * 16 + 8 * h + 4);
#pragma unroll
        for (int e = 0; e < 8; ++e) { or8[e] = f_r * br8[e] - f_i * bi8[e]; oi8[e] = f_r * bi8[e] + f_i * br8[e]; }
        Bf[q] = __builtin_bit_cast(bf16x8, pack8(or8)); Bf[2 + q] = __builtin_bit_cast(bf16x8, pack8(oi8)); } }
    bf16x8 Cf[4];
    { const int c = lane & 15;
#pragma unroll
      for (int ks = 0; ks < 4; ++ks) { const int p0 = 16 * ks + 4 * (lane >> 4);
        const f32x4 cr = *(const f32x4*)(c_re + c * 64 + p0), ci = *(const f32x4*)(c_im + c * 64 + p0);
        float o[8] = {cr[0], -ci[0], cr[1], -ci[1], cr[2], -ci[2], cr[3], -ci[3]};
        Cf[ks] = __builtin_bit_cast(bf16x8, pack8(o)); } }
    float sr = 0.f, si = 0.f;
    const int nsc = SAMPLE ? 16 : 64;
    const float* h_re = a.in[2] + (size_t)layer * 128 * 4096 + g * 64 + lane; const float* h_im = a.in[3] + (size_t)layer * 128 * 4096 + g * 64 + lane;
    float* o_re = a.out + O_SRS + (size_t)layer * 128 * 4096 + g * 64 + lane; float* o_im = a.out + O_SIS + (size_t)layer * 128 * 4096 + g * 64 + lane;
    const bf16_t* up = P + (size_t)((SAMPLE ? TP : b * 2048) + (lane & 31)) * NP + C_XA + g * 16 + 8 * (lane >> 5);
    bf16x8 Af = *(const bf16x8*)up;
    float hr[8], hi[8];
    if (SAMPLE) {
#pragma unroll
        for (int q = 0; q < 8; ++q) { hr[q] = h_re[(size_t)q * 4096]; hi[q] = h_im[(size_t)q * 4096]; } }
    for (int sc = 0; sc < nsc; ++sc) {
        const int row0 = SAMPLE ? TP + sc * 32 : b * 2048 + sc * 32;
        const bf16x8 Ac = Af;
        float hcr[8], hci[8];
        if (SAMPLE) {
#pragma unroll
            for (int q = 0; q < 8; ++q) { hcr[q] = hr[q]; hci[q] = hi[q]; } }
        if (sc + 1 < nsc) { Af = *(const bf16x8*)(up + (size_t)(sc + 1) * 32 * NP);
            if (SAMPLE) {
#pragma unroll
                for (int q = 0; q < 8; ++q) { hr[q] = h_re[(size_t)((sc + 1) * 8 + q) * 4096]; hi[q] = h_im[(size_t)((sc + 1) * 8 + q) * 4096]; } } }
        *(LAS bf16x8*)(Ub + (lane & 31) * 32 + 16 * (lane >> 5)) = Ac;
#pragma unroll
        for (int nb = 0; nb < 4; ++nb) {
            f32x16 acc;
#pragma unroll
            for (int r = 0; r < 16; ++r) acc[r] = 0.f;
            acc = __builtin_amdgcn_mfma_f32_32x32x16_bf16(Ac, Bf[nb], acc, 0, 0, 0);
#pragma unroll
            for (int r = 0; r < 16; ++r) { const int t = (r & 3) + 8 * (r >> 2) + 4 * (lane >> 5); BU[t * S5_BUS + 32 * nb + (lane & 31)] = acc[r]; }
        }
        LDS_WAIT();
#pragma unroll
        for (int t = 0; t < 32; ++t) {
            if (SAMPLE && (t & 3) == 0) { sr = hcr[t >> 2]; si = hci[t >> 2]; }
            const float bur = BU[t * S5_BUS + lane], bui = BU[t * S5_BUS + 64 + lane];
            const float nsr = ar * sr - ai * si + bur, nsi = ar * si + ai * sr + bui;
            sr = nsr; si = nsi;
            *(LAS unsigned*)(Sb + t * S5_SROW + 4 * lane) = pk2(sr, si);
            if (SAMPLE && (t & 3) == 3) { const int bi = sc * 8 + (t >> 2); o_re[(size_t)bi * 4096] = sr; o_im[(size_t)bi * 4096] = si; }
        }
        LDS_WAIT();
#pragma unroll
        for (int mb = 0; mb < 2; ++mb) {
            f32x4 y = (f32x4){0.f, 0.f, 0.f, 0.f};
#pragma unroll
            for (int ks = 0; ks < 4; ++ks) { const bf16x8 Sf = *(const LAS bf16x8*)(Sb + (16 * mb + (lane & 15)) * S5_SROW + 64 * ks + 16 * (lane >> 4));
                y = __builtin_amdgcn_mfma_f32_16x16x32_bf16(Cf[ks], Sf, y, 0, 0, 0); }
            const int tt = 16 * mb + (lane & 15);
            const u32x2 xw = *(const LAS u32x2*)(Ub + tt * 32 + 8 * (lane >> 4));
            u32x2 o; o.x = pk2(gelu_tanh(y[0] + dch[0] * bflo(xw.x)), gelu_tanh(y[1] + dch[1] * bfhi(xw.x)));
            o.y = pk2(gelu_tanh(y[2] + dch[2] * bflo(xw.y)), gelu_tanh(y[3] + dch[3] * bfhi(xw.y)));
            *(u32x2*)(Zb + (size_t)(row0 + tt) * 1024 + g * 16 + 4 * (lane >> 4)) = o;
        }
        LDS_WAIT();
    }
    if (!SAMPLE) { a.out[O_SRP + (size_t)((layer * 4 + b) * 64 + g) * 64 + lane] = sr; a.out[O_SIP + (size_t)((layer * 4 + b) * 64 + g) * 64 + lane] = si; }
}

constexpr int GM_TROW = 80;
__device__ __forceinline__ void gmlp_prompt_item(int layer, int item, const int tid) {
    CArgs& a = kargs(); LAS unsigned char* lds = lds_base();
    const int lane = tid & 63, w = __builtin_amdgcn_readfirstlane(tid >> 6);
    const bf16_t* P = (const bf16_t*)(a.ws + WS_P); bf16_t* YB = (bf16_t*)(a.ws + WS_YB);
    const float* lng = a.in[19] + layer * 1024; const float* lnb = a.in[20] + layer * 1024;
    const int r0 = item * 128, g = w;
    LAS f32x2* stats = (LAS f32x2*)lds;
    LAS unsigned char* vt = lds + 1024 + w * (16 * GM_TROW);
    __syncthreads();
    {
#pragma unroll 1
        for (int hb = 0; hb < 2; ++hb) {
        u32x4 raw[8][2];
#pragma unroll
        for (int i = 0; i < 8; ++i) { const bf16_t* rp = P + (size_t)(r0 + 16 * w + 8 * hb + i) * NP + C_VB + lane * 16; raw[i][0] = *(const u32x4*)rp; raw[i][1] = *(const u32x4*)(rp + 8); }
#pragma unroll
        for (int i = 0; i < 8; ++i) { float x[16]; { float t8[8]; unpack8(raw[i][0], t8);
#pragma unroll
                for (int e = 0; e < 8; ++e) x[e] = t8[e];
                unpack8(raw[i][1], t8);
#pragma unroll
                for (int e = 0; e < 8; ++e) x[8 + e] = t8[e]; }
            float s = 0.f;
#pragma unroll
            for (int e = 0; e < 16; ++e) s += x[e];
            const float mean = wave_sum(s) * (1.f / 1024.f); float s2 = 0.f;
#pragma unroll
            for (int e = 0; e < 16; ++e) { const float d = x[e] - mean; s2 += d * d; }
            const float rstd = rsq(wave_sum(s2) * (1.f / 1024.f) + 1e-5f);
            if (lane == 0) stats[16 * w + 8 * hb + i] = (f32x2){mean, rstd}; }
        }
    }
    __syncthreads();
    bf16x8 Wf[20];
    { const float* Ws = a.in[21] + (size_t)(layer * 8 + g) * 128 * 128;
#pragma unroll
      for (int kb = 0; kb < 4; ++kb)
#pragma unroll
        for (int ib = 2 * kb; ib < 8; ++ib) { const int fi = (kb == 0 ? 0 : kb == 1 ? 8 : kb == 2 ? 14 : 18) + ib - 2 * kb;
            const int i = 16 * ib + (lane & 15), j0 = 32 * kb + 8 * (lane >> 4);
            const f32x4 w0 = *(const f32x4*)(Ws + i * 128 + j0), w1 = *(const f32x4*)(Ws + i * 128 + j0 + 4);
            float wv[8];
#pragma unroll
            for (int e = 0; e < 8; ++e) { const float x = e < 4 ? w0[e & 3] : w1[e & 3]; wv[e] = (j0 + e <= i) ? x : 0.f; }
            Wf[fi] = __builtin_bit_cast(bf16x8, pack8(wv));
            if ((fi & 3) == 3) __builtin_amdgcn_sched_barrier(0); } }
    const float* bsp = a.in[22] + (size_t)(layer * 8 + g) * 128;
#pragma unroll 1
    for (int rnd = 0; rnd < 8; ++rnd) {
        const int cbase = g * 128 + rnd * 16;
        f32x4 acc[8];
#pragma unroll
        for (int ib = 0; ib < 8; ++ib) acc[ib] = (f32x4){0.f, 0.f, 0.f, 0.f};
        const int cg = lane & 1, j = lane >> 1;
        u32x4 raw[4];
#pragma unroll
        for (int kb = 0; kb < 4; ++kb) raw[kb] = *(const u32x4*)(P + (size_t)(r0 + 32 * kb + j) * NP + C_VB + cbase + cg * 8);
        const f32x4 g0 = *(const f32x4*)(lng + cbase + cg * 8), g1 = *(const f32x4*)(lng + cbase + cg * 8 + 4);
        const f32x4 b0 = *(const f32x4*)(lnb + cbase + cg * 8), b1 = *(const f32x4*)(lnb + cbase + cg * 8 + 4);
#pragma unroll
        for (int kb = 0; kb < 4; ++kb) {
            { float x[8]; unpack8(raw[kb], x);
              const f32x2 st = stats[32 * kb + j];
#pragma unroll
              for (int e = 0; e < 8; ++e) { const float gg = e < 4 ? g0[e & 3] : g1[e & 3], bb = e < 4 ? b0[e & 3] : b1[e & 3];
                  const float v = (x[e] - st.x) * st.y * gg + bb;
                  *(LAS bf16_t*)(vt + (cg * 8 + e) * GM_TROW + 2 * j) = (bf16_t)f2bf(v); } }
            LDS_WAIT();
            const bf16x8 Af = *(const LAS bf16x8*)(vt + (lane & 15) * GM_TROW + 16 * (lane >> 4));
#pragma unroll
            for (int ib = 2 * kb; ib < 8; ++ib) { const int fi = (kb == 0 ? 0 : kb == 1 ? 8 : kb == 2 ? 14 : 18) + ib - 2 * kb;
                acc[ib] = __builtin_amdgcn_mfma_f32_16x16x32_bf16(Af, Wf[fi], acc[ib], 0, 0, 0); }
            LDS_WAIT();
        }
#pragma unroll
        for (int ib = 0; ib < 8; ++ib) { const int i = 16 * ib + (lane & 15); const float bs = bsp[i]; const size_t row = (size_t)(r0 + i);
            const int ch = cbase + 4 * (lane >> 4);
            const u32x2 uw = *(const u32x2*)(P + row * NP + C_UB + ch), gw = *(const u32x2*)(P + row * NP + C_GB + ch);
            const f32x4 s = acc[ib] + bs;
            u32x2 o; o.x = pk2(bflo(uw.x) * s[0] * silu(bflo(gw.x)), bfhi(uw.x) * s[1] * silu(bfhi(gw.x)));
            o.y = pk2(bflo(uw.y) * s[2] * silu(bflo(gw.y)), bfhi(uw.y) * s[3] * silu(bfhi(gw.y)));
            *(u32x2*)(YB + row * 1024 + ch) = o; }
    }
}
__device__ __forceinline__ void gmlp_sample_item(int layer, int b, int lane) {
    CArgs& a = kargs();
    const bf16_t* P = (const bf16_t*)(a.ws + WS_P); bf16_t* YB = (bf16_t*)(a.ws + WS_YB);
    const float* lng = a.in[19] + layer * 1024 + lane * 16; const float* lnb = a.in[20] + layer * 1024 + lane * 16;
    const int g = lane >> 3;
    const float* Ws = a.in[21] + (size_t)(layer * 8 + g) * 128 * 128; const float* bsp = a.in[22] + (size_t)(layer * 8 + g) * 128;
    float vn[4][16];
#pragma unroll
    for (int t = 0; t < 4; ++t) { const size_t row = (size_t)(TP + b * 4 + t); const bf16_t* rp = P + row * NP + C_VB + lane * 16;
        float x[16]; { float t8[8]; unpack8(*(const u32x4*)rp, t8);
#pragma unroll
            for (int e = 0; e < 8; ++e) x[e] = t8[e];
            unpack8(*(const u32x4*)(rp + 8), t8);
#pragma unroll
            for (int e = 0; e < 8; ++e) x[8 + e] = t8[e]; }
        float s = 0.f;
#pragma unroll
        for (int e = 0; e < 16; ++e) s += x[e];
        const float mean = wave_sum(s) * (1.f / 1024.f); float s2 = 0.f;
#pragma unroll
        for (int e = 0; e < 16; ++e) { const float d = x[e] - mean; s2 += d * d; }
        const float rstd = rsq(wave_sum(s2) * (1.f / 1024.f) + 1e-5f);
        float* ov = a.out + O_GV + ((size_t)(layer * 128 + b) * 4 + t) * 1024 + lane * 16;
#pragma unroll
        for (int e = 0; e < 16; ++e) vn[t][e] = (x[e] - mean) * rstd * lng[e] + lnb[e];
#pragma unroll
        for (int e = 0; e < 16; e += 4) *(f32x4*)(ov + e) = (f32x4){vn[t][e], vn[t][e + 1], vn[t][e + 2], vn[t][e + 3]}; }
#pragma unroll
    for (int i = 0; i < 4; ++i) { const size_t row = (size_t)(TP + b * 4 + i);
        float s[16]; const float bs = bsp[i];
#pragma unroll
        for (int e = 0; e < 16; ++e) s[e] = bs;
#pragma unroll
        for (int j = 0; j < 4; ++j) if (j <= i) { const float wv = Ws[i * 128 + j];
#pragma unroll
            for (int e = 0; e < 16; ++e) s[e] += wv * vn[j][e]; }
        float ub[16], gb[16];
        { float t8[8]; unpack8(*(const u32x4*)(P + row * NP + C_UB + lane * 16), t8);
#pragma unroll
          for (int e = 0; e < 8; ++e) ub[e] = t8[e];
          unpack8(*(const u32x4*)(P + row * NP + C_UB + lane * 16 + 8), t8);
#pragma unroll
          for (int e = 0; e < 8; ++e) ub[8 + e] = t8[e];
          unpack8(*(const u32x4*)(P + row * NP + C_GB + lane * 16), t8);
#pragma unroll
          for (int e = 0; e < 8; ++e) gb[e] = t8[e];
          unpack8(*(const u32x4*)(P + row * NP + C_GB + lane * 16 + 8), t8);
#pragma unroll
          for (int e = 0; e < 8; ++e) gb[8 + e] = t8[e]; }
        float o0[8], o1[8];
#pragma unroll
        for (int e = 0; e < 8; ++e) { o0[e] = ub[e] * s[e] * silu(gb[e]); o1[e] = ub[8 + e] * s[8 + e] * silu(gb[8 + e]); }
        *(u32x4*)(YB + row * 1024 + lane * 16) = pack8(o0); *(u32x4*)(YB + row * 1024 + lane * 16 + 8) = pack8(o1); }
}

template <bool SAMPLE>
__device__ __forceinline__ void gdn_item_v1(int layer, int item, const int tid) {
    CArgs& a = kargs(); LAS unsigned char* lds = lds_base();
    const int lane = tid & 63, w = tid >> 6;
    const int b = item >> 3, h = item & 7;
    const int T = SAMPLE ? 4 : 2048, rbase = SAMPLE ? TP + b * 4 : b * 2048, NB = SAMPLE ? 128 : 4;
    const bf16_t* P = (const bf16_t*)(a.ws + WS_P); const float* AB = (const float*)(a.ws + WS_AB); bf16_t* YC = (bf16_t*)(a.ws + WS_YC);
    const float* convw = a.in[24] + (size_t)layer * 4 * 3072;
    const float* sconv = a.in[5] + (size_t)(layer * 128 + b) * 3 * 3072;
    LAS float* qs = (LAS float*)lds; LAS float* ks = qs + 64 * 128; LAS float* vs = ks + 64 * 128;
    LAS float* red = vs + 64 * 128; LAS float* red2 = red + 512; LAS float* av = red2 + 512; LAS float* bv = av + 64;
    const int dv = (w & 1) * 64 + lane, sl = w >> 1, dk0 = sl * 32;
    float S[32];
    if (SAMPLE) { const float* s0 = a.in[4] + ((size_t)((layer * 128 + b) * 8 + h) * 128 + dk0) * 128 + dv;
#pragma unroll
        for (int i = 0; i < 32; ++i) S[i] = s0[(size_t)i * 128]; }
    else {
#pragma unroll
        for (int i = 0; i < 32; ++i) S[i] = 0.f; }
    const float Aexp = expf(a.in[25][layer * 8 + h]), dtb = a.in[26][layer * 8 + h];
    for (int c0 = 0; c0 < T; c0 += 64) {
        const int n = (T - c0) < 64 ? (T - c0) : 64;
        __syncthreads();
        for (int idx = tid; idx < n * 384; idx += 512) {
            const int t = idx / 384, ch = idx - t * 384, sec = ch >> 7, cc = ch & 127, col = sec * 1024 + h * 128 + cc, tg = c0 + t;
            float accv = 0.f;
#pragma unroll
            for (int j = 0; j < 4; ++j) { const int tt = tg - 3 + j; float x;
                if (tt >= 0) x = bf2f(P[(size_t)(rbase + tt) * NP + C_QKV + col]);
                else x = SAMPLE ? sconv[(3 + tt) * 3072 + col] : 0.f;
                accv += convw[j * 3072 + col] * x; }
            const float y = silu(accv);
            LAS float* dst = sec == 0 ? qs : (sec == 1 ? ks : vs); dst[t * 128 + cc] = y;
        }
        if (tid < n) { const size_t row = (size_t)(rbase + c0 + tid); const float ac = AB[row * 16 + h], bc = AB[row * 16 + 8 + h];
            const float gg = -Aexp * softplus(ac + dtb); av[tid] = expf(gg); bv[tid] = sigm(bc); }
        __syncthreads();
        for (int t = w; t < n; t += 8) {
            { const float q0 = qs[t * 128 + lane], q1 = qs[t * 128 + 64 + lane]; const float ss = wave_sum(q0 * q0 + q1 * q1);
              const float r = (rsq(ss + 1e-6f)) * 0.08838834764831845f; qs[t * 128 + lane] = q0 * r; qs[t * 128 + 64 + lane] = q1 * r; }
            { const float k0 = ks[t * 128 + lane], k1 = ks[t * 128 + 64 + lane]; const float ss = wave_sum(k0 * k0 + k1 * k1);
              const float r = rsq(ss + 1e-6f); ks[t * 128 + lane] = k0 * r; ks[t * 128 + 64 + lane] = k1 * r; }
        }
        __syncthreads();
        for (int t = 0; t < n; ++t) {
            const float at = av[t], bt = bv[t];
            float p = 0.f;
#pragma unroll
            for (int i = 0; i < 32; i += 4) { const f32x4 kk = *(const LAS f32x4*)(ks + t * 128 + dk0 + i);
                p += kk[0] * S[i] + kk[1] * S[i + 1] + kk[2] * S[i + 2] + kk[3] * S[i + 3]; }
            red[sl * 128 + dv] = p;
            __syncthreads();
            const float kS = (red[dv] + red[128 + dv]) + (red[256 + dv] + red[384 + dv]);
            const float vnew = bt * (vs[t * 128 + dv] - at * kS);
            float po = 0.f;
#pragma unroll
            for (int i = 0; i < 32; i += 4) { const f32x4 kk = *(const LAS f32x4*)(ks + t * 128 + dk0 + i), qq = *(const LAS f32x4*)(qs + t * 128 + dk0 + i);
#pragma unroll
                for (int e = 0; e < 4; ++e) { S[i + e] = at * S[i + e] + kk[e] * vnew; po += qq[e] * S[i + e]; } }
            red2[sl * 128 + dv] = po;
            __syncthreads();
            if (sl == 0) vs[t * 128 + dv] = (red2[dv] + red2[128 + dv]) + (red2[256 + dv] + red2[384 + dv]);
        }
        __syncthreads();
        const float* ng = a.in[27] + layer * 128;
        for (int t = w; t < n; t += 8) {
            const float o0 = vs[t * 128 + lane], o1 = vs[t * 128 + 64 + lane]; const float ss = wave_sum(o0 * o0 + o1 * o1);
            const float r = rsq(ss * (1.f / 128.f) + 1e-6f); const size_t row = (size_t)(rbase + c0 + t);
            const float g0 = bf2f(P[row * NP + C_GATEC + h * 128 + lane]), g1 = bf2f(P[row * NP + C_GATEC + h * 128 + 64 + lane]);
            YC[row * 1024 + h * 128 + lane] = (bf16_t)f2bf(o0 * r * ng[lane] * silu(g0));
            YC[row * 1024 + h * 128 + 64 + lane] = (bf16_t)f2bf(o1 * r * ng[64 + lane] * silu(g1));
        }
    }
    { float* so = a.out + (SAMPLE ? O_DS : O_DP) + ((size_t)((layer * NB + b) * 8 + h) * 128 + dk0) * 128 + dv;
#pragma unroll
      for (int i = 0; i < 32; ++i) so[(size_t)i * 128] = S[i]; }
    { float* co = a.out + (SAMPLE ? O_CS : O_CP) + (size_t)(layer * NB + b) * 3 * 3072;
      for (int idx = tid; idx < 3 * 384; idx += 512) { const int r = idx / 384, ch = idx - r * 384, col = (ch >> 7) * 1024 + h * 128 + (ch & 127);
          co[r * 3072 + col] = bf2f(P[(size_t)(rbase + T - 3 + r) * NP + C_QKV + col]); } }
}


constexpr size_t WS_GC = WS_M32;
constexpr int GC_STRIDE = 98304, GC_WN = 0, GC_QG = 16384, GC_KG = 32768, GC_AT = 49152, GC_U = 57344, GC_GAMMA = 90112, GC_OPS = 57344;
static_assert(WS_GC + (size_t)1024 * GC_STRIDE <= WS_H32, "chunk buffers fit in the M32|MB overlay");
constexpr int GP_QR = 0, GP_KR = 17408, GP_KBR = 34816, GP_VT = 52224, GP_KGT = 70656, GP_KT2 = 89088, GP_LM = 107520, GP_TM = 124928, GP_AS = 134144,
              GP_GC = 143360, GP_BETA = 143616, GP_GRAW = 143872, GP_WST = 0;
#define MFMA32(a, b, c) __builtin_amdgcn_mfma_f32_32x32x16_bf16((a), (b), (c), 0, 0, 0)

__device__ __forceinline__ void gdn_prep_item(int layer, int item, const int tid) {
    CArgs& a = kargs(); LAS unsigned char* lds = lds_base();
    const int lane = tid & 63, w = __builtin_amdgcn_readfirstlane(tid >> 6), hh = lane >> 5, l31 = lane & 31;
    const int b = item >> 8, h = (item >> 5) & 7, n = item & 31;
    const bf16_t* P = (const bf16_t*)(a.ws + WS_P); const float* AB = (const float*)(a.ws + WS_AB);
    unsigned char* gc = a.ws + WS_GC + (size_t)item * GC_STRIDE;
    const int t = tid >> 3, cg = tid & 7;
    const int r0 = b * 2048 + n * 64;
    __syncthreads();
    float qv[16], kv[16], vv[16];
    {
        const float* convw = a.in[24] + (size_t)layer * 4 * 3072;
#pragma unroll
        for (int sec = 0; sec < 3; ++sec) {
            const int ch = sec * 1024 + h * 128 + 16 * cg;
            float acc[16];
#pragma unroll
            for (int e = 0; e < 16; ++e) acc[e] = 0.f;
#pragma unroll
            for (int j = 0; j < 4; ++j) {
                const int tt = n * 64 + t - 3 + j; const float msk = tt < 0 ? 0.f : 1.f;
                float x[16];
                { const bf16_t* rp = P + (size_t)(b * 2048 + (tt < 0 ? 0 : tt)) * NP + C_QKV + ch; float t8[8];
                    unpack8(*(const u32x4*)rp, t8);
#pragma unroll
                    for (int e = 0; e < 8; ++e) x[e] = t8[e];
                    unpack8(*(const u32x4*)(rp + 8), t8);
#pragma unroll
                    for (int e = 0; e < 8; ++e) x[8 + e] = t8[e]; }
                const float* wp = convw + j * 3072 + ch;
#pragma unroll
                for (int e = 0; e < 16; e += 4) { const f32x4 wv = *(const f32x4*)(wp + e) * msk;
                    acc[e] += wv[0] * x[e]; acc[e + 1] += wv[1] * x[e + 1]; acc[e + 2] += wv[2] * x[e + 2]; acc[e + 3] += wv[3] * x[e + 3]; }
                if (j == 3 && n == 31 && t >= 61) { float* co = a.out + O_CP + ((size_t)(layer * 4 + b) * 3 + (t - 61)) * 3072 + ch;
#pragma unroll
                    for (int e = 0; e < 16; e += 4) *(f32x4*)(co + e) = (f32x4){x[e], x[e + 1], x[e + 2], x[e + 3]}; }
            }
            float ss = 0.f;
#pragma unroll
            for (int e = 0; e < 16; ++e) { acc[e] = silu(acc[e]); ss += acc[e] * acc[e]; }
            if (sec < 2) { ss += __shfl_xor(ss, 1); ss += __shfl_xor(ss, 2); ss += __shfl_xor(ss, 4);
                const float r = (rsq(ss + 1e-6f)) * (sec == 0 ? 0.08838834764831845f : 1.f);
#pragma unroll
                for (int e = 0; e < 16; ++e) { if (sec == 0) qv[e] = acc[e] * r; else kv[e] = acc[e] * r; } }
            else {
#pragma unroll
                for (int e = 0; e < 16; ++e) vv[e] = acc[e]; }
        }
        if (cg == 0) { const size_t row = (size_t)(r0 + t); const float ac = AB[row * 16 + h], bc = AB[row * 16 + 8 + h];
            const float Aexp = expf(a.in[25][layer * 8 + h]), dtb = a.in[26][layer * 8 + h];
            *(LAS float*)(lds + GP_GRAW + 4 * t) = -Aexp * softplus(ac + dtb); *(LAS float*)(lds + GP_BETA + 4 * t) = sigm(bc); }
    }
    __syncthreads();
    if (w == 0) { float g = *(LAS float*)(lds + GP_GRAW + 4 * lane);
#pragma unroll
        for (int o = 1; o < 64; o <<= 1) { const float y = __shfl_up(g, o); if (lane >= o) g += y; }
        *(LAS float*)(lds + GP_GC + 4 * lane) = g; }
    __syncthreads();
    {
        const float gct = *(LAS float*)(lds + GP_GC + 4 * t), bt = *(LAS float*)(lds + GP_BETA + 4 * t), gl = *(LAS float*)(lds + GP_GC + 4 * 63);
        const float eg = fexp(gct), egl = fexp(gl - gct);
        float tq[8], tk[8], tb[8];
#pragma unroll
        for (int half = 0; half < 2; ++half) {
#pragma unroll
            for (int e = 0; e < 8; ++e) { tq[e] = qv[8 * half + e]; tk[e] = kv[8 * half + e]; tb[e] = kv[8 * half + e] * bt; }
            *(LAS u32x4*)(lds + GP_QR + t * 272 + (16 * cg + 8 * half) * 2) = pack8(tq);
            *(LAS u32x4*)(lds + GP_KR + t * 272 + (16 * cg + 8 * half) * 2) = pack8(tk);
            *(LAS u32x4*)(lds + GP_KBR + t * 272 + (16 * cg + 8 * half) * 2) = pack8(tb);
        }
#pragma unroll
        for (int d = 0; d < 16; ++d) { const int rowd = 16 * cg + d;
            *(LAS bf16_t*)(lds + GP_VT + rowd * 144 + 2 * t) = (bf16_t)f2bf(vv[d] * bt);
            *(LAS bf16_t*)(lds + GP_KGT + rowd * 144 + 2 * t) = (bf16_t)f2bf(kv[d] * bt * eg);
            *(LAS bf16_t*)(lds + GP_KT2 + rowd * 144 + 2 * t) = (bf16_t)f2bf(kv[d] * egl); }
#pragma unroll
        for (int hq = 0; hq < 2; ++hq) { float o8[8];
#pragma unroll
            for (int j = 0; j < 8; ++j) o8[j] = qv[8 * (j >> 2) + 4 * hq + (j & 3)] * eg;
            *(u32x4*)(gc + GC_QG + ((((t >> 5) * 4 + (cg >> 1)) * 2 + (cg & 1)) * 64 + (t & 31) + 32 * hq) * 16) = pack8(o8); }
        if (tid == 0) *(float*)(gc + GC_GAMMA) = fexp(gl);
    }
    __syncthreads();
    {
        const int typ = w >> 2, mi = (w >> 1) & 1, nj = w & 1;
        f32x16 acc;
#pragma unroll
        for (int r = 0; r < 16; ++r) acc[r] = 0.f;
        if (!(mi == 0 && nj == 1)) {
            const LAS unsigned char* Ab = lds + (typ ? GP_QR : GP_KBR) + (32 * mi + l31) * 272 + 16 * hh;
            const LAS unsigned char* Bb = lds + GP_KR + (32 * nj + l31) * 272 + 16 * hh;
#pragma unroll
            for (int ks = 0; ks < 8; ++ks) acc = MFMA32(*(const LAS bf16x8*)(Ab + 32 * ks), *(const LAS bf16x8*)(Bb + 32 * ks), acc);
        }
        const int j = 32 * nj + l31; const float gcj = *(LAS float*)(lds + GP_GC + 4 * j);
#pragma unroll
        for (int r = 0; r < 16; ++r) { const int i = 32 * mi + (r & 3) + 8 * (r >> 2) + 4 * hh;
            const float gci = *(LAS float*)(lds + GP_GC + 4 * i);
            const float d = (i >= j) ? fexp(gci - gcj) : 0.f;
            if (typ == 0) *(LAS float*)(lds + GP_LM + i * 272 + 4 * j) = (i > j) ? acc[r] * d : 0.f;
            else *(LAS bf16_t*)(lds + GP_AS + i * 144 + 2 * j) = (bf16_t)f2bf((i >= j) ? acc[r] * d : 0.f); }
    }
    __syncthreads();
    if (w == 0) {
        float x[64];
        f32x4 cur[16], nxt[16];
        x[0] = (lane == 0) ? 1.f : 0.f;
        cur[0] = *(const LAS f32x4*)(lds + GP_LM + 1 * 272);
#pragma unroll
        for (int i = 1; i < 64; ++i) {
            if (i + 1 < 64) {
#pragma unroll
                for (int j4 = 0; j4 < (i + 4) / 4; ++j4) nxt[j4] = *(const LAS f32x4*)(lds + GP_LM + (i + 1) * 272 + 16 * j4);
            }
            __builtin_amdgcn_sched_barrier(0);
            float s0 = (i == lane) ? 1.f : 0.f, s1 = 0.f, s2 = 0.f, s3 = 0.f;
#pragma unroll
            for (int j4 = 0; j4 < (i + 3) / 4; ++j4) {
#pragma unroll
                for (int e = 0; e < 4; ++e) { const int j = 4 * j4 + e; if (j < i) { const float p = cur[j4][e] * x[j];
                    if (e == 0) s0 -= p; else if (e == 1) s1 -= p; else if (e == 2) s2 -= p; else s3 -= p; } } }
            x[i] = (s0 + s1) + (s2 + s3);
            __builtin_amdgcn_sched_barrier(0);
            if (i + 1 < 64) {
#pragma unroll
                for (int j4 = 0; j4 < (i + 4) / 4; ++j4) cur[j4] = nxt[j4];
            }
        }
#pragma unroll
        for (int i = 0; i < 64; ++i) *(LAS bf16_t*)(lds + GP_TM + i * 144 + 2 * lane) = (bf16_t)f2bf(x[i]);
    } else {
        for (int task = tid - 64; task < 1536; task += 448) {
            const int ll = task & 63, hq = ll >> 5;
            if (task < 1024) { const int f = task >> 6, db = f >> 2, tb = (f >> 1) & 1, s = f & 1, dk = 32 * db + (ll & 31), t0 = 32 * tb + 16 * s + 4 * hq;
                const u32x2 lo = *(const LAS u32x2*)(lds + GP_KT2 + dk * 144 + 2 * t0), hi = *(const LAS u32x2*)(lds + GP_KT2 + dk * 144 + 2 * (t0 + 8));
                *(u32x4*)(gc + GC_KG + (f * 64 + ll) * 16) = (u32x4){lo.x, lo.y, hi.x, hi.y}; }
            else { const int f = (task - 1024) >> 6, mb = f >> 2, tb = (f >> 1) & 1, s = f & 1, i = 32 * mb + (ll & 31), j0 = 32 * tb + 16 * s + 4 * hq;
                const u32x2 lo = *(const LAS u32x2*)(lds + GP_AS + i * 144 + 2 * j0), hi = *(const LAS u32x2*)(lds + GP_AS + i * 144 + 2 * (j0 + 8));
                *(u32x4*)(gc + GC_AT + (f * 64 + ll) * 16) = (u32x4){lo.x, lo.y, hi.x, hi.y}; }
        }
    }
    __syncthreads();
    {
        const LAS unsigned char* Bb = lds + (w < 4 ? GP_VT : GP_KGT) + (32 * (w & 3) + l31) * 144 + 16 * hh;
#pragma unroll
        for (int mb = 0; mb < 2; ++mb) {
            f32x16 acc;
#pragma unroll
            for (int r = 0; r < 16; ++r) acc[r] = 0.f;
            const LAS unsigned char* Ab = lds + GP_TM + (32 * mb + l31) * 144 + 16 * hh;
#pragma unroll
            for (int ks = 0; ks < 4; ++ks) acc = MFMA32(*(const LAS bf16x8*)(Ab + 32 * ks), *(const LAS bf16x8*)(Bb + 32 * ks), acc);
            if (w < 4) { unsigned* up = (unsigned*)(gc + GC_U) + ((w * 2 + mb) * 8) * 64 + lane;
#pragma unroll
                for (int q = 0; q < 8; ++q) up[q * 64] = pk2(acc[2 * q], acc[2 * q + 1]); }
            else {
#pragma unroll
                for (int r = 0; r < 16; ++r) { const int tt = 32 * mb + (r & 3) + 8 * (r >> 2) + 4 * hh;
                    *(LAS bf16_t*)(lds + GP_WST + tt * 272 + 2 * (32 * (w - 4) + l31)) = (bf16_t)f2bf(-acc[r]); } }
        }
    }
    __syncthreads();
#pragma unroll
    for (int q = 0; q < 2; ++q) { const int task = tid + 512 * q, f = task >> 6, ll = task & 63, hq = ll >> 5, mb = f >> 3, kb = (f >> 1) & 3, s = f & 1;
        const int tt = 32 * mb + (ll & 31), d0 = 32 * kb + 16 * s + 4 * hq;
        const u32x2 lo = *(const LAS u32x2*)(lds + GP_WST + tt * 272 + 2 * d0), hi = *(const LAS u32x2*)(lds + GP_WST + tt * 272 + 2 * (d0 + 8));
        *(u32x4*)(gc + GC_WN + (f * 64 + ll) * 16) = (u32x4){lo.x, lo.y, hi.x, hi.y}; }
}

__device__ __forceinline__ bf16x8 cvt_frag(const f32x16& v, int s) {
    u32x4 w; w.x = pk2(v[8 * s], v[8 * s + 1]); w.y = pk2(v[8 * s + 2], v[8 * s + 3]); w.z = pk2(v[8 * s + 4], v[8 * s + 5]); w.w = pk2(v[8 * s + 6], v[8 * s + 7]);
    return __builtin_bit_cast(bf16x8, w);
}
constexpr int CH_OB = 2 * GC_OPS;
#define CH_LOAD(dst, cidx) do { const unsigned char* _s = gcb + (size_t)(cidx) * GC_STRIDE + lt * 16; _Pragma("unroll") for (int _i = 0; _i < 14; ++_i) dst[_i] = *(const u32x4*)(_s + _i * 4096); } while (0)
#define CH_WRITE(src, bufi) do { LAS unsigned char* _d = lds + (bufi) * GC_OPS + lt * 16; _Pragma("unroll") for (int _i = 0; _i < 14; ++_i) *(LAS u32x4*)(_d + _i * 4096) = src[_i]; } while (0)
#define CH_GATE(dst, cidx) do { const bf16_t* _g = P + (size_t)(b * 2048 + (cidx) * 64 + (lt >> 4) * 4) * NP + C_GATEC + h * 128 + (lt & 15) * 8; _Pragma("unroll") for (int _q = 0; _q < 4; ++_q) dst[_q] = *(const u32x4*)(_g + (size_t)_q * NP); } while (0)
#define CH_ULOAD(dst, cidx) do { const unsigned* _u = (const unsigned*)(gcb + (size_t)(cidx) * GC_STRIDE + GC_U) + (w * 2 * 8) * 64 + lane; \
    _Pragma("unroll") for (int _m = 0; _m < 2; ++_m) _Pragma("unroll") for (int _q = 0; _q < 8; ++_q) dst[_m][_q] = _u[(_m * 8 + _q) * 64]; } while (0)
__device__ __forceinline__ void gdn_chain(int layer, int bh, const int tid) {
    CArgs& a = kargs(); LAS unsigned char* lds = lds_base();
    const int lane = tid & 63, w = __builtin_amdgcn_readfirstlane(tid >> 6), hh = lane >> 5, l31 = lane & 31;
    const int b = bh >> 3, h = bh & 7;
    const unsigned char* gcb = a.ws + WS_GC + (size_t)bh * 32 * GC_STRIDE;
    __syncthreads();
    if (w >= 4) {
        const int lt = tid - 256;
        const bf16_t* P = (const bf16_t*)(a.ws + WS_P); bf16_t* YC = (bf16_t*)(a.ws + WS_YC);
        float ngv[8]; { const float* ng = a.in[27] + layer * 128 + (lt & 15) * 8; const f32x4 n0 = *(const f32x4*)ng, n1 = *(const f32x4*)(ng + 4);
#pragma unroll
            for (int e = 0; e < 4; ++e) { ngv[e] = n0[e]; ngv[4 + e] = n1[e]; } }
        u32x4 ra[14], rb[14], gt[4];
        CH_LOAD(ra, 0); CH_LOAD(rb, 1);
        CH_WRITE(ra, 0);
        CH_LOAD(ra, 2);
        CH_GATE(gt, 0);
        __syncthreads();
#define CH_FINISH(cc) do { const int t0 = (lt >> 4) * 4, dg = lt & 15; \
            _Pragma("unroll") for (int q = 0; q < 4; ++q) { float t8[8], g8[8], o8[8]; \
                unpack8(*(const LAS u32x4*)(lds + CH_OB + ((cc) & 1) * 16384 + (t0 + q) * 256 + dg * 16), t8); unpack8(gt[q], g8); float ss = 0.f; \
                _Pragma("unroll") for (int e = 0; e < 8; ++e) ss += t8[e] * t8[e]; \
                ss += __shfl_xor(ss, 1); ss += __shfl_xor(ss, 2); ss += __shfl_xor(ss, 4); ss += __shfl_xor(ss, 8); \
                const float r = rsq(ss * (1.f / 128.f) + 1e-6f); \
                _Pragma("unroll") for (int e = 0; e < 8; ++e) o8[e] = t8[e] * r * ngv[e] * silu(g8[e]); \
                *(u32x4*)(YC + (size_t)(b * 2048 + (cc) * 64 + t0 + q) * 1024 + h * 128 + dg * 8) = pack8(o8); } } while (0)
        for (int c = 0; c < 32; c += 2) {
            if (c >= 1) { CH_FINISH(c - 1); CH_GATE(gt, c); }
            CH_WRITE(rb, 1);
            if (c + 3 < 32) CH_LOAD(rb, c + 3);
            __syncthreads();
            CH_FINISH(c); CH_GATE(gt, c + 1);
            if (c + 2 < 32) { CH_WRITE(ra, 0); }
            if (c + 4 < 32) CH_LOAD(ra, c + 4);
            __syncthreads();
        }
        CH_FINISH(31);
    } else {
        f32x16 S[4];
#pragma unroll
        for (int kb = 0; kb < 4; ++kb)
#pragma unroll
            for (int r = 0; r < 16; ++r) S[kb][r] = 0.f;
        const float gam_all = (lane < 32) ? *(const float*)(gcb + (size_t)lane * GC_STRIDE + GC_GAMMA) : 0.f;
        unsigned ua[2][8], ub[2][8];
        CH_ULOAD(ua, 0); CH_ULOAD(ub, 1);
        __syncthreads();
#define CH_STEP(c, ucur) do { \
            const LAS unsigned char* ops = lds + ((c) & 1) * GC_OPS + lane * 16; \
            const float gamma = __shfl(gam_all, (c)); \
            f32x16 va[2], oa[2]; \
            _Pragma("unroll") for (int mb = 0; mb < 2; ++mb) _Pragma("unroll") for (int q = 0; q < 8; ++q) { va[mb][2 * q] = bflo(ucur[mb][q]); va[mb][2 * q + 1] = bfhi(ucur[mb][q]); } \
            _Pragma("unroll") for (int r = 0; r < 16; ++r) { oa[0][r] = 0.f; oa[1][r] = 0.f; } \
            if ((c) + 2 < 32) CH_ULOAD(ucur, (c) + 2); \
            _Pragma("unroll") for (int kb = 0; kb < 4; ++kb) _Pragma("unroll") for (int s = 0; s < 2; ++s) { const bf16x8 Bs = cvt_frag(S[kb], s); \
                _Pragma("unroll") for (int mb = 0; mb < 2; ++mb) { const int f = (mb * 4 + kb) * 2 + s; \
                    va[mb] = MFMA32(*(const LAS bf16x8*)(ops + GC_WN + f * 1024), Bs, va[mb]); \
                    oa[mb] = MFMA32(*(const LAS bf16x8*)(ops + GC_QG + f * 1024), Bs, oa[mb]); } } \
            _Pragma("unroll") for (int kb = 0; kb < 4; ++kb) _Pragma("unroll") for (int r = 0; r < 16; ++r) S[kb][r] *= gamma; \
            _Pragma("unroll") for (int tb = 0; tb < 2; ++tb) _Pragma("unroll") for (int s = 0; s < 2; ++s) { const bf16x8 Bv = cvt_frag(va[tb], s); \
                _Pragma("unroll") for (int kb = 0; kb < 4; ++kb) S[kb] = MFMA32(*(const LAS bf16x8*)(ops + GC_KG + ((kb * 2 + tb) * 2 + s) * 1024), Bv, S[kb]); \
                _Pragma("unroll") for (int mb = 0; mb < 2; ++mb) if (mb >= tb) oa[mb] = MFMA32(*(const LAS bf16x8*)(ops + GC_AT + ((mb * 2 + tb) * 2 + s) * 1024), Bv, oa[mb]); } \
            LAS unsigned char* ob = lds + CH_OB + ((c) & 1) * 16384; \
            _Pragma("unroll") for (int mb = 0; mb < 2; ++mb) _Pragma("unroll") for (int r = 0; r < 16; ++r) { const int tt = 32 * mb + (r & 3) + 8 * (r >> 2) + 4 * hh; \
                *(LAS bf16_t*)(ob + tt * 256 + 2 * (32 * w + l31)) = (bf16_t)f2bf(oa[mb][r]); } \
            __syncthreads(); } while (0)
        for (int c = 0; c < 32; c += 2) { CH_STEP(c, ua); CH_STEP(c + 1, ub); }
        float* so = a.out + O_DP + (size_t)((layer * 4 + b) * 8 + h) * 128 * 128 + 32 * w + l31;
#pragma unroll
        for (int kb = 0; kb < 4; ++kb)
#pragma unroll
            for (int r = 0; r < 16; ++r) so[(size_t)(32 * kb + (r & 3) + 8 * (r >> 2) + 4 * hh) * 128] = S[kb][r];
    }
}

__device__ __forceinline__ void gdn_sample_item(int layer, int item, const int tid) {
    CArgs& a = kargs(); LAS unsigned char* lds = lds_base();
    const int lane = tid & 63, w = __builtin_amdgcn_readfirstlane(tid >> 6);
    const int b = item >> 3, h = item & 7, rbase = TP + b * 4;
    const bf16_t* P = (const bf16_t*)(a.ws + WS_P); const float* AB = (const float*)(a.ws + WS_AB); bf16_t* YC = (bf16_t*)(a.ws + WS_YC);
    LAS float* qs = (LAS float*)lds; LAS float* ks = qs + 512; LAS float* vs = ks + 512;
    LAS float* red = vs + 512;
    LAS float* dots = red + 4096; LAS float* gcv = dots + 32; LAS float* btv = gcv + 4; LAS float* ob = btv + 4;
    const int dv = (w & 1) * 64 + lane, sl = w >> 1, dk0 = sl * 32;
    float S[32];
    { const float* s0 = a.in[4] + ((size_t)((layer * 128 + b) * 8 + h) * 128 + dk0) * 128 + dv;
#pragma unroll
      for (int i = 0; i < 32; ++i) S[i] = s0[(size_t)i * 128]; }
    __syncthreads();
    {
        const float* convw = a.in[24] + (size_t)layer * 4 * 3072; const float* sconv = a.in[5] + (size_t)(layer * 128 + b) * 3 * 3072;
        float* co = a.out + O_CS + (size_t)(layer * 128 + b) * 3 * 3072;
#pragma unroll
        for (int it3 = 0; it3 < 3; ++it3) { const int idx = tid + 512 * it3;
            const int t = idx / 384, ch = idx - t * 384, sec = ch >> 7, cc = ch & 127, col = sec * 1024 + h * 128 + cc;
            float accv = 0.f;
#pragma unroll
            for (int j = 0; j < 4; ++j) { const int tt = t - 3 + j;
                const float xp = bf2f(P[(size_t)(rbase + (tt < 0 ? 0 : tt)) * NP + C_QKV + col]), xs = sconv[(tt < 0 ? 3 + tt : 2) * 3072 + col];
                const float x = (tt >= 0) ? xp : xs;
                if (j == 3 && t >= 1) co[(t - 1) * 3072 + col] = x;
                accv += convw[j * 3072 + col] * x; }
            LAS float* dst = sec == 0 ? qs : (sec == 1 ? ks : vs); dst[t * 128 + cc] = silu(accv);
        }
        if (tid < 4) { const size_t row = (size_t)(rbase + tid); const float ac = AB[row * 16 + h], bc = AB[row * 16 + 8 + h];
            gcv[tid] = -expf(a.in[25][layer * 8 + h]) * softplus(ac + a.in[26][layer * 8 + h]); btv[tid] = sigm(bc); }
    }
    __syncthreads();
    if (w < 4) { const int t = w;
        { const float q0 = qs[t * 128 + lane], q1 = qs[t * 128 + 64 + lane]; const float ss = wave_sum(q0 * q0 + q1 * q1);
          const float r = (rsq(ss + 1e-6f)) * 0.08838834764831845f; qs[t * 128 + lane] = q0 * r; qs[t * 128 + 64 + lane] = q1 * r; }
        { const float k0 = ks[t * 128 + lane], k1 = ks[t * 128 + 64 + lane]; const float ss = wave_sum(k0 * k0 + k1 * k1);
          const float r = rsq(ss + 1e-6f); ks[t * 128 + lane] = k0 * r; ks[t * 128 + 64 + lane] = k1 * r; } }
    __syncthreads();
    {
#pragma unroll
        for (int q = 0; q < 4; ++q) { const int id = w * 4 + q, typ = id >> 4, i = (id >> 2) & 3, j = id & 3;
            const LAS float* xa = (typ ? qs : ks) + i * 128; const LAS float* xb = ks + j * 128;
            const float d = wave_sum(xa[lane] * xb[lane] + xa[64 + lane] * xb[64 + lane]);
            if (lane == 0) dots[id] = d; }
        float pk[4], pq[4];
#pragma unroll
        for (int j = 0; j < 4; ++j) { pk[j] = 0.f; pq[j] = 0.f; }
#pragma unroll
        for (int i = 0; i < 32; i += 4)
#pragma unroll
            for (int j = 0; j < 4; ++j) { const f32x4 kk = *(const LAS f32x4*)(ks + j * 128 + dk0 + i), qq = *(const LAS f32x4*)(qs + j * 128 + dk0 + i);
                pk[j] += kk[0] * S[i] + kk[1] * S[i + 1] + kk[2] * S[i + 2] + kk[3] * S[i + 3];
                pq[j] += qq[0] * S[i] + qq[1] * S[i + 1] + qq[2] * S[i + 2] + qq[3] * S[i + 3]; }
#pragma unroll
        for (int j = 0; j < 4; ++j) { red[(j * 4 + sl) * 128 + dv] = pk[j]; red[((4 + j) * 4 + sl) * 128 + dv] = pq[j]; }
    }
    __syncthreads();
    {
        float gc[4], bt[4];
        gc[0] = gcv[0]; gc[1] = gc[0] + gcv[1]; gc[2] = gc[1] + gcv[2]; gc[3] = gc[2] + gcv[3];
#pragma unroll
        for (int j = 0; j < 4; ++j) bt[j] = btv[j];
        float L[4][4], Tm[4][4];
#pragma unroll
        for (int i = 0; i < 4; ++i)
#pragma unroll
            for (int j = 0; j < 4; ++j) L[i][j] = (i > j) ? bt[i] * dots[i * 4 + j] * fexp(gc[i] - gc[j]) : 0.f;
#pragma unroll
        for (int i = 0; i < 4; ++i)
#pragma unroll
            for (int c = 0; c < 4; ++c) { float s = (i == c) ? 1.f : 0.f;
#pragma unroll
                for (int j = 0; j < 4; ++j) if (j < i) s -= L[i][j] * Tm[j][c];
                Tm[i][c] = s; }
        float kS[4], qS[4], rhs[4], vn[4];
#pragma unroll
        for (int j = 0; j < 4; ++j) { kS[j] = (red[(j * 4 + 0) * 128 + dv] + red[(j * 4 + 1) * 128 + dv]) + (red[(j * 4 + 2) * 128 + dv] + red[(j * 4 + 3) * 128 + dv]);
            qS[j] = (red[((4 + j) * 4 + 0) * 128 + dv] + red[((4 + j) * 4 + 1) * 128 + dv]) + (red[((4 + j) * 4 + 2) * 128 + dv] + red[((4 + j) * 4 + 3) * 128 + dv]);
            rhs[j] = bt[j] * (vs[j * 128 + dv] - fexp(gc[j]) * kS[j]); }
#pragma unroll
        for (int i = 0; i < 4; ++i) { float s = 0.f;
#pragma unroll
            for (int j = 0; j < 4; ++j) if (j <= i) s += Tm[i][j] * rhs[j];
            vn[i] = s; }
        if (sl == 0) {
#pragma unroll
            for (int i = 0; i < 4; ++i) { float o = fexp(gc[i]) * qS[i];
#pragma unroll
                for (int j = 0; j < 4; ++j) if (j <= i) o += dots[16 + i * 4 + j] * fexp(gc[i] - gc[j]) * vn[j];
                ob[i * 128 + dv] = o; } }
        const float gl = gc[3], egl = fexp(gl);
        float cf[4];
#pragma unroll
        for (int j = 0; j < 4; ++j) cf[j] = fexp(gl - gc[j]) * vn[j];
        float* so = a.out + O_DS + ((size_t)((layer * 128 + b) * 8 + h) * 128 + dk0) * 128 + dv;
#pragma unroll
        for (int i = 0; i < 32; ++i) { float s = egl * S[i];
#pragma unroll
            for (int j = 0; j < 4; ++j) s += ks[j * 128 + dk0 + i] * cf[j];
            so[(size_t)i * 128] = s; }
    }
    __syncthreads();
    if (w < 4) { const int t = w; const float* ng = a.in[27] + layer * 128;
        const float o0 = ob[t * 128 + lane], o1 = ob[t * 128 + 64 + lane]; const float ss = wave_sum(o0 * o0 + o1 * o1);
        const float r = rsq(ss * (1.f / 128.f) + 1e-6f); const size_t row = (size_t)(rbase + t);
        const float g0 = bf2f(P[row * NP + C_GATEC + h * 128 + lane]), g1 = bf2f(P[row * NP + C_GATEC + h * 128 + 64 + lane]);
        YC[row * 1024 + h * 128 + lane] = (bf16_t)f2bf(o0 * r * ng[lane] * silu(g0));
        YC[row * 1024 + h * 128 + 64 + lane] = (bf16_t)f2bf(o1 * r * ng[64 + lane] * silu(g1)); }
}

#ifndef REP_ROLE
#define REP_ROLE -1
#endif
#define RR(x) for (int _rr = 0; _rr < ((REP_ROLE == (x)) ? 2 : 1); ++_rr)
constexpr int QA_S5 = 80, QA_GM = 144, QA_PREP = 1168, QA_GMS = 1184, QA_END = 2208;
constexpr int CTL_QUEUE = 4096;
__device__ __forceinline__ void phase_mixers(int layer, int G, int bid, int tid0) {
#ifndef PROBE_MIX
#define PROBE_MIX -1
#endif
#define PM(x) (PROBE_MIX == -1 || PROBE_MIX == (x))
    volatile LAS int* qslot = (volatile LAS int*)(lds_base() + LDS_BARST + 16);
    unsigned* ctr = (unsigned*)kargs().ws + CTL_QUEUE + 64 * layer;
    for (;;) {
        const int tid = launder_v(tid0), lane = tid & 63, w = __builtin_amdgcn_readfirstlane(tid >> 6);
        __syncthreads();
        if (tid == 0) *qslot = (int)__hip_atomic_fetch_add(ctr, 1u, __ATOMIC_RELAXED, __HIP_MEMORY_SCOPE_AGENT);
        __syncthreads();
        const int it = launder_s(__builtin_amdgcn_readfirstlane(*qslot));
        if (it >= QA_END) break;
        if (it < QA_S5) { if (w < 4) { const int q = launder_s(it * 4 + w);
                if (q < 256) { if (PM(1)) s5_item<false>(layer, q, w * S5_WLDS, lane); }
                else { if (PM(2)) s5_item<true>(layer, q - 256, w * S5_WLDS, lane); } } }
        else if (it < QA_GM) { if (PM(3)) gmlp_prompt_item(layer, it - QA_S5, tid); }
        else if (it < QA_PREP) { if (PM(0)) gdn_prep_item(layer, it - QA_GM, tid); }
        else if (it < QA_GMS) { if (PM(4)) gmlp_sample_item(layer, (it - QA_PREP) * 8 + w, lane); }
        else { if (PM(5)) gdn_sample_item(layer, it - QA_GMS, tid); }
    }
}

#define XB_TMO      128
#define XB_XCNT(j)  (256  + 64 * (j))
#define XB_XSUB(j)  (1280 + 64 * (j))
#define XB_XGEN(j)  (2304 + 64 * (j))
#define XB_TOP      3328
#define XB_TOPGEN   3392
#define XCD_BAR_WORDS 3456
#define XB_SPIN_CAP (1u << 18)
__device__ __forceinline__ unsigned xb_ld(unsigned* p)              { return __hip_atomic_load(p, __ATOMIC_RELAXED, __HIP_MEMORY_SCOPE_AGENT); }
__device__ __forceinline__ unsigned xb_add(unsigned* p, unsigned v) { return __hip_atomic_fetch_add(p, v, __ATOMIC_RELAXED, __HIP_MEMORY_SCOPE_AGENT); }
__device__ __forceinline__ unsigned xb_xcc_id() { return (unsigned)__builtin_amdgcn_s_getreg((3 << 11) | 20) & 0xFu; }
#define XB_SPIN(cond, bar) do { unsigned _sp = 0; while (cond) { __builtin_amdgcn_s_sleep(1); \
    if ((++_sp & 255u) == 0u) { if (xb_ld(&(bar)[XB_TMO])) break; if (_sp > XB_SPIN_CAP) { atomicAdd(&(bar)[XB_TMO], 1u); break; } } } } while (0)
struct XcdBarrier { unsigned* bar; unsigned x; volatile LAS unsigned* st; };
__device__ __forceinline__ void xcd_barrier_complete(unsigned* bar, unsigned x, unsigned& nloc, unsigned& nx) {
    const unsigned G = gridDim.x * gridDim.y * gridDim.z;
    unsigned sum, cnt, mine, sp = 0u;
    for (;;) {
        sum = 0u; cnt = 0u; mine = 0u;
#pragma unroll
        for (unsigned j = 0; j < 16; ++j) { const unsigned c = xb_ld(&bar[XB_XCNT(j)]); sum += c; cnt += (c > 0u) ? 1u : 0u; mine = (j == x) ? c : mine; }
        if (sum == G) break;
        __builtin_amdgcn_s_sleep(1);
        if ((++sp & 255u) == 0u) { if (xb_ld(&bar[XB_TMO])) break; if (sp > XB_SPIN_CAP) { atomicAdd(&bar[XB_TMO], 1u); break; } }
    }
    nloc = mine > 0u ? mine : 1u; nx = cnt > 0u ? cnt : 1u;
}
__device__ __forceinline__ void xcd_barrier(const XcdBarrier& b) {
    asm volatile("s_waitcnt vmcnt(0)" ::: "memory");
    __syncthreads();
    if (threadIdx.x == 0) {
        unsigned* bar = b.bar;
        __builtin_amdgcn_s_waitcnt(0);
        unsigned nloc = b.st[0], nx = b.st[1];
        if (nloc == 0u) { xcd_barrier_complete(bar, b.x, nloc, nx); b.st[0] = nloc; b.st[1] = nx; }
        const unsigned old = xb_add(&bar[XB_XSUB(b.x)], 1u);
        const unsigned gen = old / nloc;
        if (old + 1u == (gen + 1u) * nloc) {
            __builtin_amdgcn_fence(__ATOMIC_RELEASE, "agent");
            asm volatile("s_waitcnt vmcnt(0)" ::: "memory");
            const unsigned og = xb_add(&bar[XB_TOP], 1u);
            const unsigned tg = og / nx;
            if (og + 1u == (tg + 1u) * nx) xb_add(&bar[XB_TOPGEN], 1u);
            else XB_SPIN(xb_ld(&bar[XB_TOPGEN]) == tg, bar);
            __builtin_amdgcn_fence(__ATOMIC_ACQUIRE, "agent");
            xb_add(&bar[XB_XGEN(b.x)], 1u);
            asm volatile("s_waitcnt vmcnt(0)" ::: "memory");
        } else {
            XB_SPIN(xb_ld(&bar[XB_XGEN(b.x)]) == gen, bar);
            __builtin_amdgcn_fence(__ATOMIC_ACQUIRE, "agent");
            asm volatile("s_waitcnt vmcnt(0)" ::: "memory");
        }
    }
    __syncthreads();
}

__global__ void __launch_bounds__(512, 2) mega(Args karg) {
    const int ph_lo = karg.ph_lo, ph_hi = karg.ph_hi;
    extern __shared__ __attribute__((aligned(16))) unsigned char lds_raw[];
    volatile LAS unsigned* bst = (volatile LAS unsigned*)((LAS unsigned char*)lds_raw + LDS_BARST);
#if MK_SINGLE
    if (threadIdx.x == 0) { bst[0] = 0u; bst[1] = 0u; }
    __syncthreads();
    if (threadIdx.x == 0) (void)xb_add((unsigned*)karg.ws + XB_XCNT(xb_xcc_id()), 1u);
#endif
#ifndef REP_SUB
#define REP_SUB -1
#endif
#ifndef REP_N
#define REP_N 2
#endif
    int rep = 0;
    for (int ph = ph_lo; ph < ph_hi; (REP_SUB >= 0 && ph >= 1 && (ph - 1) % 6 == REP_SUB && rep + 1 < REP_N) ? (void)++rep : (void)(rep = 0, ++ph)) {
        if (ph > ph_lo && rep == 0) { XcdBarrier xb; xb.bar = (unsigned*)kargs().ws; xb.x = xb_xcc_id(); xb.st = bst; xcd_barrier(xb); }
        const int G = launder_s((int)gridDim.x), bid = launder_s((int)blockIdx.x), tid = launder_v((int)threadIdx.x);
        CArgs& a = kargs(); LAS unsigned char* lds = lds_base();
        unsigned char* ws = a.ws;
#ifndef PROBE_SUB
#define PROBE_SUB -1
#endif
#define PS(x) (PROBE_SUB == -1 || PROBE_SUB == (x))
        if (ph == 0) { if (PS(6)) phase_convert(a, lds, G, bid, tid); continue; }
        const int layer = (ph - 1) / 6, sub = (ph - 1) % 6;
        unsigned char* wb = ws + WS_W0 + (size_t)layer * WS_WL;
        if (PS(0) && sub == 0) {
            pg8::Gemm g{(const bf16_t*)(ws + WS_XB), nullptr, nullptr, (const bf16_t*)(wb + WO_IN), nullptr, nullptr, DM};
            pg8::Sched S; S.init(MT / 256, NP / 256, 1, G, bid);
            pg8::Epi1 E{(bf16_t*)(ws + WS_P), (float*)(ws + WS_AB)};
            pg8::gemm_phase(lds, g, S, E, tid);
        } else if (PS(1) && sub == 1) {
            phase_mixers(layer, G, bid, tid);
        } else if (PS(2) && sub == 2) {
            if (bid < 32) { RR(6) gdn_chain(layer, bid, tid); }
            else {
            pg8::Gemm g{(const bf16_t*)(ws + WS_ZB), nullptr, nullptr, (const bf16_t*)(wb + WO_GLU), nullptr, nullptr, 1024};
            pg8::Sched S; S.init(MT / 256, 4, 1, G - 32, bid - 32);
            pg8::Epi2 E{(const bf16_t*)(ws + WS_ZB), (const bf16_t*)(ws + WS_P), a.in[17] + layer * 1024, (bf16_t*)(ws + WS_YA)};
            pg8::gemm_phase(lds, g, S, E, tid);
            }
        } else if (PS(3) && sub == 3) {
            pg8::Gemm g{(const bf16_t*)(ws + WS_YA), (const bf16_t*)(ws + WS_YB), (const bf16_t*)(ws + WS_YC),
                        (const bf16_t*)(wb + WO_PA), (const bf16_t*)(wb + WO_PB), (const bf16_t*)(wb + WO_PC), 1024};
            pg8::Sched S; S.init(MT / 256, 8, 3, G, bid);
            pg8::Epi3 E{(const bf16_t*)(ws + WS_P), a.in[7] + layer * 3 * DM, (float*)(ws + WS_M32), (bf16_t*)(ws + WS_MB)};
            pg8::gemm_phase(lds, g, S, E, tid);
        } else if (PS(4) && sub == 4) {
            pg8::Gemm g{(const bf16_t*)(ws + WS_MB), nullptr, nullptr, (const bf16_t*)(wb + WO_OUT), nullptr, nullptr, DM};
            pg8::Sched S; S.init(MT / 256, 8, 1, G, bid);
            const float* xp = layer == 0 ? a.in[0] : (const float*)(ws + WS_X32);
            const float* xs = layer == 0 ? a.in[1] : (const float*)(ws + WS_X32) + (size_t)TP * DM;
            pg8::Epi4 E{xp, xs, (float*)(ws + WS_H32)};
            pg8::gemm_phase(lds, g, S, E, tid);
        } else if (PS(5) && sub == 5) {
            phase_ln(a, layer, G, bid, tid);
        }
    }
}

extern "C" void kernel_launch(void* const* d_in, const int* in_sizes, int n_in, void* d_out, int out_size, void* d_ws, size_t ws_size, hipStream_t stream) {
    static int grid = 0;
    if (grid == 0) {
        if (n_in != 32 || (size_t)out_size != O_END || ws_size < WS_END) {
            fprintf(stderr, "kernel_launch: unexpected problem: n_in %d out %d ws %zu (need %zu)\n", n_in, out_size, ws_size, (size_t)WS_END); grid = -1; return; }
        int dev = 0, cus = 0, per_cu = 0;
        if (hipGetDevice(&dev) != hipSuccess || hipDeviceGetAttribute(&cus, hipDeviceAttributeMultiprocessorCount, dev) != hipSuccess) { grid = -1; return; }
        if (hipFuncSetAttribute((const void*)mega, hipFuncAttributeMaxDynamicSharedMemorySize, LDS_BYTES) != hipSuccess) { fprintf(stderr, "kernel_launch: hipFuncSetAttribute failed\n"); grid = -1; return; }
        if (hipOccupancyMaxActiveBlocksPerMultiprocessor(&per_cu, (const void*)mega, 512, LDS_BYTES) != hipSuccess || per_cu < 1) {
            fprintf(stderr, "kernel_launch: occupancy query says %d blocks per CU\n", per_cu); (void)hipGetLastError(); grid = -1; return; }
        grid = cus;
    }
    if (grid < 0) return;
    Args a{};
    for (int i = 0; i < 32; ++i) a.in[i] = (const float*)d_in[i];
    a.out = (float*)d_out; a.ws = (unsigned char*)d_ws;
#if MK_SINGLE
    a.ph_lo = 0; a.ph_hi = NPHASE;
    if (hipMemsetAsync(d_ws, 0, 32768, stream) != hipSuccess) { fprintf(stderr, "kernel_launch: memset of the barrier words failed\n"); return; }
    hipLaunchKernelGGL(mega, dim3(grid), dim3(512), LDS_BYTES, stream, a);
#else
    for (int ph = 0; ph < NPHASE; ++ph) {
        a.ph_lo = ph; a.ph_hi = ph + 1;
        hipLaunchKernelGGL(mega, dim3(grid), dim3(512), LDS_BYTES, stream, a);
    }
#endif
}
```
